# Optimizing an MI355X kernel written in HIP

```python
import math
import jax, jax.numpy as jnp
from jax import lax
import numpy as np

D_MODEL = 1024
BATCH = 16
SEQ = 2048
DEPTH = 4

D_MIX = D_MODEL
D_NSA = D_MIX // 2
D_CONV = D_MIX - D_NSA
HEAD_DIM = 64
N_HEADS = D_NSA // HEAD_DIM
N_KV = 2
Q_PER_KV = N_HEADS // N_KV
D_KV = N_KV * HEAD_DIM
N_BRANCH = 3
L_CMP = 32
CMP_STRIDE = 16
L_SEL = 64
N_SEL = 8
WINDOW = 512
Q_BLOCK = 128
SEL_Q_BLOCK = 64
CONV_WIDTH = 31
NUM_BUCKETS = 32
MAX_DISTANCE = 128
D_IN = D_NSA + 6 * D_KV + N_HEADS * N_BRANCH + 2 * D_CONV
D_FF = 2816
N_EXPERTS = 8
TOP_K = 2
D_FF_EXPERT = 3584
N_DENSE = DEPTH - DEPTH // 2
N_MOE = DEPTH // 2
DEEPNORM_ALPHA = (2 * DEPTH) ** 0.25
DEEPNORM_BETA = (8 * DEPTH) ** -0.25
LN_EPS = 1e-5
NEG_INF = -1e30

kernel_name = 'hybrid_nsa_conformer_moe_trunk'


def layer_norm(x, g, b):
    xf = x.astype(jnp.float32)
    mu = jnp.mean(xf, axis=-1, keepdims=True)
    var = jnp.mean(jnp.square(xf - mu), axis=-1, keepdims=True)
    y = (xf - mu) * lax.rsqrt(var + LN_EPS)
    return (y * g.astype(jnp.float32) + b.astype(jnp.float32)).astype(x.dtype)


def masked_softmax(logits, valid):
    p = jax.nn.softmax(jnp.where(valid, logits, NEG_INF), axis=-1)
    return jnp.where(valid, p, 0.0)


def rel_bucket(dist):
    n = jnp.maximum(dist, 0)
    max_exact = NUM_BUCKETS // 2
    nf = jnp.maximum(n, 1).astype(jnp.float32)
    large = max_exact + (jnp.log(nf / max_exact) / math.log(MAX_DISTANCE / max_exact)
                         * (NUM_BUCKETS - max_exact)).astype(jnp.int32)
    large = jnp.minimum(large, NUM_BUCKETS - 1)
    return jnp.where(n < max_exact, n, large)


def compress(k, pos, w1, w2):
    B, T = k.shape[:2]
    n_cmp = (T - L_CMP) // CMP_STRIDE + 1
    idx = CMP_STRIDE * np.arange(n_cmp)[:, None] + np.arange(L_CMP)[None, :]
    blk = k[:, idx] + pos[None, None, :, None, :]
    blk = blk.transpose(0, 1, 3, 2, 4).reshape(B, n_cmp, N_KV, L_CMP * HEAD_DIM)
    return jax.nn.gelu(blk @ w1) @ w2


def compressed_branch(q5, kc, vc, rel_bias):
    T = q5.shape[1]
    n_cmp = kc.shape[1]
    starts = CMP_STRIDE * np.arange(n_cmp)
    ends = starts + L_CMP - 1
    dist = jnp.asarray(np.arange(T)[:, None] - ends[None, :], dtype=jnp.int32)
    valid = dist >= 0
    bias = rel_bias[rel_bucket(dist)].reshape(T, n_cmp, N_KV, Q_PER_KV).transpose(2, 3, 0, 1)
    logits = jnp.einsum('btgrd,bngd->bgrtn', q5, kc).astype(jnp.float32) + bias.astype(jnp.float32)
    p = masked_softmax(logits, valid)
    o = jnp.einsum('bgrtn,bngd->btgrd', p.astype(vc.dtype), vc)
    nb = T // L_SEL
    bstart = L_SEL * np.arange(nb)
    overlap = ((starts[:, None] < bstart[None, :] + L_SEL)
               & (starts[:, None] + L_CMP > bstart[None, :])).astype(np.float32)
    imp = jnp.einsum('bgrtn,nj->bgtj', p, jnp.asarray(overlap))
    return o, imp


def selected_branch(q5, ks, vs, imp, rel_bias):
    B, T = q5.shape[:2]
    nb = T // L_SEL
    n_sel = min(N_SEL, nb)
    tb = np.arange(T) // L_SEL
    j = np.arange(nb)
    future = jnp.asarray(j[None, :] > tb[:, None])
    forced = jnp.asarray((j[None, :] == 0) | (j[None, :] == tb[:, None]) | (j[None, :] == tb[:, None] - 1))
    score = jnp.where(future, -jnp.inf, jnp.where(forced, jnp.inf, imp))
    _, idx = lax.top_k(score, n_sel)

    def to_blocks(a):
        return a.reshape(B, nb, L_SEL, N_KV, HEAD_DIM).transpose(0, 3, 1, 2, 4).reshape(B, N_KV, nb, L_SEL * HEAD_DIM)

    kb, vb = to_blocks(ks), to_blocks(vs)
    nc = T // SEL_Q_BLOCK
    qc = q5.reshape(B, nc, SEL_Q_BLOCK, N_KV, Q_PER_KV, HEAD_DIM).transpose(1, 0, 2, 3, 4, 5)
    ic = idx.reshape(B, N_KV, nc, SEL_Q_BLOCK, n_sel).transpose(2, 0, 1, 3, 4)
    t0s = jnp.arange(nc, dtype=jnp.int32) * SEL_Q_BLOCK
    rel_g = rel_bias.reshape(NUM_BUCKETS, N_KV, Q_PER_KV)
    b_ix = jnp.arange(B)[:, None, None]
    g_ix = jnp.arange(N_KV)[None, :, None]
    g_ix5 = jnp.arange(N_KV)[None, :, None, None, None]

    def chunk(args):
        qb, ib, t0 = args
        tq = t0 + jnp.arange(SEL_Q_BLOCK)
        flat = ib.reshape(B, N_KV, SEL_Q_BLOCK * n_sel)
        kg = kb[b_ix, g_ix, flat].reshape(B, N_KV, SEL_Q_BLOCK, n_sel, L_SEL, HEAD_DIM)
        vg = vb[b_ix, g_ix, flat].reshape(B, N_KV, SEL_Q_BLOCK, n_sel, L_SEL, HEAD_DIM)
        pos = ib[..., None] * L_SEL + jnp.arange(L_SEL)
        dist = tq[None, None, :, None, None] - pos
        bias = jnp.moveaxis(rel_g[rel_bucket(dist), g_ix5], -1, 3)
        logits = jnp.einsum('bqgrd,bgqskd->bgqrsk', qb, kg).astype(jnp.float32) + bias.astype(jnp.float32)
        logits = logits.reshape(B, N_KV, SEL_Q_BLOCK, Q_PER_KV, n_sel * L_SEL)
        valid = (dist >= 0).reshape(B, N_KV, SEL_Q_BLOCK, 1, n_sel * L_SEL)
        p = masked_softmax(logits, valid).reshape(B, N_KV, SEL_Q_BLOCK, Q_PER_KV, n_sel, L_SEL)
        return jnp.einsum('bgqrsk,bgqskd->bqgrd', p.astype(vg.dtype), vg)

    o = lax.map(chunk, (qc, ic, t0s))
    return o.transpose(1, 0, 2, 3, 4, 5).reshape(B, T, N_KV, Q_PER_KV, HEAD_DIM)


def window_branch(q5, kw, vw, rel_bias):
    B, T = q5.shape[:2]
    nqb = T // Q_BLOCK
    kp = jnp.pad(kw, ((0, 0), (WINDOW, 0), (0, 0), (0, 0)))
    vp = jnp.pad(vw, ((0, 0), (WINDOW, 0), (0, 0), (0, 0)))
    qw = q5.reshape(B, nqb, Q_BLOCK, N_KV, Q_PER_KV, HEAD_DIM).transpose(1, 0, 2, 3, 4, 5)
    t0s = jnp.arange(nqb, dtype=jnp.int32) * Q_BLOCK

    def block(args):
        qb, t0 = args
        kband = lax.dynamic_slice_in_dim(kp, t0, Q_BLOCK + WINDOW, axis=1)
        vband = lax.dynamic_slice_in_dim(vp, t0, Q_BLOCK + WINDOW, axis=1)
        tq = t0 + jnp.arange(Q_BLOCK)
        pos = t0 - WINDOW + jnp.arange(Q_BLOCK + WINDOW)
        dist = tq[:, None] - pos[None, :]
        valid = (dist >= 0) & (dist < WINDOW) & (pos[None, :] >= 0)
        bias = rel_bias[rel_bucket(dist)].reshape(Q_BLOCK, Q_BLOCK + WINDOW, N_KV, Q_PER_KV).transpose(2, 3, 0, 1)
        logits = jnp.einsum('bqgrd,bkgd->bgrqk', qb, kband).astype(jnp.float32) + bias.astype(jnp.float32)
        p = masked_softmax(logits, valid)
        return jnp.einsum('bgrqk,bkgd->bqgrd', p.astype(vband.dtype), vband)

    o = lax.map(block, (qw, t0s))
    return o.transpose(1, 0, 2, 3, 4, 5).reshape(B, T, N_KV, Q_PER_KV, HEAD_DIM)


def conformer_conv(u, w, b, g, beta):
    a, gt = jnp.split(u, 2, axis=-1)
    y = a * jax.nn.sigmoid(gt)
    y = lax.conv_general_dilated(y, w[:, None, :], window_strides=(1,), padding=[(CONV_WIDTH - 1, 0)],
                                 dimension_numbers=('NWC', 'WIO', 'NWC'), feature_group_count=D_CONV) + b
    return jax.nn.silu(layer_norm(y, g, beta))


def hybrid_mixer(h, w_in, cmp_pos, cmp_w1, cmp_w2, conv_w, conv_b, conv_ln_g, conv_ln_b, w_out, rel_bias):
    B, T, _ = h.shape
    u = h @ w_in
    splits = [int(s) for s in np.cumsum([D_NSA] + [D_KV] * 6 + [N_HEADS * N_BRANCH])]
    q, kc, vc, ks, vs, kw, vw, gl, conv_in = jnp.split(u, splits, axis=-1)

    def kv(a):
        return a.reshape(B, T, N_KV, HEAD_DIM)

    q5 = q.reshape(B, T, N_KV, Q_PER_KV, HEAD_DIM) * (HEAD_DIM ** -0.5)
    kcmp = compress(kv(kc), cmp_pos[0], cmp_w1[0], cmp_w2[0])
    vcmp = compress(kv(vc), cmp_pos[1], cmp_w1[1], cmp_w2[1])
    o_cmp, imp = compressed_branch(q5, kcmp, vcmp, rel_bias)
    o_slc = selected_branch(q5, kv(ks), kv(vs), imp, rel_bias)
    o_win = window_branch(q5, kv(kw), kv(vw), rel_bias)
    g = jax.nn.sigmoid(gl.reshape(B, T, N_KV, Q_PER_KV, N_BRANCH))
    o_nsa = g[..., 0:1] * o_cmp + g[..., 1:2] * o_slc + g[..., 2:3] * o_win
    o_conv = conformer_conv(conv_in, conv_w, conv_b, conv_ln_g, conv_ln_b)
    return jnp.concatenate([o_nsa.reshape(B, T, D_NSA), o_conv], axis=-1) @ w_out


def swiglu(h, w1, w2):
    gate, up = jnp.split(h @ w1, 2, axis=-1)
    return (jax.nn.silu(gate) * up) @ w2


def moe_ffn(h, router_w, w1, w2):
    B, T, D = h.shape
    hf = h.reshape(B * T, D)
    logits = (hf @ router_w).astype(jnp.float32)
    top_vals, top_idx = lax.top_k(logits, TOP_K)
    wts = jax.nn.softmax(top_vals, axis=-1)
    out = jnp.zeros_like(hf)
    for e in range(N_EXPERTS):
        we = jnp.sum(jnp.where(top_idx == e, wts, 0.0), axis=-1).astype(hf.dtype)
        out = out + we[:, None] * swiglu(hf, w1[e], w2[e])
    return out.reshape(B, T, D)


def setup_inputs(seed: int = 0) -> dict:
    key = jax.random.key(seed)
    ks = jax.random.split(key, 24)
    nrm = lambda k, s, sc: jax.random.normal(k, s, jnp.float32) * sc
    return {
        'x': nrm(ks[0], (BATCH, SEQ, D_MODEL), 1.0),
        'c': nrm(ks[1], (BATCH, D_MODEL), 1.0),
        'w_in': nrm(ks[2], (DEPTH, D_MODEL, D_IN), D_MODEL ** -0.5),
        'cmp_pos': nrm(ks[3], (DEPTH, 2, L_CMP, HEAD_DIM), 0.1),
        'cmp_w1': nrm(ks[4], (DEPTH, 2, L_CMP * HEAD_DIM, HEAD_DIM), (L_CMP * HEAD_DIM) ** -0.5),
        'cmp_w2': nrm(ks[5], (DEPTH, 2, HEAD_DIM, HEAD_DIM), HEAD_DIM ** -0.5),
        'conv_w': nrm(ks[6], (DEPTH, CONV_WIDTH, D_CONV), CONV_WIDTH ** -0.5),
        'conv_b': nrm(ks[7], (DEPTH, D_CONV), 0.02),
        'conv_ln_g': 1.0 + nrm(ks[8], (DEPTH, D_CONV), 0.02),
        'conv_ln_b': nrm(ks[9], (DEPTH, D_CONV), 0.02),
        'w_out': nrm(ks[10], (DEPTH, D_MIX, D_MODEL), D_MIX ** -0.5 * DEEPNORM_BETA),
        'rel_bias': nrm(ks[11], (NUM_BUCKETS, N_HEADS), 0.5),
        'ada_w': nrm(ks[12], (DEPTH, D_MODEL, 6 * D_MODEL), 0.2 * D_MODEL ** -0.5),
        'ada_b': nrm(ks[13], (DEPTH, 6 * D_MODEL), 0.02),
        'ln_g': 1.0 + nrm(ks[14], (DEPTH, 2, D_MODEL), 0.02),
        'ln_b': nrm(ks[15], (DEPTH, 2, D_MODEL), 0.02),
        'ffn_w1': nrm(ks[16], (N_DENSE, D_MODEL, 2 * D_FF), D_MODEL ** -0.5),
        'ffn_w2': nrm(ks[17], (N_DENSE, D_FF, D_MODEL), D_FF ** -0.5 * DEEPNORM_BETA),
        'router_w': nrm(ks[18], (N_MOE, D_MODEL, N_EXPERTS), D_MODEL ** -0.5),
        'moe_w1': nrm(ks[19], (N_MOE, N_EXPERTS, D_MODEL, 2 * D_FF_EXPERT), D_MODEL ** -0.5),
        'moe_w2': nrm(ks[20], (N_MOE, N_EXPERTS, D_FF_EXPERT, D_MODEL), D_FF_EXPERT ** -0.5 * DEEPNORM_BETA),
    }


def reference(x, c, w_in, cmp_pos, cmp_w1, cmp_w2, conv_w, conv_b, conv_ln_g, conv_ln_b, w_out, rel_bias,
              ada_w, ada_b, ln_g, ln_b, ffn_w1, ffn_w2, router_w, moe_w1, moe_w2):
    sc = jax.nn.silu(c)
    for l in range(DEPTH):
        mod = sc @ ada_w[l] + ada_b[l]
        shift1, scale1, gate1, shift2, scale2, gate2 = [m[:, None, :] for m in jnp.split(mod, 6, axis=-1)]
        h = x * (1.0 + scale1) + shift1
        y = hybrid_mixer(h, w_in[l], cmp_pos[l], cmp_w1[l], cmp_w2[l], conv_w[l], conv_b[l],
                         conv_ln_g[l], conv_ln_b[l], w_out[l], rel_bias)
        x = layer_norm(DEEPNORM_ALPHA * x + (1.0 + gate1) * y, ln_g[l, 0], ln_b[l, 0])
        h = x * (1.0 + scale2) + shift2
        if l % 2 == 0:
            f = swiglu(h, ffn_w1[l // 2], ffn_w2[l // 2])
        else:
            f = moe_ffn(h, router_w[l // 2], moe_w1[l // 2], moe_w2[l // 2])
        x = layer_norm(DEEPNORM_ALPHA * x + (1.0 + gate2) * f, ln_g[l, 1], ln_b[l, 1])
    return x
```

```cpp
#include <hip/hip_runtime.h>
#include <cstdio>
#include <cstdint>
#include <cmath>
namespace pg8 {
#define PG8_LAS __attribute__((address_space(3)))
typedef unsigned short bf16_t;
typedef short bf16x8 __attribute__((ext_vector_type(8)));
typedef float f32x4 __attribute__((ext_vector_type(4)));
typedef unsigned u32x4 __attribute__((ext_vector_type(4)));
constexpr int BM = 256, BK = 64, HALF = 128, HTB = HALF * BK * 2  , STAGE_BYTES = 8 * HTB, NXCD = 8, WGM = 8;

__host__ __device__ __forceinline__ int lds_byte(int r, int c) { const int st = (r >> 4) * 2 + (c >> 5), rr = r & 15, cc = c & 31, ob = rr * 64 + cc * 2; return st * 1024 + (ob ^ (((ob >> 9) & 1) << 5)); }
__host__ __device__ __forceinline__ void stage_rc(int b, int& R, int& C) { const int st = b / 1024, sb = b % 1024, swz = sb ^ (((sb >> 9) & 1) << 5); R = (st >> 1) * 16 + swz / 64; C = (st & 1) * 32 + (swz % 64) / 2; }
__host__ __device__ __forceinline__ int perm32(int rho) { const int n = rho >> 4, i = rho & 15; return 8 * (i >> 2) + 4 * n + (i & 3); }

struct Unit { int pm, pn, pa; };
struct Gemm { const bf16_t* A; const bf16_t* Bt; int M, N, K; };

struct StaticOrder {
    int nM, nN, nwg, G, c;
    __host__ __device__ void init(int M, int N, int G_, int c_) { nM = M / BM; nN = N / BM; nwg = nM * nN; G = G_; c = c_; }
    __host__ __device__ bool next(int i, Unit& u) const {
        const long L = (long)i * G + c; if (L >= nwg) return false;
        int wgid = (int)L; { const int q = nwg / NXCD, r = nwg % NXCD, xcd = wgid % NXCD, off = wgid / NXCD; wgid = (xcd < r ? xcd * (q + 1) : r * (q + 1) + (xcd - r) * q) + off; }
        const int nig = WGM * nN, gid = wgid / nig, fm = gid * WGM, gsz = (nM - fm) < WGM ? (nM - fm) : WGM;
        u.pm = fm + ((wgid % nig) % gsz); u.pn = (wgid % nig) / gsz; u.pa = u.pm; return true;
    }
    __device__ __forceinline__ void a_ready(const Unit&) const {}
    __device__ __forceinline__ void done(const Unit&) const {}
};


__device__ __forceinline__ unsigned cvt_pk_bf16(float lo, float hi) { unsigned r; asm volatile("v_cvt_pk_bf16_f32 %0, %1, %2" : "=v"(r) : "v"(lo), "v"(hi)); return r; }

struct EpiU {
    static constexpr bool PERM = true, AFTER_DRAIN = false;
    bf16_t* O; int ldc; int nscale; float scale0;
    __device__ __forceinline__ void operator()(const f32x4 (&acc)[2][2][4][2], const Unit& u, int wr, int wc, int fr, int fq) const {
        const int row0 = u.pm * BM + wr * 64 + fr; const int col0 = u.pn * BM + wc * 32 + 8 * fq;
        const float sc = (u.pn < nscale) ? scale0 : 1.f;
#pragma unroll
        for (int ai = 0; ai < 2; ++ai)
#pragma unroll
            for (int m = 0; m < 4; ++m) { bf16_t* rowp = O + (size_t)(row0 + ai * HALF + m * 16) * ldc + col0;
#pragma unroll
                for (int bj = 0; bj < 2; ++bj) { f32x4 v0 = acc[ai][bj][m][0] * sc, v1 = acc[ai][bj][m][1] * sc;
                    u32x4 w; w.x = cvt_pk_bf16(v0[0], v0[1]); w.y = cvt_pk_bf16(v0[2], v0[3]); w.z = cvt_pk_bf16(v1[0], v1[1]); w.w = cvt_pk_bf16(v1[2], v1[3]);
                    *(u32x4*)(rowp + bj * HALF) = w; } }
    }
};
__device__ __forceinline__ float silu_f(float x) { return x * __builtin_amdgcn_rcpf(1.f + __builtin_amdgcn_exp2f(-1.4426950408889634f * x)); }
struct EpiSwiGLU {
    static constexpr bool PERM = true, AFTER_DRAIN = false;
    bf16_t* O; int ldo; int nNl;
    __device__ __forceinline__ void operator()(const f32x4 (&acc)[2][2][4][2], const Unit& u, int wr, int wc, int fr, int fq) const {
        const int row0 = u.pm * BM + wr * 64 + fr; const int hc0 = (u.pn % nNl) * HALF + wc * 32 + 8 * fq;
#pragma unroll
        for (int ai = 0; ai < 2; ++ai)
#pragma unroll
            for (int m = 0; m < 4; ++m) { bf16_t* rowp = O + (size_t)(row0 + ai * HALF + m * 16) * ldo + hc0;
                const f32x4 g0 = acc[ai][0][m][0], g1 = acc[ai][0][m][1], u0 = acc[ai][1][m][0], u1 = acc[ai][1][m][1];
                u32x4 w; w.x = cvt_pk_bf16(silu_f(g0[0]) * u0[0], silu_f(g0[1]) * u0[1]); w.y = cvt_pk_bf16(silu_f(g0[2]) * u0[2], silu_f(g0[3]) * u0[3]);
                w.z = cvt_pk_bf16(silu_f(g1[0]) * u1[0], silu_f(g1[1]) * u1[1]); w.w = cvt_pk_bf16(silu_f(g1[2]) * u1[2], silu_f(g1[3]) * u1[3]);
                *(u32x4*)rowp = w; }
    }
};
struct EpiF32 {
    static constexpr bool PERM = false, AFTER_DRAIN = false;
    float* O; int ldc; int nNl;
    __device__ __forceinline__ void operator()(const f32x4 (&acc)[2][2][4][2], const Unit& u, int wr, int wc, int fr, int fq) const {
        const int row0 = u.pm * BM + wr * 64 + fr; const int col0 = (u.pn % nNl) * BM + wc * 32 + 4 * fq;
#pragma unroll
        for (int ai = 0; ai < 2; ++ai)
#pragma unroll
            for (int m = 0; m < 4; ++m) { float* rowp = O + (size_t)(row0 + ai * HALF + m * 16) * ldc + col0;
#pragma unroll
                for (int bj = 0; bj < 2; ++bj)
#pragma unroll
                    for (int n = 0; n < 2; ++n) *(f32x4*)(rowp + bj * HALF + n * 16) = acc[ai][bj][m][n]; }
    }
};
struct MoeOrder {
    StaticOrder so; int P1, P2, P3, P4, P5, P6, P7; int nNl, a_sparse;
    __device__ __forceinline__ void init_dense(int nM, int nNl_, int G, int c) { so.nM = nM; so.nN = nNl_; so.nwg = nM * nNl_; so.G = G; so.c = c; nNl = nNl_; a_sparse = 0; P1 = P2 = P3 = P4 = P5 = P6 = P7 = nM; }
    __device__ __forceinline__ void init_moe(const unsigned* cnt  , int nNl_, int G, int c, int a_sparse_) {
        int p = 0; p += ((int)cnt[0] + 255) >> 8; P1 = p; p += ((int)cnt[64] + 255) >> 8; P2 = p; p += ((int)cnt[128] + 255) >> 8; P3 = p; p += ((int)cnt[192] + 255) >> 8; P4 = p;
        p += ((int)cnt[256] + 255) >> 8; P5 = p; p += ((int)cnt[320] + 255) >> 8; P6 = p; p += ((int)cnt[384] + 255) >> 8; P7 = p; p += ((int)cnt[448] + 255) >> 8;
        so.nM = p; so.nN = nNl_; so.nwg = p * nNl_; so.G = G; so.c = c; nNl = nNl_; a_sparse = a_sparse_;
    }
    __device__ __forceinline__ bool next(int i, Unit& u) const {
        if (!so.next(i, u)) return false;
        int e = 0, pe = 0;
        if (u.pm >= P1) { e = 1; pe = P1; } if (u.pm >= P2) { e = 2; pe = P2; } if (u.pm >= P3) { e = 3; pe = P3; } if (u.pm >= P4) { e = 4; pe = P4; }
        if (u.pm >= P5) { e = 5; pe = P5; } if (u.pm >= P6) { e = 6; pe = P6; } if (u.pm >= P7) { e = 7; pe = P7; }
        u.pa = a_sparse ? e * 128 + (u.pm - pe) : u.pm; u.pn = e * nNl + u.pn; return true;
    }
    __device__ __forceinline__ void a_ready(const Unit&) const {}
    __device__ __forceinline__ void done(const Unit&) const {}
};
template <class Epi, class Sched, bool ALIGN_EPI = false, bool SP2 = false>
__device__ __forceinline__ void gemm_phase(PG8_LAS unsigned char* lds, const Gemm g, const Sched& S, const Epi& E) {
    int tid_ = threadIdx.x; asm volatile("" : "+v"(tid_));
    const int tid = tid_, wid = __builtin_amdgcn_readfirstlane(tid >> 6), lane = tid & 63, wr = wid >> 2, wc = wid & 3, fr = lane & 15, fq = lane >> 4;
    const int K = g.K, nt = K / BK;
    unsigned voffA[2], voffB[2];
#pragma unroll
    for (int i = 0; i < 2; ++i) { int R, C; stage_rc(tid * 16 + i * 8192, R, C); const int Rb = Epi::PERM ? ((R & ~31) + perm32(R & 31)) : R;
        voffA[i] = (unsigned)(R * K + C) * 2u; voffB[i] = (unsigned)(Rb * K + C) * 2u; }
    const size_t kstep = (size_t)(BK * 2);
    const size_t hstep = (size_t)HALF * K * 2;
    const size_t tstep = 2 * hstep;
    const unsigned ldsw = (unsigned)wid * 1024u;
    const int aoff = lds_byte(wr * 64 + fr, fq * 8), boff = lds_byte(wc * 32 + fr, fq * 8);
#define PG8_SA(b, h) (((b) * 2 + (h)) * HTB)
#define PG8_SB(b, h) ((4 + (b) * 2 + (h)) * HTB)
#define PG8_STAGE(bufoff, gbase, voff) do { _Pragma("unroll") for (int _i = 0; _i < 2; ++_i) \
        __builtin_amdgcn_global_load_lds((const unsigned*)((const char*)(gbase) + (voff)[_i]), (PG8_LAS unsigned*)(lds + (bufoff) + ldsw + _i * 8192), 16, 0, 0); } while (0)
#define PG8_LDA(dst, b, h) do { _Pragma("unroll") for (int m = 0; m < 4; ++m) _Pragma("unroll") for (int k = 0; k < 2; ++k) dst[m][k] = *(const PG8_LAS bf16x8*)(lds + PG8_SA(b, h) + aoff + m * 2048 + k * 1024); } while (0)
#define PG8_LDB(dst, b, h) do { _Pragma("unroll") for (int n = 0; n < 2; ++n) _Pragma("unroll") for (int k = 0; k < 2; ++k) dst[n][k] = *(const PG8_LAS bf16x8*)(lds + PG8_SB(b, h) + boff + n * 2048 + k * 1024); } while (0)
#define PG8_MMA(ai, bj, At, Bt) do { __builtin_amdgcn_s_setprio(1); _Pragma("unroll") for (int m = 0; m < 4; ++m) _Pragma("unroll") for (int n = 0; n < 2; ++n) _Pragma("unroll") for (int k = 0; k < 2; ++k) \
        acc[ai][bj][m][n] = __builtin_amdgcn_mfma_f32_16x16x32_bf16(Bt[n][k], At[m][k], acc[ai][bj][m][n], 0, 0, 0); __builtin_amdgcn_s_setprio(0); } while (0)
#define PG8_WAIT_V(n) asm volatile("s_waitcnt vmcnt(" #n ")" ::: "memory")
#define PG8_WAIT_L(n) asm volatile("s_waitcnt lgkmcnt(" #n ")" ::: "memory")
#define PG8_BAR __builtin_amdgcn_s_barrier()
#define PG8_SCHED __builtin_amdgcn_sched_barrier(0)
    Unit cur, nxt; int ui = 0;
    if (!S.next(0, cur)) return;
    f32x4 acc[2][2][4][2];
#pragma unroll
    for (int a = 0; a < 2; ++a)
#pragma unroll
        for (int b = 0; b < 2; ++b)
#pragma unroll
            for (int m = 0; m < 4; ++m)
#pragma unroll
                for (int n = 0; n < 2; ++n) acc[a][b][m][n] = (f32x4){0.f, 0.f, 0.f, 0.f};
    bf16x8 At[4][2], B0[2][2], B1[2][2];
    const char* cA = (const char*)g.A + (size_t)cur.pa * tstep; const char* cB = (const char*)g.Bt + (size_t)cur.pn * tstep;
    S.a_ready(cur);
    if constexpr (SP2) {
        PG8_STAGE(PG8_SB(0, 0), cB, voffB); PG8_STAGE(PG8_SB(0, 1), cB + hstep, voffB); PG8_STAGE(PG8_SA(0, 0), cA, voffA); PG8_STAGE(PG8_SA(0, 1), cA + hstep, voffA);
        if (wr == 1) PG8_BAR;
        PG8_WAIT_V(2); PG8_BAR;
        PG8_STAGE(PG8_SB(1, 0), cB + kstep, voffB); PG8_STAGE(PG8_SA(1, 0), cA + kstep, voffA); PG8_STAGE(PG8_SB(1, 1), cB + hstep + kstep, voffB);
        PG8_WAIT_V(6); PG8_BAR;
    } else {
        PG8_STAGE(PG8_SB(0, 0), cB, voffB); PG8_STAGE(PG8_SA(0, 0), cA, voffA); PG8_STAGE(PG8_SB(0, 1), cB + hstep, voffB); PG8_STAGE(PG8_SA(0, 1), cA + hstep, voffA);
        if (wr == 1) PG8_BAR;
        PG8_WAIT_V(4); PG8_BAR;
        PG8_STAGE(PG8_SB(1, 0), cB + kstep, voffB); PG8_STAGE(PG8_SA(1, 0), cA + kstep, voffA); PG8_STAGE(PG8_SB(1, 1), cB + hstep + kstep, voffB);
        PG8_WAIT_V(6); PG8_BAR;
    }
    for (;;) {
        const bool has_next = S.next(ui + 1, nxt);
        const char* nA = has_next ? (const char*)g.A + (size_t)nxt.pa * tstep : cA; const char* nB = has_next ? (const char*)g.Bt + (size_t)nxt.pn * tstep : cB;
        for (int t = 0; t < nt; t += 2) {
            const bool last = (t == nt - 2);
            const char* a1 = cA + (size_t)(t + 1) * kstep;
            const char* a2 = last ? nA : cA + (size_t)(t + 2) * kstep; const char* b2 = last ? nB : cB + (size_t)(t + 2) * kstep;
            const char* a3 = a2 + kstep; const char* b3 = b2 + kstep;
            if (last && has_next) S.a_ready(nxt);
            if constexpr (SP2) {
            PG8_LDB(B0, 0, 0); PG8_LDB(B1, 0, 1); PG8_SCHED; PG8_LDA(At, 0, 0); PG8_STAGE(PG8_SA(1, 1), a1 + hstep, voffA);
            PG8_WAIT_V(8); PG8_WAIT_L(0); PG8_BAR; PG8_MMA(0, 0, At, B0); PG8_MMA(0, 1, At, B1); PG8_BAR; PG8_SCHED;
            PG8_LDA(At, 0, 1); PG8_STAGE(PG8_SB(0, 0), b2, voffB); PG8_STAGE(PG8_SB(0, 1), b2 + hstep, voffB); PG8_STAGE(PG8_SA(0, 0), a2, voffA);
            PG8_WAIT_V(8); PG8_WAIT_L(0); PG8_BAR; PG8_MMA(1, 0, At, B0); PG8_MMA(1, 1, At, B1); PG8_BAR; PG8_SCHED;
            PG8_LDB(B0, 1, 0); PG8_LDB(B1, 1, 1); PG8_SCHED; PG8_LDA(At, 1, 0); PG8_STAGE(PG8_SA(0, 1), a2 + hstep, voffA);
            PG8_WAIT_V(8); PG8_WAIT_L(0); PG8_BAR; PG8_MMA(0, 0, At, B0); PG8_MMA(0, 1, At, B1); PG8_BAR; PG8_SCHED;
            PG8_LDA(At, 1, 1); PG8_STAGE(PG8_SB(1, 0), b3, voffB); PG8_STAGE(PG8_SB(1, 1), b3 + hstep, voffB); PG8_STAGE(PG8_SA(1, 0), a3, voffA);
            PG8_WAIT_V(8); PG8_WAIT_L(0); PG8_BAR; PG8_MMA(1, 0, At, B0); PG8_MMA(1, 1, At, B1); PG8_BAR; PG8_SCHED;
            } else {
            PG8_LDB(B0, 0, 0); PG8_SCHED; PG8_LDA(At, 0, 0); PG8_STAGE(PG8_SA(1, 1), a1 + hstep, voffA);
            PG8_WAIT_L(8); PG8_BAR; PG8_WAIT_L(0); PG8_MMA(0, 0, At, B0); PG8_BAR; PG8_SCHED;
            PG8_LDB(B1, 0, 1); PG8_STAGE(PG8_SB(0, 0), b2, voffB);
            PG8_BAR; PG8_WAIT_L(0); PG8_MMA(0, 1, At, B1); PG8_BAR;
            PG8_LDA(At, 0, 1); PG8_STAGE(PG8_SA(0, 0), a2, voffA);
            PG8_BAR; PG8_WAIT_L(0); PG8_MMA(1, 0, At, B0); PG8_BAR; PG8_SCHED;
            PG8_STAGE(PG8_SB(0, 1), b2 + hstep, voffB);
            PG8_WAIT_V(6); PG8_BAR; PG8_MMA(1, 1, At, B1); PG8_BAR;
            PG8_LDB(B0, 1, 0); PG8_SCHED; PG8_LDA(At, 1, 0); PG8_STAGE(PG8_SA(0, 1), a2 + hstep, voffA);
            PG8_WAIT_L(8); PG8_BAR; PG8_WAIT_L(0); PG8_MMA(0, 0, At, B0); PG8_BAR; PG8_SCHED;
            PG8_LDB(B1, 1, 1); PG8_STAGE(PG8_SB(1, 0), b3, voffB);
            PG8_BAR; PG8_WAIT_L(0); PG8_MMA(0, 1, At, B1); PG8_BAR;
            PG8_LDA(At, 1, 1); PG8_STAGE(PG8_SA(1, 0), a3, voffA);
            PG8_BAR; PG8_WAIT_L(0); PG8_MMA(1, 0, At, B0); PG8_BAR; PG8_SCHED;
            PG8_STAGE(PG8_SB(1, 1), b3 + hstep, voffB);
            PG8_WAIT_V(6); PG8_BAR; PG8_MMA(1, 1, At, B1); PG8_BAR;
            }
        }
        if constexpr (ALIGN_EPI) { if (wr == 0) PG8_BAR; }
        if constexpr (!Epi::AFTER_DRAIN) { E(acc, cur, wr, wc, fr, fq); S.done(cur); }
        if (!has_next) break;
#pragma unroll
        for (int a = 0; a < 2; ++a)
#pragma unroll
            for (int b = 0; b < 2; ++b)
#pragma unroll
                for (int m = 0; m < 4; ++m)
#pragma unroll
                    for (int n = 0; n < 2; ++n) acc[a][b][m][n] = (f32x4){0.f, 0.f, 0.f, 0.f};
        cur = nxt; cA = nA; cB = nB; ++ui;
        if constexpr (ALIGN_EPI) { if (wr == 1) PG8_BAR; }
    }
    PG8_WAIT_V(0);
    if constexpr (!ALIGN_EPI) { if (wr == 0) PG8_BAR; }
    PG8_BAR;
    if constexpr (Epi::AFTER_DRAIN) { E.fused(acc, cur, wr, wc, fr, fq, lds, wid, lane); S.done(cur); }
#undef PG8_SA
#undef PG8_SB
#undef PG8_STAGE
#undef PG8_LDA
#undef PG8_LDB
#undef PG8_MMA
#undef PG8_WAIT_V
#undef PG8_WAIT_L
#undef PG8_BAR
#undef PG8_SCHED
}
}
#define GAS __attribute__((address_space(1)))
#define LAS __attribute__((address_space(3)))
typedef unsigned short bf16;
typedef unsigned v4u __attribute__((ext_vector_type(4)));
typedef float f32x4 __attribute__((ext_vector_type(4)));
typedef short bf16x8 __attribute__((ext_vector_type(8)));
typedef GAS unsigned gu32;
typedef GAS unsigned long long gu64;
#define RLX_AGENT __ATOMIC_RELAXED, __HIP_MEMORY_SCOPE_AGENT
#define LDS_WAIT() asm volatile("s_waitcnt lgkmcnt(0)" ::: "memory")
#define VM_WAIT() asm volatile("s_waitcnt vmcnt(0)" ::: "memory")
__device__ __forceinline__ unsigned long long rt() { return __builtin_amdgcn_s_memrealtime(); }
__device__ __forceinline__ unsigned f2bf(float f) { unsigned u = __builtin_bit_cast(unsigned, f); return (u + 0x7fffu + ((u >> 16) & 1u)) >> 16; }
__device__ __forceinline__ unsigned pk2(float lo, float hi) { return f2bf(lo) | (f2bf(hi) << 16); }

#define XB_TMO      128
#define XB_XCNT(j)  (256  + 64 * (j))
#define XB_XSUB(j)  (1280 + 64 * (j))
#define XB_XGEN(j)  (2304 + 64 * (j))
#define XB_TOP      3328
#define XB_TOPGEN   3392
#define XCD_BAR_WORDS 3456
#define XB_SPIN_CAP (1u << 18)

__device__ __forceinline__ unsigned xb_ld(unsigned* p)              { return __hip_atomic_load(p, __ATOMIC_RELAXED, __HIP_MEMORY_SCOPE_AGENT); }
__device__ __forceinline__ unsigned xb_add(unsigned* p, unsigned v) { return __hip_atomic_fetch_add(p, v, __ATOMIC_RELAXED, __HIP_MEMORY_SCOPE_AGENT); }
__device__ __forceinline__ unsigned xb_xcc_id() { return (unsigned)__builtin_amdgcn_s_getreg((3 << 11) | 20) & 0xFu; }
#define XB_SPIN(cond, bar) do { unsigned _sp = 0; while (cond) { __builtin_amdgcn_s_sleep(1); \
    if ((++_sp & 255u) == 0u) { if (xb_ld(&(bar)[XB_TMO])) break; if (_sp > XB_SPIN_CAP) { atomicAdd(&(bar)[XB_TMO], 1u); break; } } } } while (0)

struct XcdBarrier {
    unsigned* bar; unsigned x;
    volatile LAS unsigned* st;
};

__device__ __forceinline__ XcdBarrier xcd_barrier_post(unsigned* bar, volatile LAS unsigned* st) {
    XcdBarrier b; b.bar = bar; b.x = xb_xcc_id(); b.st = st;
    if (threadIdx.x == 0) (void)xb_add(&bar[XB_XCNT(b.x)], 1u);
    return b;
}
__device__ __forceinline__ void xcd_barrier_complete(unsigned* bar, unsigned x, unsigned& nloc, unsigned& nx) {
    const unsigned G = gridDim.x * gridDim.y * gridDim.z;
    unsigned sum, cnt, mine, sp = 0u;
    for (;;) {
        sum = 0u; cnt = 0u; mine = 0u;
#pragma unroll
        for (unsigned j = 0; j < 16; ++j) { const unsigned c = xb_ld(&bar[XB_XCNT(j)]); sum += c; cnt += (c > 0u) ? 1u : 0u; mine = (j == x) ? c : mine; }
        if (sum == G) break;
        __builtin_amdgcn_s_sleep(1);
        if ((++sp & 255u) == 0u) { if (xb_ld(&bar[XB_TMO])) break; if (sp > XB_SPIN_CAP) { atomicAdd(&bar[XB_TMO], 1u); break; } }
    }
    nloc = mine > 0u ? mine : 1u; nx = cnt > 0u ? cnt : 1u;
}

__device__ __forceinline__ void xcd_barrier(const XcdBarrier& b) {
    asm volatile("s_waitcnt vmcnt(0)" ::: "memory");
    __syncthreads();
    if (threadIdx.x == 0) {
        unsigned* bar = b.bar;
        __builtin_amdgcn_s_waitcnt(0);
        unsigned nloc = b.st[0], nx = b.st[1];
        if (nloc == 0u) { xcd_barrier_complete(bar, b.x, nloc, nx); b.st[0] = nloc; b.st[1] = nx; }
        const unsigned old = xb_add(&bar[XB_XSUB(b.x)], 1u);
        const unsigned gen = old / nloc;
        if (old + 1u == (gen + 1u) * nloc) {
            __builtin_amdgcn_fence(__ATOMIC_RELEASE, "agent");
            asm volatile("s_waitcnt vmcnt(0)" ::: "memory");
            const unsigned og = xb_add(&bar[XB_TOP], 1u);
            const unsigned tg = og / nx;
            if (og + 1u == (tg + 1u) * nx) xb_add(&bar[XB_TOPGEN], 1u);
            else XB_SPIN(xb_ld(&bar[XB_TOPGEN]) == tg, bar);
            __builtin_amdgcn_fence(__ATOMIC_ACQUIRE, "agent");
            xb_add(&bar[XB_XGEN(b.x)], 1u);
            asm volatile("s_waitcnt vmcnt(0)" ::: "memory");
        } else {
            XB_SPIN(xb_ld(&bar[XB_XGEN(b.x)]) == gen, bar);
            __builtin_amdgcn_fence(__ATOMIC_ACQUIRE, "agent");
            asm volatile("s_waitcnt vmcnt(0)" ::: "memory");
        }
    }
    __syncthreads();
}

constexpr int NWAVES = 8;
constexpr int BATCH = 16, T = 2048, D = 1024, M = BATCH * T, DEPTH = 4;
constexpr int NU = 2560;
constexpr int UQ = 0, UKC = 512, UVC = 640, UKS = 768, UVS = 896, UKW = 1024, UVW = 1152, UCA = 1280, UCG = 1792, UGL = 2304;
constexpr int D_IN = 2328;
constexpr int FF = 2816, FFE = 3584, NEXP = 8;
constexpr int NCMP = 127, NCP = 128;
constexpr float LN_EPS = 1e-5f;
constexpr float ALPHA = 1.6817928305074290f;
constexpr float LOG2E = 1.4426950408889634f;
constexpr float C2 = 0.125f * 1.4426950408889634f;
constexpr int ECAP = 32768;

constexpr size_t MiB = 1u << 20;
constexpr size_t WS_CTL = 0, CTL_ZERO_BYTES = 1 * MiB;
constexpr size_t WS_MOD = 1 * MiB;
constexpr size_t WS_TBL = 3 * MiB;
constexpr size_t WS_KCMP = 4 * MiB;
constexpr size_t WS_VCMP = 4 * MiB + 512 * 1024;
constexpr size_t WS_ROUTE = 5 * MiB;
constexpr size_t WS_WCMP = 6 * MiB;
constexpr size_t WS_WIN = 8 * MiB;
constexpr size_t WS_WO = 13 * MiB;
constexpr size_t WS_W1 = 16 * MiB;
constexpr size_t WS_W2 = 128 * MiB;
constexpr size_t WS_H = 184 * MiB;
constexpr size_t WS_CAT = 248 * MiB;
constexpr size_t WS_Y = 312 * MiB;
constexpr size_t WS_U = 440 * MiB;
constexpr size_t WS_Y2 = 312 * MiB;
constexpr size_t WS_HG = 600 * MiB;
constexpr size_t WS_HID = 1112 * MiB;
constexpr size_t WS_END = 1574 * MiB;
static_assert(WS_Y2 + (size_t)(2 * M + 2048) * D * 4 <= WS_HG && WS_HID + (size_t)(2 * M + 2048) * FFE * 2 <= WS_END, "d_ws map");
constexpr int CW_TMO = 0, CW_CODE = 1;
constexpr int CW_BAR = 4096;
constexpr int CW_CNT = 16384;
constexpr int RING_OFF = 0, RING_BYTES = 131072;
constexpr int LDSCTL_OFF = RING_BYTES, MISC_OFF = LDSCTL_OFF + 320;
constexpr int LDS_BYTES = 147456;
struct Args { const float* in[21]; float* out; unsigned char* ws; int ph_lo, ph_hi; };

struct Frame {
    LAS unsigned char* lds;
    volatile LAS unsigned* MISC;
    gu32* ctl;
    int tid, lane, wave, G;

    float* X;
    unsigned char* ws;
};
enum { I_X = 0, I_C, I_WIN, I_CPOS, I_CW1, I_CW2, I_CVW, I_CVB, I_CVG, I_CVBE, I_WOUT, I_RB, I_ADAW, I_ADAB, I_LNG, I_LNB, I_FW1, I_FW2, I_RW, I_MW1, I_MW2 };

__device__ __forceinline__ float wave_sum(float v) {
#pragma unroll
    for (int o = 1; o < 64; o <<= 1) v += __shfl_xor(v, o);
    return v;
}
__device__ __forceinline__ float bf2f(unsigned short v) { return __uint_as_float((unsigned)v << 16); }
__device__ __forceinline__ float bflo(unsigned w) { return __uint_as_float(w << 16); }
__device__ __forceinline__ float bfhi(unsigned w) { return __uint_as_float(w & 0xffff0000u); }
__device__ __forceinline__ float sigmoid_f(float x) { return 1.f / (1.f + __expf(-x)); }

__device__ __forceinline__ void ph_ada(const Args& A, Frame& F) {
    LAS float* sc = (LAS float*)(F.lds);
    LAS float* red = (LAS float*)(F.lds + 65536);
    float* MOD = (float*)(F.ws + WS_MOD);
    for (int i = F.tid; i < BATCH * D; i += 512) { const float v = A.in[I_C][i]; sc[i] = v / (1.f + expf(-v)); }
    __syncthreads();
    const int c = F.tid & 63, ks = F.tid >> 6;
    for (int item = blockIdx.x; item < DEPTH * 96; item += gridDim.x) {
        const int l = item / 96, cb = item % 96, col = cb * 64 + c;
        const float* W = A.in[I_ADAW] + (size_t)l * D * 6 * D + col;
        float acc[16];
#pragma unroll
        for (int b = 0; b < 16; ++b) acc[b] = 0.f;
        for (int k = ks * 128; k < ks * 128 + 128; ++k) { const float w = W[(size_t)k * 6 * D];
#pragma unroll
            for (int b = 0; b < 16; ++b) acc[b] += sc[b * D + k] * w; }
#pragma unroll
        for (int b = 0; b < 16; ++b) red[(ks * 16 + b) * 64 + c] = acc[b];
        __syncthreads();
        for (int o = F.tid; o < 1024; o += 512) { const int b = o >> 6, cc = o & 63; float s = 0.f;
#pragma unroll
            for (int k2 = 0; k2 < 8; ++k2) s += red[(k2 * 16 + b) * 64 + cc];
            MOD[(size_t)(l * BATCH + b) * 6 * D + cb * 64 + cc] = s + A.in[I_ADAB][l * 6 * D + cb * 64 + cc]; }
        __syncthreads();
    }
}
__device__ __forceinline__ int rel_bucket_dev(int d) {
    if (d < 16) return d;
    int b = 16;
    b += (d >= 19); b += (d >= 21); b += (d >= 24); b += (d >= 27); b += (d >= 31); b += (d >= 35); b += (d >= 40); b += (d >= 46);
    b += (d >= 52); b += (d >= 59); b += (d >= 67); b += (d >= 77); b += (d >= 87); b += (d >= 99); b += (d >= 113);
    return b;
}
__device__ __forceinline__ void ph_tbl(const Args& A, Frame& F) {
    if (blockIdx.x != 0) return;
    float* TBL = (float*)(F.ws + WS_TBL);
    for (int i = F.tid; i < 1024; i += 512) { const int h = i >> 7, d = i & 127; TBL[i] = A.in[I_RB][rel_bucket_dev(d) * 8 + h] * LOG2E; }
}
__device__ __forceinline__ int cvt_dest(int kind, int Fh, int n) {
    if (kind == 0) return n;
    if (kind == 1) return n < 1280 ? n : (n < 1304 ? n + 1024 : n - 24);
    return n < Fh ? ((n >> 7) << 8) + (n & 127) : (((n - Fh) >> 7) << 8) + 128 + ((n - Fh) & 127);
}
__device__ __forceinline__ void cvt_item(const float* W, int K, int N, bf16* WT, int kind, int Fh, LAS float* scr, int item, int lane) {
    const int nblk = (N + 31) >> 5, kb = item / nblk, nb = item % nblk, k0 = 64 * kb, n0 = 32 * nb;
    const int nn = n0 + (lane & 31);
#pragma unroll 8
    for (int i = 0; i < 32; ++i) { const int kk = 2 * i + (lane >> 5); scr[kk * 33 + (lane & 31)] = (nn < N) ? W[(size_t)(k0 + kk) * N + nn] : 0.f; }
    LDS_WAIT(); asm volatile("" ::: "memory");
    const int c = lane & 7;
#pragma unroll
    for (int j = 0; j < 4; ++j) { const int nl = (lane >> 3) + 8 * j; const int n = n0 + nl; const LAS float* s = scr + (8 * c) * 33 + nl;
        v4u o; o.x = pk2(s[0 * 33], s[1 * 33]); o.y = pk2(s[2 * 33], s[3 * 33]); o.z = pk2(s[4 * 33], s[5 * 33]); o.w = pk2(s[6 * 33], s[7 * 33]);
        if (n < N) *(GAS v4u*)(WT + (size_t)cvt_dest(kind, Fh, n) * K + k0 + 8 * c) = o; }
    LDS_WAIT(); asm volatile("" ::: "memory");
}
__device__ __forceinline__ void ph_cvt(const Args& A, Frame& F, int l) {
    LAS float* scr = (LAS float*)(F.lds + F.wave * 16384);
    const int gw = blockIdx.x * NWAVES + F.wave, NGW = gridDim.x * NWAVES;
    bf16* WIN = (bf16*)(F.ws + WS_WIN); bf16* WO = (bf16*)(F.ws + WS_WO); bf16* W1 = (bf16*)(F.ws + WS_W1); bf16* W2 = (bf16*)(F.ws + WS_W2);
    const int I_A = 16 * 73, I_B = 16 * 32, I_Z = 464;
    const bool moe = (l & 1) != 0; const int l2 = l >> 1;
    const int I_1 = moe ? 8 * 16 * 224 : 16 * 176, I_2 = moe ? 8 * 56 * 32 : 44 * 32;
    const int NIT = I_A + I_B + I_Z + I_1 + I_2;
    for (int it = gw; it < NIT; it += NGW) {
        int r = it;
        if (r < I_1) { if (!moe) cvt_item(A.in[I_FW1] + (size_t)l2 * D * 2 * FF, D, 2 * FF, W1, 2, FF, scr, r, F.lane);
                       else { const int e = r / (16 * 224); cvt_item(A.in[I_MW1] + (size_t)(l2 * 8 + e) * D * 2 * FFE, D, 2 * FFE, W1 + (size_t)e * 2 * FFE * D, 2, FFE, scr, r % (16 * 224), F.lane); }
                       continue; } r -= I_1;
        if (r < I_2) { if (!moe) cvt_item(A.in[I_FW2] + (size_t)l2 * FF * D, FF, D, W2, 0, 0, scr, r, F.lane);
                       else { const int e = r / (56 * 32); cvt_item(A.in[I_MW2] + (size_t)(l2 * 8 + e) * FFE * D, FFE, D, W2 + (size_t)e * D * FFE, 0, 0, scr, r % (56 * 32), F.lane); }
                       continue; } r -= I_2;
        if (r < I_A) { cvt_item(A.in[I_WIN] + (size_t)l * D * D_IN, D, D_IN, WIN, 1, 0, scr, r, F.lane); continue; } r -= I_A;
        if (r < I_B) { cvt_item(A.in[I_WOUT] + (size_t)l * D * D, D, D, WO, 0, 0, scr, r, F.lane); continue; } r -= I_B;
        { unsigned zz = 0u; asm volatile("" : "+v"(zz)); v4u z = {zz, zz, zz, zz}; *(GAS v4u*)(WIN + (size_t)D_IN * D + ((size_t)r * 64 + F.lane) * 8) = z; }
    }
}
__device__ __forceinline__ void ph_mod0(const Args& A, Frame& F) {
    const int gw = blockIdx.x * NWAVES + F.wave, NGW = gridDim.x * NWAVES;
    const float* MOD = (const float*)(F.ws + WS_MOD); bf16* H = (bf16*)(F.ws + WS_H);
    for (int m = gw; m < M; m += NGW) { const int b = m >> 11; const float* mod = MOD + (size_t)b * 6 * D;
        const f32x4* xr = (const f32x4*)(A.in[I_X] + (size_t)m * D) + F.lane;
#pragma unroll
        for (int j = 0; j < 4; ++j) { const f32x4 v = xr[64 * j]; const f32x4 sh = *((const f32x4*)mod + F.lane + 64 * j), scl = *((const f32x4*)(mod + D) + F.lane + 64 * j);
            const f32x4 h = v * (1.f + scl) + sh;
            *((unsigned long long*)(H + (size_t)m * D) + F.lane + 64 * j) = (unsigned long long)pk2(h.x, h.y) | ((unsigned long long)pk2(h.z, h.w) << 32); }
    }
}
__device__ __forceinline__ void ph_ln1(const Args& A, Frame& F, int l) {
    const int gw = blockIdx.x * NWAVES + F.wave, NGW = gridDim.x * NWAVES;
    const float* MODL = (const float*)(F.ws + WS_MOD) + (size_t)l * BATCH * 6 * D; bf16* H = (bf16*)(F.ws + WS_H); bf16* HG = (bf16*)(F.ws + WS_HG);
    const float* Y = (const float*)(F.ws + WS_Y); const float* xin = (l == 0) ? A.in[I_X] : F.X;
    const float* lg = A.in[I_LNG] + (size_t)(l * 2 + 0) * D; const float* lb = A.in[I_LNB] + (size_t)(l * 2 + 0) * D;
    const bool moe = (l & 1) != 0; const float* RW = A.in[I_RW] + (size_t)(l >> 1) * D * 8;
    unsigned* ROUTE = (unsigned*)(F.ws + WS_ROUTE); unsigned* cnt = (unsigned*)(F.ctl + CW_CNT) + (l >> 1) * 8 * 64;
    for (int m = gw; m < M; m += NGW) { const int b = m >> 11; const float* mod = MODL + (size_t)b * 6 * D;
        f32x4 v[4]; float s = 0.f;
#pragma unroll
        for (int j = 0; j < 4; ++j) { const int q4 = F.lane + 64 * j; const f32x4 xv = *((const f32x4*)(xin + (size_t)m * D) + q4), yv = *((const f32x4*)(Y + (size_t)m * D) + q4), g1 = *((const f32x4*)(mod + 2 * D) + q4);
            v[j] = ALPHA * xv + (1.f + g1) * yv; s += (v[j].x + v[j].y) + (v[j].z + v[j].w); }
        const float mean = wave_sum(s) * (1.f / D); float s2 = 0.f;
#pragma unroll
        for (int j = 0; j < 4; ++j) { v[j] = v[j] - mean; s2 += (v[j].x * v[j].x + v[j].y * v[j].y) + (v[j].z * v[j].z + v[j].w * v[j].w); }
        const float rstd = 1.f / sqrtf(wave_sum(s2) * (1.f / D) + LN_EPS);
        float lgt[8];
#pragma unroll
        for (int e = 0; e < 8; ++e) lgt[e] = 0.f;
        unsigned long long hp[4];
#pragma unroll
        for (int j = 0; j < 4; ++j) { const int q4 = F.lane + 64 * j; const f32x4 gg = *((const f32x4*)lg + q4), bb = *((const f32x4*)lb + q4);
            const f32x4 xn = v[j] * rstd * gg + bb; *((f32x4*)(F.X + (size_t)m * D) + q4) = xn;
            const f32x4 sh = *((const f32x4*)(mod + 3 * D) + q4), scl = *((const f32x4*)(mod + 4 * D) + q4);
            const f32x4 h = xn * (1.f + scl) + sh;
            hp[j] = (unsigned long long)pk2(h.x, h.y) | ((unsigned long long)pk2(h.z, h.w) << 32);
            if (moe) {
#pragma unroll
                for (int k = 0; k < 4; ++k) { const f32x4 r0 = *(const f32x4*)(RW + (size_t)(4 * q4 + k) * 8), r1 = *(const f32x4*)(RW + (size_t)(4 * q4 + k) * 8 + 4); const float hv = h[k];
                    lgt[0] += hv * r0.x; lgt[1] += hv * r0.y; lgt[2] += hv * r0.z; lgt[3] += hv * r0.w; lgt[4] += hv * r1.x; lgt[5] += hv * r1.y; lgt[6] += hv * r1.z; lgt[7] += hv * r1.w; } }
        }
        if (!moe) {
#pragma unroll
            for (int j = 0; j < 4; ++j) *((unsigned long long*)(H + (size_t)m * D) + F.lane + 64 * j) = hp[j];
        } else {
#pragma unroll
            for (int e = 0; e < 8; ++e) lgt[e] = wave_sum(lgt[e]);
            int e1 = 0; float v1 = lgt[0];
#pragma unroll
            for (int e = 1; e < 8; ++e) if (lgt[e] > v1) { v1 = lgt[e]; e1 = e; }
            int e2 = -1; float v2 = 0.f;
#pragma unroll
            for (int e = 0; e < 8; ++e) if (e != e1 && (e2 < 0 || lgt[e] > v2)) { v2 = lgt[e]; e2 = e; }
            const float w2 = 1.f / (1.f + expf(v1 - v2)), w1 = 1.f - w2;
            unsigned p1 = 0, p2 = 0;
            if (F.lane == 0) { p1 = atomicAdd(cnt + e1 * 64, 1u); p2 = atomicAdd(cnt + e2 * 64, 1u);
                v4u r; r.x = (unsigned)e1; r.y = p1; r.z = (unsigned)e2; r.w = p2; *(v4u*)(ROUTE + (size_t)m * 8) = r; ROUTE[(size_t)m * 8 + 4] = __float_as_uint(w1); ROUTE[(size_t)m * 8 + 5] = __float_as_uint(w2); }
            p1 = __shfl(p1, 0); p2 = __shfl(p2, 0);
            bf16* d1 = HG + ((size_t)e1 * ECAP + p1) * D; bf16* d2 = HG + ((size_t)e2 * ECAP + p2) * D;
#pragma unroll
            for (int j = 0; j < 4; ++j) { *((unsigned long long*)d1 + F.lane + 64 * j) = hp[j]; *((unsigned long long*)d2 + F.lane + 64 * j) = hp[j]; }
        }
    }
}
__device__ __forceinline__ void ph_ln2(const Args& A, Frame& F, int l) {
    const int gw = blockIdx.x * NWAVES + F.wave, NGW = gridDim.x * NWAVES;
    const float* MODL = (const float*)(F.ws + WS_MOD) + (size_t)l * BATCH * 6 * D; bf16* H = (bf16*)(F.ws + WS_H);
    const float* Y = (const float*)(F.ws + WS_Y); const float* Y2 = (const float*)(F.ws + WS_Y2);
    const float* lg = A.in[I_LNG] + (size_t)(l * 2 + 1) * D; const float* lb = A.in[I_LNB] + (size_t)(l * 2 + 1) * D;
    const bool moe = (l & 1) != 0;
    const unsigned* ROUTE = (const unsigned*)(F.ws + WS_ROUTE); const unsigned* cnt = (const unsigned*)(F.ctl + CW_CNT) + (l >> 1) * 8 * 64;
    int P[8];
    { int p = 0;
#pragma unroll
      for (int e = 0; e < 8; ++e) { P[e] = p; p += moe ? (((int)cnt[e * 64] + 255) >> 8) : 0; } }
    for (int m = gw; m < M; m += NGW) { const int b = m >> 11; const float* mod = MODL + (size_t)b * 6 * D;
        const float* f1 = Y + (size_t)m * D; const float* f2 = f1; float w1 = 1.f, w2 = 0.f;
        if (moe) { const v4u r = *(const v4u*)(ROUTE + (size_t)m * 8); w1 = __uint_as_float(ROUTE[(size_t)m * 8 + 4]); w2 = __uint_as_float(ROUTE[(size_t)m * 8 + 5]);
            int b1 = 0, b2 = 0;
#pragma unroll
            for (int e = 0; e < 8; ++e) { if ((int)r.x == e) b1 = P[e]; if ((int)r.z == e) b2 = P[e]; }
            f1 = Y2 + ((size_t)b1 * 256 + r.y) * D; f2 = Y2 + ((size_t)b2 * 256 + r.w) * D; }
        f32x4 v[4]; float s = 0.f;
#pragma unroll
        for (int j = 0; j < 4; ++j) { const int q4 = F.lane + 64 * j; const f32x4 xv = *((const f32x4*)(F.X + (size_t)m * D) + q4), g2 = *((const f32x4*)(mod + 5 * D) + q4);
            f32x4 fv = *((const f32x4*)f1 + q4); if (moe) fv = w1 * fv + w2 * *((const f32x4*)f2 + q4);
            v[j] = ALPHA * xv + (1.f + g2) * fv; s += (v[j].x + v[j].y) + (v[j].z + v[j].w); }
        const float mean = wave_sum(s) * (1.f / D); float s2 = 0.f;
#pragma unroll
        for (int j = 0; j < 4; ++j) { v[j] = v[j] - mean; s2 += (v[j].x * v[j].x + v[j].y * v[j].y) + (v[j].z * v[j].z + v[j].w * v[j].w); }
        const float rstd = 1.f / sqrtf(wave_sum(s2) * (1.f / D) + LN_EPS);
        const float* modn = mod + (size_t)BATCH * 6 * D;
#pragma unroll
        for (int j = 0; j < 4; ++j) { const int q4 = F.lane + 64 * j; const f32x4 gg = *((const f32x4*)lg + q4), bb = *((const f32x4*)lb + q4);
            const f32x4 xn = v[j] * rstd * gg + bb; *((f32x4*)(F.X + (size_t)m * D) + q4) = xn;
            if (l + 1 < DEPTH) { const f32x4 sh = *((const f32x4*)modn + q4), scl = *((const f32x4*)(modn + D) + q4); const f32x4 h = xn * (1.f + scl) + sh;
                *((unsigned long long*)(H + (size_t)m * D) + q4) = (unsigned long long)pk2(h.x, h.y) | ((unsigned long long)pk2(h.z, h.w) << 32); } }
    }
}

__device__ __forceinline__ float gelu_tanh_f(float x) { return 0.5f * x * (1.f + tanhf(0.7978845608028654f * (x + 0.044715f * x * x * x))); }
__device__ __forceinline__ void ph_compress_naive(const Args& A, Frame& F, int l) {
    const int gw = blockIdx.x * NWAVES + F.wave, NGW = gridDim.x * NWAVES;
    const bf16* U = (const bf16*)(F.ws + WS_U);
    for (int it = gw; it < 2 * BATCH * NCP * 2; it += NGW) {
        const int g = it & 1, n = (it >> 1) & 127, b = (it >> 8) & 15, kv = it >> 12;
        bf16* OUT = (bf16*)(F.ws + (kv ? WS_VCMP : WS_KCMP)) + ((size_t)(b * NCP + n) * 2 + g) * 64;
        float out = 0.f;
        if (n < NCMP) {
            const float* w1 = A.in[I_CW1] + (size_t)(l * 2 + kv) * 2048 * 64; const float* pos = A.in[I_CPOS] + (size_t)(l * 2 + kv) * 2048;
            const float* w2 = A.in[I_CW2] + (size_t)(l * 2 + kv) * 64 * 64;
            const bf16* ub = U + ((size_t)b * T + 16 * n) * NU + (kv ? UVC : UKC) + g * 64;
            float pre = 0.f;
            for (int kk = 0; kk < 2048; ++kk) { const float a = bf2f(ub[(size_t)(kk >> 6) * NU + (kk & 63)]) + pos[kk]; pre += a * w1[(size_t)kk * 64 + F.lane]; }
            const float ge = gelu_tanh_f(pre);
            for (int j = 0; j < 64; ++j) out += __shfl(ge, j) * w2[j * 64 + F.lane];
        }
        OUT[F.lane] = (bf16)f2bf(out);
    }
}
__device__ __forceinline__ void ph_conv_naive(const Args& A, Frame& F, int l) {
    LAS float* glu = (LAS float*)F.lds;
    LAS float* red = (LAS float*)(F.lds + 46 * 512 * 4);
    const bf16* U = (const bf16*)(F.ws + WS_U); bf16* CAT = (bf16*)(F.ws + WS_CAT);
    const int c = F.tid;
    float w[31];
#pragma unroll
    for (int k = 0; k < 31; ++k) w[k] = A.in[I_CVW][(size_t)(l * 31 + k) * 512 + c];
    const float cb = A.in[I_CVB][l * 512 + c], lg = A.in[I_CVG][l * 512 + c], lb = A.in[I_CVBE][l * 512 + c];
    for (int it = blockIdx.x; it < M / 16; it += gridDim.x) {
        const int b = it >> 7, t0 = (it & 127) * 16;
        for (int rr = 0; rr < 46; ++rr) { const int tt = t0 - 30 + rr; float v = 0.f;
            if (tt >= 0) { const bf16* ur = U + ((size_t)b * T + tt) * NU; v = bf2f(ur[UCA + c]) * sigmoid_f(bf2f(ur[UCG + c])); }
            glu[rr * 512 + c] = v; }
        LDS_WAIT();
        float y[16];
#pragma unroll
        for (int i = 0; i < 16; ++i) { float a = cb;
#pragma unroll
            for (int k = 0; k < 31; ++k) a += w[k] * glu[(i + k) * 512 + c];
            y[i] = a; }
#pragma unroll
        for (int i = 0; i < 16; ++i) { const float s = wave_sum(y[i]); if (F.lane == 0) red[i * 8 + F.wave] = s; }
        __syncthreads();
        float mean[16];
#pragma unroll
        for (int i = 0; i < 16; ++i) { float s = 0.f;
#pragma unroll
            for (int k = 0; k < 8; ++k) s += red[i * 8 + k];
            mean[i] = s * (1.f / 512.f); }
        __syncthreads();
#pragma unroll
        for (int i = 0; i < 16; ++i) { y[i] -= mean[i]; const float s = wave_sum(y[i] * y[i]); if (F.lane == 0) red[i * 8 + F.wave] = s; }
        __syncthreads();
#pragma unroll
        for (int i = 0; i < 16; ++i) { float s = 0.f;
#pragma unroll
            for (int k = 0; k < 8; ++k) s += red[i * 8 + k];
            const float rstd = 1.f / sqrtf(s * (1.f / 512.f) + LN_EPS); const float z = y[i] * rstd * lg + lb;
            CAT[((size_t)b * T + t0 + i) * D + 512 + c] = (bf16)f2bf(z * sigmoid_f(z)); }
        __syncthreads();
    }
}
__device__ __forceinline__ float dot64(const v4u (&qp)[8], const bf16* kp) {
    float s = 0.f;
#pragma unroll
    for (int c = 0; c < 8; ++c) { const v4u kv = *(const v4u*)(kp + 8 * c);
        s += bflo(qp[c].x) * bflo(kv.x) + bfhi(qp[c].x) * bfhi(kv.x); s += bflo(qp[c].y) * bflo(kv.y) + bfhi(qp[c].y) * bfhi(kv.y);
        s += bflo(qp[c].z) * bflo(kv.z) + bfhi(qp[c].z) * bfhi(kv.z); s += bflo(qp[c].w) * bflo(kv.w) + bfhi(qp[c].w) * bfhi(kv.w); }
    return s;
}
__device__ __forceinline__ void axpy64(float (&O)[64], float e, const bf16* vp) {
#pragma unroll
    for (int c = 0; c < 8; ++c) { const v4u vv = *(const v4u*)(vp + 8 * c);
        O[8 * c + 0] += e * bflo(vv.x); O[8 * c + 1] += e * bfhi(vv.x); O[8 * c + 2] += e * bflo(vv.y); O[8 * c + 3] += e * bfhi(vv.y);
        O[8 * c + 4] += e * bflo(vv.z); O[8 * c + 5] += e * bfhi(vv.z); O[8 * c + 6] += e * bflo(vv.w); O[8 * c + 7] += e * bfhi(vv.w); }
}
__device__ __forceinline__ void ph_attn_naive(const Args& A, Frame& F, int l) {
    (void)l;
    LAS float* impH = (LAS float*)F.lds;
    LAS unsigned* selm = (LAS unsigned*)(F.lds + 32768);
    LAS float* WOUT = (LAS float*)(F.lds + 32768 + 256);
    const bf16* U = (const bf16*)(F.ws + WS_U); bf16* CAT = (bf16*)(F.ws + WS_CAT);
    const bf16* KC = (const bf16*)(F.ws + WS_KCMP); const bf16* VC = (const bf16*)(F.ws + WS_VCMP);
    const float* TBL = (const float*)(F.ws + WS_TBL);
    const float NEG = -INFINITY;
    for (int it = blockIdx.x; it < BATCH * 2 * 32; it += gridDim.x) {
        const int tb = it & 31, g = (it >> 5) & 1, b = it >> 6;
        const int t0 = tb * 64, i = F.tid & 63, r = F.wave & 3, t = t0 + i, h = g * 4 + r;
        const size_t m = (size_t)b * T + t;
        const bf16* urow = U + m * NU;
        v4u qp[8];
#pragma unroll
        for (int c = 0; c < 8; ++c) qp[c] = *(const v4u*)(urow + UQ + h * 64 + 8 * c);
        const float* tb_h = TBL + h * 128;
        const float gl0 = sigmoid_f(bf2f(urow[UGL + g * 12 + r * 3 + 0])), gl1 = sigmoid_f(bf2f(urow[UGL + g * 12 + r * 3 + 1])), gl2 = sigmoid_f(bf2f(urow[UGL + g * 12 + r * 3 + 2]));
        LAS float* acc = WOUT + (r * 64 + i) * 64;
        float O[64]; float wsc = 0.f;
        if (F.wave < 4) {
            float mx = NEG;
            for (int n = 0; n < NCMP; ++n) { const int dist = t - (16 * n + 31);
                if (dist >= 0) { const float s = dot64(qp, KC + ((size_t)(b * NCP + n) * 2 + g) * 64) + tb_h[dist < 127 ? dist : 127]; mx = fmaxf(mx, s); } }
            float ls = 0.f;
#pragma unroll
            for (int d = 0; d < 64; ++d) O[d] = 0.f;
            LAS float* imp = impH + (r * 64 + i) * 32;
            for (int j = 0; j < 32; ++j) imp[j] = 0.f;
            for (int n = 0; n < NCMP; ++n) { const int dist = t - (16 * n + 31);
                if (dist >= 0) { const float s = dot64(qp, KC + ((size_t)(b * NCP + n) * 2 + g) * 64) + tb_h[dist < 127 ? dist : 127];
                    const float e = exp2f(s - mx); ls += e; axpy64(O, e, VC + ((size_t)(b * NCP + n) * 2 + g) * 64);
                    imp[n >> 2] += e; if ((n & 3) == 3) imp[(n + 1) >> 2] += e; } }
            const float invl = ls > 0.f ? 1.f / ls : 0.f;
            for (int j = 0; j < 32; ++j) imp[j] *= invl;
#pragma unroll
            for (int d = 0; d < 64; ++d) acc[d] = gl0 * invl * O[d];
        } else {
            float mx = NEG, ls = 0.f;
#pragma unroll
            for (int d = 0; d < 64; ++d) O[d] = 0.f;
            const int p0 = t0 - 511 > 0 ? t0 - 511 : 0;
            for (int pos = p0; pos < t0 + 64; ++pos) { const int dist = t - pos;
                if (dist >= 0 && dist < 512) { const bf16* kr = U + ((size_t)b * T + pos) * NU;
                    const float s = dot64(qp, kr + UKW + g * 64) + tb_h[dist < 127 ? dist : 127];
                    if (s > mx) { const float sc = exp2f(mx - s); ls *= sc;
#pragma unroll
                        for (int d = 0; d < 64; ++d) O[d] *= sc;
                        mx = s; }
                    const float e = exp2f(s - mx); ls += e; axpy64(O, e, kr + UVW + g * 64); } }
            wsc = gl2 / ls;
        }
        __syncthreads();
        if (F.wave >= 4) {
#pragma unroll
            for (int d = 0; d < 64; ++d) acc[d] += wsc * O[d];
        }
        if (F.wave == 0) {
            LAS float* sc = impH + i * 32;
            for (int j = 0; j < 32; ++j) { float s = impH[(0 * 64 + i) * 32 + j] + impH[(1 * 64 + i) * 32 + j] + impH[(2 * 64 + i) * 32 + j] + impH[(3 * 64 + i) * 32 + j];
                if (j > tb) s = NEG; else if (j == 0 || j == tb || j == tb - 1) s = INFINITY;
                sc[j] = s; }
            unsigned mask = 0u;
            for (int k = 0; k < 8; ++k) { int best = -1; float bv = 0.f;
                for (int j = 0; j < 32; ++j) if (!((mask >> j) & 1u)) { const float v = sc[j]; if (best < 0 || v > bv) { best = j; bv = v; } }
                mask |= 1u << best; }
            mask &= (tb == 31) ? 0xffffffffu : ((1u << (tb + 1)) - 1u);
            selm[i] = mask;
        }
        __syncthreads();
        if (F.wave < 4) {
            const unsigned mask = selm[i];
            float mx = NEG, ls = 0.f;
#pragma unroll
            for (int d = 0; d < 64; ++d) O[d] = 0.f;
            for (int j = 0; j <= tb; ++j) { const bool sel = (mask >> j) & 1u;
                if (!__any(sel)) continue;
                for (int kk = 0; kk < 64; ++kk) { const int pos = 64 * j + kk, dist = t - pos;
                    if (sel && dist >= 0) { const bf16* kr = U + ((size_t)b * T + pos) * NU;
                        const float s = dot64(qp, kr + UKS + g * 64) + tb_h[dist < 127 ? dist : 127];
                        if (s > mx) { const float sc = exp2f(mx - s); ls *= sc;
#pragma unroll
                            for (int d = 0; d < 64; ++d) O[d] *= sc;
                            mx = s; }
                        const float e = exp2f(s - mx); ls += e; axpy64(O, e, kr + UVS + g * 64); } } }
            const float sc = gl1 / ls;
            bf16* orow = CAT + m * D + h * 64;
#pragma unroll
            for (int c = 0; c < 8; ++c) { float o[8];
#pragma unroll
                for (int k = 0; k < 8; ++k) o[k] = acc[8 * c + k] + sc * O[8 * c + k];
                v4u w; w.x = pk2(o[0], o[1]); w.y = pk2(o[2], o[3]); w.z = pk2(o[4], o[5]); w.w = pk2(o[6], o[7]); *(v4u*)(orow + 8 * c) = w; }
        }
        __syncthreads();
    }
}

constexpr int NSTEP_PRO = 2, NSTEP_LAYER = 8, NSTEPS = NSTEP_PRO + DEPTH * NSTEP_LAYER;
__global__ void __launch_bounds__(NWAVES * 64, 2) fwd(Args args) {
    extern __shared__ __attribute__((aligned(16))) unsigned char lds[];
    Frame F;
    F.lds = (LAS unsigned char*)lds;
    F.MISC = (volatile LAS unsigned*)(F.lds + MISC_OFF);
    F.tid = threadIdx.x; F.lane = F.tid & 63; F.wave = __builtin_amdgcn_readfirstlane(F.tid >> 6);
    F.G = gridDim.x;
    F.ws = args.ws; F.ctl = (gu32*)(args.ws + WS_CTL); F.X = args.out;
    for (int u = F.tid; u < (LDS_BYTES - LDSCTL_OFF) / 4; u += NWAVES * 64) ((LAS unsigned*)(F.lds + LDSCTL_OFF))[u] = 0u;
    __syncthreads();
    const int lo = args.ph_lo, hi = args.ph_hi;
    XcdBarrier bar; bar.bar = (unsigned*)(F.ctl + CW_BAR); bar.x = 0; bar.st = nullptr;
    if (hi - lo > 1) bar = xcd_barrier_post((unsigned*)(F.ctl + CW_BAR), F.MISC + 8);
#define IN(k) (lo <= (k) && (k) < hi)
#define SEAM(k) do { if (IN(k) && IN((k) + 1)) xcd_barrier(bar); } while (0)
#define FRESH() do { int t_ = threadIdx.x; asm volatile("" : "+v"(t_)); F.tid = t_; F.lane = t_ & 63; F.wave = __builtin_amdgcn_readfirstlane(t_ >> 6); } while (0)

    if (IN(0)) { ph_ada(args, F); ph_tbl(args, F); ph_cvt(args, F, 0); }
    SEAM(0);
    if (IN(1)) { ph_mod0(args, F); }
    SEAM(1);
    for (int l = 0; l < DEPTH; ++l) {
        const int base = NSTEP_PRO + l * NSTEP_LAYER; const bool moe = (l & 1) != 0;
        unsigned* cnt = (unsigned*)(F.ctl + CW_CNT) + (l >> 1) * 8 * 64;
        if (IN(base + 0)) {
            pg8::Gemm g{(const pg8::bf16_t*)(F.ws + WS_H), (const pg8::bf16_t*)(F.ws + WS_WIN), M, NU, D}; pg8::StaticOrder S; S.init(M, NU, F.G, (int)blockIdx.x);
            pg8::EpiU E{(pg8::bf16_t*)(F.ws + WS_U), NU, 2, C2};
            pg8::gemm_phase<pg8::EpiU, pg8::StaticOrder, true, true>(F.lds + RING_OFF, g, S, E);
        }
        SEAM(base + 0);
        if (IN(base + 1)) { FRESH(); ph_compress_naive(args, F, l); FRESH(); ph_conv_naive(args, F, l); }
        SEAM(base + 1);
        if (IN(base + 2)) { FRESH(); ph_attn_naive(args, F, l); }
        SEAM(base + 2);
        if (IN(base + 3)) {
            pg8::Gemm g{(const pg8::bf16_t*)(F.ws + WS_CAT), (const pg8::bf16_t*)(F.ws + WS_WO), M, D, D}; pg8::StaticOrder S; S.init(M, D, F.G, (int)blockIdx.x);
            pg8::EpiF32 E{(float*)(F.ws + WS_Y), D, 4};
            pg8::gemm_phase<pg8::EpiF32, pg8::StaticOrder, true, true>(F.lds + RING_OFF, g, S, E);
        }
        SEAM(base + 3);
        if (IN(base + 4)) { FRESH(); ph_ln1(args, F, l); }
        SEAM(base + 4);
        if (IN(base + 5)) {
            pg8::MoeOrder S; if (moe) S.init_moe(cnt, 2 * FFE / 256, F.G, (int)blockIdx.x, 1); else S.init_dense(M / 256, 2 * FF / 256, F.G, (int)blockIdx.x);
            pg8::Gemm g{(const pg8::bf16_t*)(F.ws + (moe ? WS_HG : WS_H)), (const pg8::bf16_t*)(F.ws + WS_W1), M, 0, D};
            pg8::EpiSwiGLU E{(pg8::bf16_t*)(F.ws + WS_HID), moe ? FFE : FF, moe ? 2 * FFE / 256 : 2 * FF / 256};
            pg8::gemm_phase<pg8::EpiSwiGLU, pg8::MoeOrder, true, true>(F.lds + RING_OFF, g, S, E);
        }
        SEAM(base + 5);
        if (IN(base + 6)) {
            pg8::MoeOrder S; if (moe) S.init_moe(cnt, 4, F.G, (int)blockIdx.x, 0); else S.init_dense(M / 256, 4, F.G, (int)blockIdx.x);
            pg8::Gemm g{(const pg8::bf16_t*)(F.ws + WS_HID), (const pg8::bf16_t*)(F.ws + WS_W2), M, D, moe ? FFE : FF};
            pg8::EpiF32 E{(float*)(F.ws + (moe ? WS_Y2 : WS_Y)), D, 4};
            pg8::gemm_phase<pg8::EpiF32, pg8::MoeOrder, true, true>(F.lds + RING_OFF, g, S, E);
        }
        SEAM(base + 6);
        if (IN(base + 7)) { FRESH(); ph_ln2(args, F, l); FRESH(); if (l + 1 < DEPTH) ph_cvt(args, F, l + 1); }
        SEAM(base + 7);
    }
#undef IN
#undef SEAM
}

extern "C" void kernel_launch(void* const* d_in, const int* in_sizes, int n_in, void* d_out, int out_size, void* d_ws, size_t ws_size, hipStream_t stream) {
    static int grid = 0;
    if (grid == 0) {
        if (n_in != 21 || out_size != M * D || ws_size < WS_END) { fprintf(stderr, "kernel_launch: unexpected shapes (n_in %d out %d ws %zu)\n", n_in, out_size, ws_size); grid = -1; return; }
        int dev = 0, cus = 0, per_cu = 0;
        if (hipGetDevice(&dev) != hipSuccess || hipDeviceGetAttribute(&cus, hipDeviceAttributeMultiprocessorCount, dev) != hipSuccess) { grid = -1; return; }
        if (hipFuncSetAttribute((const void*)fwd, hipFuncAttributeMaxDynamicSharedMemorySize, LDS_BYTES) != hipSuccess) { fprintf(stderr, "kernel_launch: hipFuncSetAttribute failed\n"); grid = -1; return; }
        if (hipOccupancyMaxActiveBlocksPerMultiprocessor(&per_cu, (const void*)fwd, NWAVES * 64, LDS_BYTES) != hipSuccess || per_cu < 1) fprintf(stderr, "kernel_launch: occupancy query reports %d\n", per_cu);
        (void)hipGetLastError();
        grid = cus;
    }
    if (grid < 0) return;
    (void)in_sizes;
    if (hipMemsetAsync((char*)d_ws + WS_CTL, 0, CTL_ZERO_BYTES, stream) != hipSuccess) return;
    Args a{};
    for (int i = 0; i < 21; ++i) a.in[i] = (const float*)d_in[i];
    a.out = (float*)d_out; a.ws = (unsigned char*)d_ws;
#ifndef MK_ONE_LAUNCH
    for (int s = 0; s < NSTEPS; ++s) { a.ph_lo = s; a.ph_hi = s + 1; hipLaunchKernelGGL(fwd, dim3(grid), dim3(NWAVES * 64), LDS_BYTES, stream, a); }
#else
    a.ph_lo = 0; a.ph_hi = NSTEPS; hipLaunchKernelGGL(fwd, dim3(grid), dim3(NWAVES * 64), LDS_BYTES, stream, a);
#endif
}
```

```cpp
#define MK_ONE_LAUNCH 1
#include <hip/hip_runtime.h>
#include <cstdio>
#include <cstdint>
#include <cmath>
namespace pg8 {
#define PG8_LAS __attribute__((address_space(3)))
typedef unsigned short bf16_t;
typedef short bf16x8 __attribute__((ext_vector_type(8)));
typedef float f32x4 __attribute__((ext_vector_type(4)));
typedef unsigned u32x4 __attribute__((ext_vector_type(4)));
constexpr int BM = 256, BK = 64, HALF = 128, HTB = HALF * BK * 2  , STAGE_BYTES = 8 * HTB, NXCD = 8, WGM = 8;

__host__ __device__ __forceinline__ int lds_byte(int r, int c) { const int st = (r >> 4) * 2 + (c >> 5), rr = r & 15, cc = c & 31, ob = rr * 64 + cc * 2; return st * 1024 + (ob ^ (((ob >> 9) & 1) << 5)); }
__host__ __device__ __forceinline__ void stage_rc(int b, int& R, int& C) { const int st = b / 1024, sb = b % 1024, swz = sb ^ (((sb >> 9) & 1) << 5); R = (st >> 1) * 16 + swz / 64; C = (st & 1) * 32 + (swz % 64) / 2; }
__host__ __device__ __forceinline__ int perm32(int rho) { const int n = rho >> 4, i = rho & 15; return 8 * (i >> 2) + 4 * n + (i & 3); }

struct Unit { int pm, pn, pa; };
struct Gemm { const bf16_t* A; const bf16_t* Bt; int M, N, K; int ldk; };

struct StaticOrder {
    int nM, nN, nwg, G, c;
    __host__ __device__ void init(int M, int N, int G_, int c_) { nM = M / BM; nN = N / BM; nwg = nM * nN; G = G_; c = c_; }
    __host__ __device__ bool next(int i, Unit& u) const {
        const long L = (long)i * G + c; if (L >= nwg) return false;
        int wgid = (int)L; { const int q = nwg / NXCD, r = nwg % NXCD, xcd = wgid % NXCD, off = wgid / NXCD; wgid = (xcd < r ? xcd * (q + 1) : r * (q + 1) + (xcd - r) * q) + off; }
        const int nig = WGM * nN, gid = wgid / nig, fm = gid * WGM, gsz = (nM - fm) < WGM ? (nM - fm) : WGM;
        u.pm = fm + ((wgid % nig) % gsz); u.pn = (wgid % nig) / gsz; u.pa = u.pm; return true;
    }
    __device__ __forceinline__ void a_ready(const Unit&) const {}
    __device__ __forceinline__ void done(const Unit&) const {}
};


__device__ __forceinline__ unsigned cvt_pk_bf16(float lo, float hi) { unsigned r; asm volatile("v_cvt_pk_bf16_f32 %0, %1, %2" : "=v"(r) : "v"(lo), "v"(hi)); return r; }

struct EpiU {
    static constexpr bool PERM = true, AFTER_DRAIN = false;
    bf16_t* O; int ldc; int nscale; float scale0, scale1;
    __device__ __forceinline__ void operator()(const f32x4 (&acc)[2][2][4][2], const Unit& u, int wr, int wc, int fr, int fq) const {
        const int row0 = u.pm * BM + wr * 64 + fr; const int col0 = u.pn * BM + wc * 32 + 8 * fq;
        const float sc = (u.pn < nscale) ? scale0 : scale1;
#pragma unroll
        for (int ai = 0; ai < 2; ++ai)
#pragma unroll
            for (int m = 0; m < 4; ++m) { bf16_t* rowp = O + (size_t)(row0 + ai * HALF + m * 16) * ldc + col0;
#pragma unroll
                for (int bj = 0; bj < 2; ++bj) { f32x4 v0 = acc[ai][bj][m][0] * sc, v1 = acc[ai][bj][m][1] * sc;
                    u32x4 w; w.x = cvt_pk_bf16(v0[0], v0[1]); w.y = cvt_pk_bf16(v0[2], v0[3]); w.z = cvt_pk_bf16(v1[0], v1[1]); w.w = cvt_pk_bf16(v1[2], v1[3]);
                    *(u32x4*)(rowp + bj * HALF) = w; } }
    }
};
__device__ __forceinline__ float silu_f(float x) { return x * __builtin_amdgcn_rcpf(1.f + __builtin_amdgcn_exp2f(-1.4426950408889634f * x)); }
struct EpiSwiGLU {
    static constexpr bool PERM = true, AFTER_DRAIN = false;
    bf16_t* O; int ldo; int nNl;
    __device__ __forceinline__ void operator()(const f32x4 (&acc)[2][2][4][2], const Unit& u, int wr, int wc, int fr, int fq) const {
        const int row0 = u.pm * BM + wr * 64 + fr; const int hc0 = (u.pn % nNl) * HALF + wc * 32 + 8 * fq;
#pragma unroll
        for (int ai = 0; ai < 2; ++ai)
#pragma unroll
            for (int m = 0; m < 4; ++m) { bf16_t* rowp = O + (size_t)(row0 + ai * HALF + m * 16) * ldo + hc0;
                const f32x4 g0 = acc[ai][0][m][0], g1 = acc[ai][0][m][1], u0 = acc[ai][1][m][0], u1 = acc[ai][1][m][1];
                u32x4 w; w.x = cvt_pk_bf16(silu_f(g0[0]) * u0[0], silu_f(g0[1]) * u0[1]); w.y = cvt_pk_bf16(silu_f(g0[2]) * u0[2], silu_f(g0[3]) * u0[3]);
                w.z = cvt_pk_bf16(silu_f(g1[0]) * u1[0], silu_f(g1[1]) * u1[1]); w.w = cvt_pk_bf16(silu_f(g1[2]) * u1[2], silu_f(g1[3]) * u1[3]);
                *(u32x4*)rowp = w; }
    }
};
__device__ __forceinline__ f32x4 swiglu4(const f32x4 g, const f32x4 u, const float s) {
    const f32x4 t = g * (-1.4426950408889634f * s);
    f32x4 e; e[0] = __builtin_amdgcn_exp2f(t[0]); e[1] = __builtin_amdgcn_exp2f(t[1]); e[2] = __builtin_amdgcn_exp2f(t[2]); e[3] = __builtin_amdgcn_exp2f(t[3]);
    const f32x4 d = e + 1.f;
    f32x4 r; r[0] = __builtin_amdgcn_rcpf(d[0]); r[1] = __builtin_amdgcn_rcpf(d[1]); r[2] = __builtin_amdgcn_rcpf(d[2]); r[3] = __builtin_amdgcn_rcpf(d[3]);
    return (g * u) * (r * (s * s));
}
struct EpiSwiGLU8 {
    static constexpr bool PERM = true, AFTER_DRAIN = false;
    unsigned char* O; int ldo; int nNl; float s;
    __device__ __forceinline__ void operator()(const f32x4 (&acc)[2][2][4][2], const Unit& u, int wr, int wc, int fr, int fq) const {
        const int row0 = u.pm * BM + wr * 64 + fr; const int hc0 = (u.pn % nNl) * HALF + wc * 32 + 8 * fq;
        typedef unsigned u32x2 __attribute__((ext_vector_type(2)));
#pragma unroll
        for (int ai = 0; ai < 2; ++ai)
#pragma unroll
            for (int m = 0; m < 4; ++m) { unsigned char* rowp = O + (size_t)(row0 + ai * HALF + m * 16) * ldo + hc0;
                const f32x4 h0 = swiglu4(acc[ai][0][m][0], acc[ai][1][m][0], s), h1 = swiglu4(acc[ai][0][m][1], acc[ai][1][m][1], s);
                int p0 = __builtin_amdgcn_cvt_pk_fp8_f32(h0[0], h0[1], 0, false); p0 = __builtin_amdgcn_cvt_pk_fp8_f32(h0[2], h0[3], p0, true);
                int p1 = __builtin_amdgcn_cvt_pk_fp8_f32(h1[0], h1[1], 0, false); p1 = __builtin_amdgcn_cvt_pk_fp8_f32(h1[2], h1[3], p1, true);
                u32x2 w; w.x = (unsigned)p0; w.y = (unsigned)p1; *(u32x2*)rowp = w; __builtin_amdgcn_sched_barrier(0); }
    }
};
struct EpiBf {
    static constexpr bool PERM = true, AFTER_DRAIN = false;
    bf16_t* O; int ldc; int nNl; float s;
    __device__ __forceinline__ void operator()(const f32x4 (&acc)[2][2][4][2], const Unit& u, int wr, int wc, int fr, int fq) const {
        const int row0 = u.pm * BM + wr * 64 + fr; const int col0 = (u.pn % nNl) * BM + wc * 32 + 8 * fq;
#pragma unroll
        for (int ai = 0; ai < 2; ++ai)
#pragma unroll
            for (int m = 0; m < 4; ++m) { bf16_t* rowp = O + (size_t)(row0 + ai * HALF + m * 16) * ldc + col0;
#pragma unroll
                for (int bj = 0; bj < 2; ++bj) { const f32x4 v0 = acc[ai][bj][m][0] * s, v1 = acc[ai][bj][m][1] * s;
                    u32x4 w; w.x = cvt_pk_bf16(v0[0], v0[1]); w.y = cvt_pk_bf16(v0[2], v0[3]); w.z = cvt_pk_bf16(v1[0], v1[1]); w.w = cvt_pk_bf16(v1[2], v1[3]);
                    *(u32x4*)(rowp + bj * HALF) = w; } }
    }
};
struct EpiF32 {
    static constexpr bool PERM = false, AFTER_DRAIN = false;
    float* O; int ldc; int nNl;
    __device__ __forceinline__ void operator()(const f32x4 (&acc)[2][2][4][2], const Unit& u, int wr, int wc, int fr, int fq) const {
        const int row0 = u.pm * BM + wr * 64 + fr; const int col0 = (u.pn % nNl) * BM + wc * 32 + 4 * fq;
#pragma unroll
        for (int ai = 0; ai < 2; ++ai)
#pragma unroll
            for (int m = 0; m < 4; ++m) { float* rowp = O + (size_t)(row0 + ai * HALF + m * 16) * ldc + col0;
#pragma unroll
                for (int bj = 0; bj < 2; ++bj)
#pragma unroll
                    for (int n = 0; n < 2; ++n) *(f32x4*)(rowp + bj * HALF + n * 16) = acc[ai][bj][m][n]; }
    }
};
struct EpiF32P {
    static constexpr bool PERM = true, AFTER_DRAIN = false;
    float* O; int ldc;
    __device__ __forceinline__ void operator()(const f32x4 (&acc)[2][2][4][2], const Unit& u, int wr, int wc, int fr, int fq) const {
        const int row0 = u.pm * BM + wr * 64 + fr; const int col0 = wc * 32 + 8 * fq;
#pragma unroll
        for (int ai = 0; ai < 2; ++ai)
#pragma unroll
            for (int m = 0; m < 4; ++m) { float* rowp = O + (size_t)(row0 + ai * HALF + m * 16) * ldc + col0;
#pragma unroll
                for (int bj = 0; bj < 2; ++bj) { *(f32x4*)(rowp + bj * HALF) = acc[ai][bj][m][0]; *(f32x4*)(rowp + bj * HALF + 4) = acc[ai][bj][m][1]; } }
    }
};
struct OneUnit {
    Unit u; int have;
    __device__ __forceinline__ bool next(int i, Unit& o) const { if (i != 0 || !have) return false; o = u; return true; }
    __device__ __forceinline__ void a_ready(const Unit&) const {}
    __device__ __forceinline__ void done(const Unit&) const {}
};
struct MoeOrder {
    StaticOrder so; int P1, P2, P3, P4, P5, P6, P7; int nNl, a_sparse;
    __device__ __forceinline__ void init_dense(int nM, int nNl_, int G, int c) { so.nM = nM; so.nN = nNl_; so.nwg = nM * nNl_; so.G = G; so.c = c; nNl = nNl_; a_sparse = 0; P1 = P2 = P3 = P4 = P5 = P6 = P7 = nM; }
    __device__ __forceinline__ void init_moe(const unsigned* cnt  , int nNl_, int G, int c, int a_sparse_) {
        int p = 0; p += ((int)cnt[0] + 255) >> 8; P1 = p; p += ((int)cnt[64] + 255) >> 8; P2 = p; p += ((int)cnt[128] + 255) >> 8; P3 = p; p += ((int)cnt[192] + 255) >> 8; P4 = p;
        p += ((int)cnt[256] + 255) >> 8; P5 = p; p += ((int)cnt[320] + 255) >> 8; P6 = p; p += ((int)cnt[384] + 255) >> 8; P7 = p; p += ((int)cnt[448] + 255) >> 8;
        so.nM = p; so.nN = nNl_; so.nwg = p * nNl_; so.G = G; so.c = c; nNl = nNl_; a_sparse = a_sparse_;
    }
    __device__ __forceinline__ bool next(int i, Unit& u) const {
        if (!so.next(i, u)) return false;
        int e = 0, pe = 0;
        if (u.pm >= P1) { e = 1; pe = P1; } if (u.pm >= P2) { e = 2; pe = P2; } if (u.pm >= P3) { e = 3; pe = P3; } if (u.pm >= P4) { e = 4; pe = P4; }
        if (u.pm >= P5) { e = 5; pe = P5; } if (u.pm >= P6) { e = 6; pe = P6; } if (u.pm >= P7) { e = 7; pe = P7; }
        u.pa = a_sparse ? e * 128 + (u.pm - pe) : u.pm; u.pn = e * nNl + u.pn; return true;
    }
    __device__ __forceinline__ void unit_of(int wgid, Unit& u) const {
        const int nig = WGM * so.nN, gid = wgid / nig, fm = gid * WGM, gsz = (so.nM - fm) < WGM ? (so.nM - fm) : WGM;
        u.pm = fm + ((wgid % nig) % gsz); u.pn = (wgid % nig) / gsz;
        int e = 0, pe = 0;
        if (u.pm >= P1) { e = 1; pe = P1; } if (u.pm >= P2) { e = 2; pe = P2; } if (u.pm >= P3) { e = 3; pe = P3; } if (u.pm >= P4) { e = 4; pe = P4; }
        if (u.pm >= P5) { e = 5; pe = P5; } if (u.pm >= P6) { e = 6; pe = P6; } if (u.pm >= P7) { e = 7; pe = P7; }
        u.pa = a_sparse ? e * 128 + (u.pm - pe) : u.pm; u.pn = e * nNl + u.pn;
    }
    __device__ __forceinline__ void a_ready(const Unit&) const {}
    __device__ __forceinline__ void done(const Unit&) const {}
};
template <class Epi, class Sched, bool ALIGN_EPI = false, bool SP2 = false, bool FP8 = false>
__device__ __forceinline__ void gemm_phase(PG8_LAS unsigned char* lds, const Gemm g, const Sched& S, const Epi& E, int tid_) {
    asm volatile("" : "+v"(tid_));
    const int tid = tid_, wid = __builtin_amdgcn_readfirstlane(tid >> 6), lane = tid & 63, wr = wid >> 2, wc = wid & 3, fr = lane & 15, fq = lane >> 4;
    int K_ = g.K; asm volatile("" : "+s"(K_));
    const int K = K_, nt = FP8 ? K / 128 : K / BK; const int RB = g.ldk ? g.ldk : (FP8 ? K : 2 * K);
    unsigned voffA[2], voffB[2];
#pragma unroll
    for (int i = 0; i < 2; ++i) { int R, C; stage_rc(tid * 16 + i * 8192, R, C); const int Rb = Epi::PERM ? ((R & ~31) + perm32(R & 31)) : R;
        voffA[i] = (unsigned)(R * RB + C * 2); voffB[i] = (unsigned)(Rb * RB + C * 2); }
    const size_t kstep = (size_t)(BK * 2);
    const size_t hstep = (size_t)HALF * RB;
    const size_t tstep = 2 * hstep;
    const unsigned ldsw = (unsigned)wid * 1024u;
    const int aoff = lds_byte(wr * 64 + fr, fq * 8), boff = lds_byte(wc * 32 + fr, fq * 8);
#define PG8_SA(b, h) (((b) * 2 + (h)) * HTB)
#define PG8_SB(b, h) ((4 + (b) * 2 + (h)) * HTB)
#define PG8_STAGE(bufoff, gbase, voff) do { _Pragma("unroll") for (int _i = 0; _i < 2; ++_i) \
        __builtin_amdgcn_global_load_lds((const unsigned*)((const char*)(gbase) + (voff)[_i]), (PG8_LAS unsigned*)(lds + (bufoff) + ldsw + _i * 8192), 16, 0, 0); } while (0)
#define PG8_LDA(dst, b, h) do { if constexpr (FP8) { _Pragma("unroll") for (int m = 0; m < 4; ++m) { dst##8[m].lo = *(const PG8_LAS v4i_t*)(lds + PG8_SA(b, h) + aoff + m * 2048); dst##8[m].hi = *(const PG8_LAS v4i_t*)(lds + PG8_SA(b, h) + aoff + m * 2048 + 1024); } } \
        else { _Pragma("unroll") for (int m = 0; m < 4; ++m) _Pragma("unroll") for (int k = 0; k < 2; ++k) dst[m][k] = *(const PG8_LAS bf16x8*)(lds + PG8_SA(b, h) + aoff + m * 2048 + k * 1024); } } while (0)
#define PG8_LDB(dst, b, h) do { if constexpr (FP8) { _Pragma("unroll") for (int n = 0; n < 2; ++n) { dst##8[n].lo = *(const PG8_LAS v4i_t*)(lds + PG8_SB(b, h) + boff + n * 2048); dst##8[n].hi = *(const PG8_LAS v4i_t*)(lds + PG8_SB(b, h) + boff + n * 2048 + 1024); } } \
        else { _Pragma("unroll") for (int n = 0; n < 2; ++n) _Pragma("unroll") for (int k = 0; k < 2; ++k) dst[n][k] = *(const PG8_LAS bf16x8*)(lds + PG8_SB(b, h) + boff + n * 2048 + k * 1024); } } while (0)
#define PG8_MMA(ai, bj, At, Bt) do { __builtin_amdgcn_s_setprio(1); \
        if constexpr (FP8) { _Pragma("unroll") for (int m = 0; m < 4; ++m) _Pragma("unroll") for (int n = 0; n < 2; ++n) \
            asm volatile("v_mfma_scale_f32_16x16x128_f8f6f4 %0, %1, %2, %0, %3, %3 op_sel_hi:[0,0,0]" : "+v"(acc[ai][bj][m][n]) : "v"(Bt##8[n]), "v"(At##8[m]), "v"(scl8)); } \
        else { _Pragma("unroll") for (int m = 0; m < 4; ++m) _Pragma("unroll") for (int n = 0; n < 2; ++n) _Pragma("unroll") for (int k = 0; k < 2; ++k) \
            acc[ai][bj][m][n] = __builtin_amdgcn_mfma_f32_16x16x32_bf16(Bt[n][k], At[m][k], acc[ai][bj][m][n], 0, 0, 0); } __builtin_amdgcn_s_setprio(0); } while (0)
#define PG8_WAIT_V(n) asm volatile("s_waitcnt vmcnt(" #n ")" ::: "memory")
#define PG8_WAIT_L(n) asm volatile("s_waitcnt lgkmcnt(" #n ")" ::: "memory")
#define PG8_BAR __builtin_amdgcn_s_barrier()
#define PG8_SCHED __builtin_amdgcn_sched_barrier(0)
    Unit cur, nxt; int ui = 0;
    if (!S.next(0, cur)) return;
    f32x4 acc[2][2][4][2];
#pragma unroll
    for (int a = 0; a < 2; ++a)
#pragma unroll
        for (int b = 0; b < 2; ++b)
#pragma unroll
            for (int m = 0; m < 4; ++m)
#pragma unroll
                for (int n = 0; n < 2; ++n) acc[a][b][m][n] = (f32x4){0.f, 0.f, 0.f, 0.f};
    typedef int v4i_t __attribute__((ext_vector_type(4))); typedef int v8i_t __attribute__((ext_vector_type(8)));
    int scl8 = 0x7F7F7F7F; asm volatile("" : "+v"(scl8));
    bf16x8 At[4][2], B0[2][2], B1[2][2]; v8i_t At8[4], B08[2], B18[2];
    const char* cA = (const char*)g.A + (size_t)cur.pa * tstep; const char* cB = (const char*)g.Bt + (size_t)cur.pn * tstep;
    S.a_ready(cur);
    if constexpr (SP2) {
        PG8_STAGE(PG8_SB(0, 0), cB, voffB); PG8_STAGE(PG8_SB(0, 1), cB + hstep, voffB); PG8_STAGE(PG8_SA(0, 0), cA, voffA); PG8_STAGE(PG8_SA(0, 1), cA + hstep, voffA);
        if (wr == 1) PG8_BAR;
        PG8_WAIT_V(2); PG8_BAR;
        PG8_STAGE(PG8_SB(1, 0), cB + kstep, voffB); PG8_STAGE(PG8_SA(1, 0), cA + kstep, voffA); PG8_STAGE(PG8_SB(1, 1), cB + hstep + kstep, voffB);
        PG8_WAIT_V(6); PG8_BAR;
    } else {
        PG8_STAGE(PG8_SB(0, 0), cB, voffB); PG8_STAGE(PG8_SA(0, 0), cA, voffA); PG8_STAGE(PG8_SB(0, 1), cB + hstep, voffB); PG8_STAGE(PG8_SA(0, 1), cA + hstep, voffA);
        if (wr == 1) PG8_BAR;
        PG8_WAIT_V(4); PG8_BAR;
        PG8_STAGE(PG8_SB(1, 0), cB + kstep, voffB); PG8_STAGE(PG8_SA(1, 0), cA + kstep, voffA); PG8_STAGE(PG8_SB(1, 1), cB + hstep + kstep, voffB);
        PG8_WAIT_V(6); PG8_BAR;
    }
    for (;;) {
        const bool has_next = S.next(ui + 1, nxt);
        const char* nA = has_next ? (const char*)g.A + (size_t)nxt.pa * tstep : cA; const char* nB = has_next ? (const char*)g.Bt + (size_t)nxt.pn * tstep : cB;
#pragma unroll 1
        for (int t = 0; t < nt; t += 2) {
            const bool last = (t == nt - 2);
            const char* a1 = cA + (size_t)(t + 1) * kstep;
            const char* a2 = last ? nA : cA + (size_t)(t + 2) * kstep; const char* b2 = last ? nB : cB + (size_t)(t + 2) * kstep;
            const char* a3 = a2 + kstep; const char* b3 = b2 + kstep;
            if (last && has_next) S.a_ready(nxt);
            if constexpr (SP2) {
            PG8_LDB(B0, 0, 0); PG8_LDB(B1, 0, 1); PG8_SCHED; PG8_LDA(At, 0, 0); PG8_STAGE(PG8_SA(1, 1), a1 + hstep, voffA);
            PG8_WAIT_V(8); PG8_WAIT_L(0); PG8_BAR; PG8_MMA(0, 0, At, B0); PG8_MMA(0, 1, At, B1); PG8_BAR; PG8_SCHED;
            PG8_LDA(At, 0, 1); PG8_STAGE(PG8_SB(0, 0), b2, voffB); PG8_STAGE(PG8_SB(0, 1), b2 + hstep, voffB); PG8_STAGE(PG8_SA(0, 0), a2, voffA);
            PG8_WAIT_V(8); PG8_WAIT_L(0); PG8_BAR; PG8_MMA(1, 0, At, B0); PG8_MMA(1, 1, At, B1); PG8_BAR; PG8_SCHED;
            PG8_LDB(B0, 1, 0); PG8_LDB(B1, 1, 1); PG8_SCHED; PG8_LDA(At, 1, 0); PG8_STAGE(PG8_SA(0, 1), a2 + hstep, voffA);
            PG8_WAIT_V(8); PG8_WAIT_L(0); PG8_BAR; PG8_MMA(0, 0, At, B0); PG8_MMA(0, 1, At, B1); PG8_BAR; PG8_SCHED;
            PG8_LDA(At, 1, 1); PG8_STAGE(PG8_SB(1, 0), b3, voffB); PG8_STAGE(PG8_SB(1, 1), b3 + hstep, voffB); PG8_STAGE(PG8_SA(1, 0), a3, voffA);
            PG8_WAIT_V(8); PG8_WAIT_L(0); PG8_BAR; PG8_MMA(1, 0, At, B0); PG8_MMA(1, 1, At, B1); PG8_BAR; PG8_SCHED;
            } else {
            PG8_LDB(B0, 0, 0); PG8_SCHED; PG8_LDA(At, 0, 0); PG8_STAGE(PG8_SA(1, 1), a1 + hstep, voffA);
            PG8_WAIT_L(8); PG8_BAR; PG8_WAIT_L(0); PG8_MMA(0, 0, At, B0); PG8_BAR; PG8_SCHED;
            PG8_LDB(B1, 0, 1); PG8_STAGE(PG8_SB(0, 0), b2, voffB);
            PG8_BAR; PG8_WAIT_L(0); PG8_MMA(0, 1, At, B1); PG8_BAR;
            PG8_LDA(At, 0, 1); PG8_STAGE(PG8_SA(0, 0), a2, voffA);
            PG8_BAR; PG8_WAIT_L(0); PG8_MMA(1, 0, At, B0); PG8_BAR; PG8_SCHED;
            PG8_STAGE(PG8_SB(0, 1), b2 + hstep, voffB);
            PG8_WAIT_V(6); PG8_BAR; PG8_MMA(1, 1, At, B1); PG8_BAR;
            PG8_LDB(B0, 1, 0); PG8_SCHED; PG8_LDA(At, 1, 0); PG8_STAGE(PG8_SA(0, 1), a2 + hstep, voffA);
            PG8_WAIT_L(8); PG8_BAR; PG8_WAIT_L(0); PG8_MMA(0, 0, At, B0); PG8_BAR; PG8_SCHED;
            PG8_LDB(B1, 1, 1); PG8_STAGE(PG8_SB(1, 0), b3, voffB);
            PG8_BAR; PG8_WAIT_L(0); PG8_MMA(0, 1, At, B1); PG8_BAR;
            PG8_LDA(At, 1, 1); PG8_STAGE(PG8_SA(1, 0), a3, voffA);
            PG8_BAR; PG8_WAIT_L(0); PG8_MMA(1, 0, At, B0); PG8_BAR; PG8_SCHED;
            PG8_STAGE(PG8_SB(1, 1), b3 + hstep, voffB);
            PG8_WAIT_V(6); PG8_BAR; PG8_MMA(1, 1, At, B1); PG8_BAR;
            }
        }
        if constexpr (ALIGN_EPI) { if (wr == 0) PG8_BAR; }
        if constexpr (FP8) asm volatile("s_nop 15\n\ts_nop 15" ::: "memory");
        if constexpr (!Epi::AFTER_DRAIN) { int fr_ = fr, fq_ = fq; asm volatile("" : "+v"(fr_), "+v"(fq_));
            E(acc, cur, wr, wc, fr_, fq_); S.done(cur); }
        if (!has_next) break;
#pragma unroll
        for (int a = 0; a < 2; ++a)
#pragma unroll
            for (int b = 0; b < 2; ++b)
#pragma unroll
                for (int m = 0; m < 4; ++m)
#pragma unroll
                    for (int n = 0; n < 2; ++n) acc[a][b][m][n] = (f32x4){0.f, 0.f, 0.f, 0.f};
        cur = nxt; cA = nA; cB = nB; ++ui;
        if constexpr (ALIGN_EPI) { if (wr == 1) PG8_BAR; }
    }
    PG8_WAIT_V(0);
    if constexpr (!ALIGN_EPI) { if (wr == 0) PG8_BAR; }
    PG8_BAR;
    if constexpr (Epi::AFTER_DRAIN) { E.fused(acc, cur, wr, wc, fr, fq, lds, wid, lane); S.done(cur); }
#undef PG8_SA
#undef PG8_SB
#undef PG8_STAGE
#undef PG8_LDA
#undef PG8_LDB
#undef PG8_MMA
#undef PG8_WAIT_V
#undef PG8_WAIT_L
#undef PG8_BAR
#undef PG8_SCHED
}
}
#define GAS __attribute__((address_space(1)))
#define LAS __attribute__((address_space(3)))
typedef unsigned short bf16;
typedef unsigned v4u __attribute__((ext_vector_type(4)));
typedef float f32x4 __attribute__((ext_vector_type(4)));
typedef short bf16x8 __attribute__((ext_vector_type(8)));
typedef GAS unsigned gu32;
typedef GAS unsigned long long gu64;
#define RLX_AGENT __ATOMIC_RELAXED, __HIP_MEMORY_SCOPE_AGENT
#define LDS_WAIT() asm volatile("s_waitcnt lgkmcnt(0)" ::: "memory")
#define VM_WAIT() asm volatile("s_waitcnt vmcnt(0)" ::: "memory")
__device__ __forceinline__ unsigned long long rt() { return __builtin_amdgcn_s_memrealtime(); }
__device__ __forceinline__ unsigned f2bf(float f) { unsigned u = __builtin_bit_cast(unsigned, f); return (u + 0x7fffu + ((u >> 16) & 1u)) >> 16; }
__device__ __forceinline__ unsigned pk2(float lo, float hi) { return f2bf(lo) | (f2bf(hi) << 16); }

#define XB_TMO      128
#define XB_XCNT(j)  (256  + 64 * (j))
#define XB_XSUB(j)  (1280 + 64 * (j))
#define XB_XGEN(j)  (2304 + 64 * (j))
#define XB_TOP      3328
#define XB_TOPGEN   3392
#define XCD_BAR_WORDS 3456
#define XB_SPIN_CAP (1u << 18)

__device__ __forceinline__ unsigned xb_ld(unsigned* p)              { return __hip_atomic_load(p, __ATOMIC_RELAXED, __HIP_MEMORY_SCOPE_AGENT); }
__device__ __forceinline__ unsigned xb_add(unsigned* p, unsigned v) { return __hip_atomic_fetch_add(p, v, __ATOMIC_RELAXED, __HIP_MEMORY_SCOPE_AGENT); }
__device__ __forceinline__ unsigned xb_xcc_id() { return (unsigned)__builtin_amdgcn_s_getreg((3 << 11) | 20) & 0xFu; }
#define XB_SPIN(cond, bar) do { unsigned _sp = 0; while (cond) { __builtin_amdgcn_s_sleep(1); \
    if ((++_sp & 255u) == 0u) { if (xb_ld(&(bar)[XB_TMO])) break; if (_sp > XB_SPIN_CAP) { atomicAdd(&(bar)[XB_TMO], 1u); break; } } } } while (0)

struct XcdBarrier {
    unsigned* bar; unsigned x;
    volatile LAS unsigned* st;
    int w0;
};
__device__ __forceinline__ bool xb_is_t0(const XcdBarrier& b) { return b.w0 == 0 && __builtin_amdgcn_mbcnt_hi(~0u, __builtin_amdgcn_mbcnt_lo(~0u, 0u)) == 0u; }

__device__ __forceinline__ XcdBarrier xcd_barrier_post(unsigned* bar, volatile LAS unsigned* st) {
    XcdBarrier b; b.bar = bar; b.x = xb_xcc_id(); b.st = st;
    if (threadIdx.x == 0) (void)xb_add(&bar[XB_XCNT(b.x)], 1u);
    return b;
}
__device__ __forceinline__ void xcd_barrier_complete(unsigned* bar, unsigned x, unsigned& nloc, unsigned& nx) {
    const unsigned G = gridDim.x * gridDim.y * gridDim.z;
    unsigned sum, cnt, mine, sp = 0u;
    for (;;) {
        sum = 0u; cnt = 0u; mine = 0u;
#pragma unroll
        for (unsigned j = 0; j < 16; ++j) { const unsigned c = xb_ld(&bar[XB_XCNT(j)]); sum += c; cnt += (c > 0u) ? 1u : 0u; mine = (j == x) ? c : mine; }
        if (sum == G) break;
        __builtin_amdgcn_s_sleep(1);
        if ((++sp & 255u) == 0u) { if (xb_ld(&bar[XB_TMO])) break; if (sp > XB_SPIN_CAP) { atomicAdd(&bar[XB_TMO], 1u); break; } }
    }
    nloc = mine > 0u ? mine : 1u; nx = cnt > 0u ? cnt : 1u;
}

__device__ __forceinline__ void xcd_barrier(const XcdBarrier& b) {
    asm volatile("s_waitcnt vmcnt(0)" ::: "memory");
    __syncthreads();
    if (xb_is_t0(b)) {
        unsigned* bar = b.bar;
        __builtin_amdgcn_s_waitcnt(0);
        unsigned nloc = b.st[0], nx = b.st[1];
        if (nloc == 0u) { xcd_barrier_complete(bar, b.x, nloc, nx); b.st[0] = nloc; b.st[1] = nx; }
        const unsigned old = xb_add(&bar[XB_XSUB(b.x)], 1u);
        const unsigned gen = old / nloc;
        if (old + 1u == (gen + 1u) * nloc) {
            __builtin_amdgcn_fence(__ATOMIC_RELEASE, "agent");
            asm volatile("s_waitcnt vmcnt(0)" ::: "memory");
            const unsigned og = xb_add(&bar[XB_TOP], 1u);
            const unsigned tg = og / nx;
            if (og + 1u == (tg + 1u) * nx) xb_add(&bar[XB_TOPGEN], 1u);
            else XB_SPIN(xb_ld(&bar[XB_TOPGEN]) == tg, bar);
            __builtin_amdgcn_fence(__ATOMIC_ACQUIRE, "agent");
            xb_add(&bar[XB_XGEN(b.x)], 1u);
            asm volatile("s_waitcnt vmcnt(0)" ::: "memory");
        } else {
            XB_SPIN(xb_ld(&bar[XB_XGEN(b.x)]) == gen, bar);
            __builtin_amdgcn_fence(__ATOMIC_ACQUIRE, "agent");
            asm volatile("s_waitcnt vmcnt(0)" ::: "memory");
        }
    }
    __syncthreads();
}

#ifndef DENSE_FP8
#define DENSE_FP8 2
#endif
#ifndef DENSE_UP8_LAYERS
#define DENSE_UP8_LAYERS 0x4
#endif
#ifndef INPROJ_FP8
#define INPROJ_FP8 1
#endif
constexpr int NWAVES = 8;
constexpr int BATCH = 16, T = 2048, D = 1024, M = BATCH * T, DEPTH = 4;
constexpr int NU = 2560;
constexpr int UQ = 0, UKC = 512, UVC = 640, UKS = 768, UVS = 896, UKW = 1024, UVW = 1152, UCA = 1280, UCG = 1792, UGL = 2304;
constexpr int D_IN = 2328;
constexpr int FF = 2816, FFE = 3584, NEXP = 8;
constexpr int NCMP = 127, NCP = 128;
constexpr float LN_EPS = 1e-5f;
constexpr float ALPHA = 1.6817928305074290f;
constexpr float LOG2E = 1.4426950408889634f;
constexpr float C2 = 0.125f * 1.4426950408889634f;
constexpr int ECAP = 32768;

constexpr size_t MiB = 1u << 20;
constexpr size_t WS_CTL = 0, CTL_ZERO_BYTES = 1 * MiB;
constexpr size_t WS_MOD = 1 * MiB;
constexpr size_t WS_TBL = 3 * MiB;
constexpr size_t WS_KCMP = 4 * MiB;
constexpr size_t WS_VCMP = 4 * MiB + 512 * 1024;
constexpr size_t WS_ROUTE = 5 * MiB;
constexpr size_t WS_WCMP = 6 * MiB;
constexpr size_t WS_WIN = 8 * MiB;
constexpr size_t WS_WO = 13 * MiB;
constexpr size_t WS_W1 = 16 * MiB;
constexpr size_t WS_W2 = 128 * MiB;
constexpr size_t WS_H = 184 * MiB;
constexpr size_t WS_CAT = 248 * MiB;
constexpr size_t WS_Y = 312 * MiB;
constexpr size_t WS_U = 440 * MiB;
constexpr size_t WS_Y2 = 312 * MiB;
constexpr size_t WS_HG = 600 * MiB;
constexpr size_t WS_HID = 1112 * MiB;
constexpr size_t WS_XB = 1574 * MiB;
constexpr size_t WS_END = 1638 * MiB;
static_assert(WS_Y2 + (size_t)(2 * M + 2048) * D * 4 <= WS_HG && WS_HID + (size_t)(2 * M + 2048) * FFE * 2 <= WS_END, "d_ws map");
constexpr int CW_TMO = 0, CW_CODE = 1;
constexpr int CW_BAR = 4096;
constexpr int CW_CNT = 16384;
constexpr int RING_OFF = 0, RING_BYTES = 131072;
constexpr int LDSCTL_OFF = RING_BYTES, MISC_OFF = LDSCTL_OFF + 320;
constexpr int LDS_BYTES = 147456;
constexpr bool dense_up8(int l) { return DENSE_FP8 == 1 || (DENSE_FP8 == 2 && ((DENSE_UP8_LAYERS >> l) & 1) != 0); }
struct Args { const float* in[21]; float* out; unsigned char* ws; int ph_lo, ph_hi; };

struct Frame {
    LAS unsigned char* lds;
    volatile LAS unsigned* MISC;
    gu32* ctl;
    int tid, lane, wave, G, wave0;

    float* X;
    unsigned char* ws;
};
enum { I_X = 0, I_C, I_WIN, I_CPOS, I_CW1, I_CW2, I_CVW, I_CVB, I_CVG, I_CVBE, I_WOUT, I_RB, I_ADAW, I_ADAB, I_LNG, I_LNB, I_FW1, I_FW2, I_RW, I_MW1, I_MW2 };

__device__ __forceinline__ float dpp_f(float v, const int ctrl_sel) {
    const int x = (int)__float_as_uint(v);
    return __uint_as_float((unsigned)(ctrl_sel == 0 ? __builtin_amdgcn_update_dpp(0, x, 0xB1, 0xF, 0xF, true) : ctrl_sel == 1 ? __builtin_amdgcn_update_dpp(0, x, 0x4E, 0xF, 0xF, true)
                                      : ctrl_sel == 2 ? __builtin_amdgcn_update_dpp(0, x, 0x141, 0xF, 0xF, true) : __builtin_amdgcn_update_dpp(0, x, 0x140, 0xF, 0xF, true)));
}
__device__ __forceinline__ float wave_sum(float v) {
    v += dpp_f(v, 0); v += dpp_f(v, 1); v += dpp_f(v, 2); v += dpp_f(v, 3);
    const int x = (int)__float_as_uint(v);
    const float a = __uint_as_float((unsigned)__builtin_amdgcn_readlane(x, 0)), b = __uint_as_float((unsigned)__builtin_amdgcn_readlane(x, 16));
    const float c = __uint_as_float((unsigned)__builtin_amdgcn_readlane(x, 32)), d = __uint_as_float((unsigned)__builtin_amdgcn_readlane(x, 48));
    return (a + b) + (c + d);
}
__device__ __forceinline__ float bf2f(unsigned short v) { return __uint_as_float((unsigned)v << 16); }
__device__ __forceinline__ float bflo(unsigned w) { return __uint_as_float(w << 16); }
__device__ __forceinline__ float bfhi(unsigned w) { return __uint_as_float(w & 0xffff0000u); }
__device__ __forceinline__ float sigmoid_f(float x) { return __builtin_amdgcn_rcpf(1.f + __builtin_amdgcn_exp2f(-1.4426950408889634f * x)); }

__device__ __forceinline__ void ph_ada(const Args& A, Frame& F) {
    LAS float* sc = (LAS float*)(F.lds);
    LAS float* red = (LAS float*)(F.lds + 65536);
    float* MOD = (float*)(F.ws + WS_MOD);
    for (int i = F.tid; i < BATCH * D; i += 512) { const float v = A.in[I_C][i]; sc[i] = v / (1.f + expf(-v)); }
    __syncthreads();
    const int c = F.tid & 63, ks = F.tid >> 6;
    for (int item = blockIdx.x; item < DEPTH * 96; item += gridDim.x) {
        const int l = item / 96, cb = item % 96, col = cb * 64 + c;
        const float* W = A.in[I_ADAW] + (size_t)l * D * 6 * D + col;
        float acc[16];
#pragma unroll
        for (int b = 0; b < 16; ++b) acc[b] = 0.f;
        for (int k0 = ks * 128; k0 < ks * 128 + 128; k0 += 32) { float wv[32];
#pragma unroll
            for (int kk = 0; kk < 32; ++kk) wv[kk] = __builtin_nontemporal_load(W + (size_t)(k0 + kk) * 6 * D);
            asm volatile("" ::: "memory");
#pragma unroll
            for (int b = 0; b < 16; ++b) { f32x4 s4[8];
#pragma unroll
                for (int q = 0; q < 8; ++q) s4[q] = *(const LAS f32x4*)(sc + b * D + k0 + 4 * q);
#pragma unroll
                for (int q = 0; q < 8; ++q) acc[b] += (s4[q].x * wv[4 * q] + s4[q].y * wv[4 * q + 1]) + (s4[q].z * wv[4 * q + 2] + s4[q].w * wv[4 * q + 3]); } }
#pragma unroll
        for (int b = 0; b < 16; ++b) red[(ks * 16 + b) * 64 + c] = acc[b];
        __syncthreads();
        for (int o = F.tid; o < 1024; o += 512) { const int b = o >> 6, cc = o & 63; float s = 0.f;
#pragma unroll
            for (int k2 = 0; k2 < 8; ++k2) s += red[(k2 * 16 + b) * 64 + cc];
            MOD[(size_t)(l * BATCH + b) * 6 * D + cb * 64 + cc] = s + A.in[I_ADAB][l * 6 * D + cb * 64 + cc]; }
        __syncthreads();
    }
}
__device__ __forceinline__ int rel_bucket_dev(int d) {
    if (d < 16) return d;
    int b = 16;
    b += (d >= 19); b += (d >= 21); b += (d >= 24); b += (d >= 27); b += (d >= 31); b += (d >= 35); b += (d >= 40); b += (d >= 46);
    b += (d >= 52); b += (d >= 59); b += (d >= 67); b += (d >= 77); b += (d >= 87); b += (d >= 99); b += (d >= 113);
    return b;
}
__device__ __forceinline__ void ph_tbl(const Args& A, Frame& F) {
    if (blockIdx.x != 0) return;
    float* TBL = (float*)(F.ws + WS_TBL);
    for (int i = F.tid; i < 2048; i += 512) { const int h = i >> 8, d = 191 - (i & 255); TBL[i] = d < 0 ? 0.f : A.in[I_RB][rel_bucket_dev(d) * 8 + h] * LOG2E; }
}
__device__ __forceinline__ int cvt_dest(int kind, int Fh, int n) {
    if (kind == 0) return n;
    if (kind == 1) return n < 1280 ? n : (n < 1304 ? n + 1024 : n - 24);
    return n < Fh ? ((n >> 7) << 8) + (n & 127) : (((n - Fh) >> 7) << 8) + 128 + ((n - Fh) & 127);
}
struct CvtItem { const float* W; bf16* WT; int K, N, kind, Fh, item; };
__device__ __forceinline__ void cvt_load(const CvtItem& c, float (&t)[32], int lane) {
    if (c.kind < 0 || c.kind == 3) return;
    const int nblk = (c.N + 31) >> 5, kb = c.item / nblk, nb = c.item % nblk, k0 = 64 * kb, n0 = 32 * nb;
    const int nn = n0 + (lane & 31);
    const float* wp = c.W + (size_t)(k0 + (lane >> 5)) * c.N + (nn < c.N ? nn : 0);
#pragma unroll
    for (int i = 0; i < 32; ++i) t[i] = __builtin_nontemporal_load(wp + (size_t)(2 * i) * c.N);
}
__device__ __forceinline__ void cvt_store(const CvtItem& c, const float (&t)[32], LAS float* scr, int lane) {
    if (c.kind < 0) return;
    if (c.kind == 3) { unsigned zz = 0u; asm volatile("" : "+v"(zz)); v4u z = {zz, zz, zz, zz}; *(GAS v4u*)(c.WT + ((size_t)c.item * 64 + lane) * 8) = z; return; }
    const int nblk = (c.N + 31) >> 5, kb = c.item / nblk, nb = c.item % nblk, k0 = 64 * kb, n0 = 32 * nb;
    const int nn = n0 + (lane & 31);
#pragma unroll
    for (int i = 0; i < 32; ++i) scr[(2 * i + (lane >> 5)) * 33 + (lane & 31)] = (nn < c.N) ? t[i] : 0.f;
    LDS_WAIT(); asm volatile("" ::: "memory");
    if (INPROJ_FP8 && c.kind == 1) {
        const int c4 = lane & 3;
#pragma unroll
        for (int j = 0; j < 2; ++j) { const int nl = (lane >> 2) + 16 * j; const int n = n0 + nl; const LAS float* s = scr + (16 * c4) * 33 + nl;
            int p0 = __builtin_amdgcn_cvt_pk_fp8_f32(s[0 * 33] * 32.f, s[1 * 33] * 32.f, 0, false); p0 = __builtin_amdgcn_cvt_pk_fp8_f32(s[2 * 33] * 32.f, s[3 * 33] * 32.f, p0, true);
            int p1 = __builtin_amdgcn_cvt_pk_fp8_f32(s[4 * 33] * 32.f, s[5 * 33] * 32.f, 0, false); p1 = __builtin_amdgcn_cvt_pk_fp8_f32(s[6 * 33] * 32.f, s[7 * 33] * 32.f, p1, true);
            int p2 = __builtin_amdgcn_cvt_pk_fp8_f32(s[8 * 33] * 32.f, s[9 * 33] * 32.f, 0, false); p2 = __builtin_amdgcn_cvt_pk_fp8_f32(s[10 * 33] * 32.f, s[11 * 33] * 32.f, p2, true);
            int p3 = __builtin_amdgcn_cvt_pk_fp8_f32(s[12 * 33] * 32.f, s[13 * 33] * 32.f, 0, false); p3 = __builtin_amdgcn_cvt_pk_fp8_f32(s[14 * 33] * 32.f, s[15 * 33] * 32.f, p3, true);
            v4u o; o.x = (unsigned)p0; o.y = (unsigned)p1; o.z = (unsigned)p2; o.w = (unsigned)p3;
            if (n < c.N) *(GAS v4u*)((unsigned char*)c.WT + (size_t)cvt_dest(c.kind, c.Fh, n) * c.K + k0 + 16 * c4) = o; }
        LDS_WAIT(); asm volatile("" ::: "memory");
        return;
    }
    const int cc = lane & 7;
#pragma unroll
    for (int j = 0; j < 4; ++j) { const int nl = (lane >> 3) + 8 * j; const int n = n0 + nl; const LAS float* s = scr + (8 * cc) * 33 + nl;
        v4u o; o.x = pk2(s[0 * 33], s[1 * 33]); o.y = pk2(s[2 * 33], s[3 * 33]); o.z = pk2(s[4 * 33], s[5 * 33]); o.w = pk2(s[6 * 33], s[7 * 33]);
        if (n < c.N) *(GAS v4u*)(c.WT + (size_t)cvt_dest(c.kind, c.Fh, n) * c.K + k0 + 8 * cc) = o; }
    LDS_WAIT(); asm volatile("" ::: "memory");
}
__device__ __forceinline__ CvtItem cvt_decode(const Args& A, Frame& F, int l, int it, int NIT) {
    bf16* WIN = (bf16*)(F.ws + WS_WIN);
    const int I_A = 16 * 73, I_C = 2 * 64;
    CvtItem c; c.W = nullptr; c.WT = nullptr; c.K = 0; c.N = 0; c.kind = -1; c.Fh = 0; c.item = 0;
    if (it >= NIT) return c;
    int r = it;
    if (r < I_A) { c.W = A.in[I_WIN] + (size_t)l * D * D_IN; c.K = D; c.N = D_IN; c.WT = WIN; c.kind = 1; c.item = r; return c; } r -= I_A;
    if (r < I_C) { const int kv = r >> 6; c.W = A.in[I_CW1] + (size_t)(l * 2 + kv) * 2048 * 64; c.K = 2048; c.N = 64; c.WT = (bf16*)(F.ws + WS_WCMP) + (size_t)kv * 64 * 2048; c.kind = 0; c.item = r & 63; return c; } r -= I_C;
    c.kind = 3; c.WT = INPROJ_FP8 ? (bf16*)((unsigned char*)WIN + (size_t)D_IN * D) : WIN + (size_t)D_IN * D; c.item = r; return c;
}
struct CvtBig { const float* W; bf16* WT; int K, N, kind, Fh, kt, nt; float q8; };
__device__ __forceinline__ CvtBig cvtbig_decode(const Args& A, Frame& F, int l, int it, int NIT) {
    bf16* WO = (bf16*)(F.ws + WS_WO); bf16* W1 = (bf16*)(F.ws + WS_W1); bf16* W2 = (bf16*)(F.ws + WS_W2);
    const bool moe = (l & 1) != 0; const int l2 = l >> 1;
    CvtBig c; c.W = nullptr; c.WT = nullptr; c.K = 0; c.N = 0; c.kind = -1; c.Fh = 0; c.kt = 0; c.nt = 0; c.q8 = 0.f;
    if (it >= NIT) return c;
    int r = it;
    if (moe) {
        if (r < 8 * 8 * 28) { const int e = r / (8 * 28), q = r % (8 * 28); c.W = A.in[I_MW1] + (size_t)(l2 * 8 + e) * D * 2 * FFE; c.K = D; c.N = 2 * FFE; c.WT = (bf16*)((unsigned char*)W1 + (size_t)e * 2 * FFE * D); c.kind = 2; c.Fh = FFE; c.kt = q / 28; c.nt = q % 28; c.q8 = 32.f; return c; } r -= 8 * 8 * 28;
        if (r < 8 * 28 * 4) { const int e = r / (28 * 4), q = r % (28 * 4); c.W = A.in[I_MW2] + (size_t)(l2 * 8 + e) * FFE * D; c.K = FFE; c.N = D; c.WT = (bf16*)((unsigned char*)W2 + (size_t)e * D * FFE); c.kind = 0; c.kt = q / 4; c.nt = q % 4; c.q8 = 128.f; return c; } r -= 8 * 28 * 4;
    } else {
        if (r < 8 * 22) { c.W = A.in[I_FW1] + (size_t)l2 * D * 2 * FF; c.K = D; c.N = 2 * FF; c.WT = W1; c.kind = 2; c.Fh = FF; c.kt = r / 22; c.nt = r % 22; c.q8 = dense_up8(l) ? 32.f : 0.f; return c; } r -= 8 * 22;
        if (r < 22 * 4) { c.W = A.in[I_FW2] + (size_t)l2 * FF * D; c.K = FF; c.N = D; c.WT = W2; c.kind = 0; c.kt = r / 4; c.nt = r % 4; c.q8 = DENSE_FP8 ? 128.f : 0.f; return c; } r -= 22 * 4;
    }
    c.W = A.in[I_WOUT] + (size_t)l * D * D; c.K = D; c.N = D; c.WT = WO; c.kind = 0; c.kt = r / 4; c.nt = r % 4; return c;
}
__device__ __forceinline__ void cvtbig_load(const CvtBig& c, float (&t)[64], int wave, int lane) {
    if (c.kind < 0) return;
    const float* wp = c.W + (size_t)(128 * c.kt + 16 * wave) * c.N + 256 * c.nt + lane;
#pragma unroll
    for (int i = 0; i < 16; ++i)
#pragma unroll
        for (int g = 0; g < 4; ++g) t[4 * i + g] = __builtin_nontemporal_load(wp + (size_t)i * c.N + 64 * g);
}
__device__ __forceinline__ void cvtbig_store(const CvtBig& c, const float (&t)[64], LAS unsigned* T, int wave, int lane) {
    if (c.kind >= 0 && c.q8 == 0.f) {
#pragma unroll
        for (int i = 0; i < 8; ++i)
#pragma unroll
            for (int g = 0; g < 4; ++g) T[(64 * g + lane) * 65 + 8 * wave + i] = pk2(t[4 * (2 * i) + g], t[4 * (2 * i + 1) + g]);
    }
    if (c.kind >= 0 && c.q8 != 0.f) {
#pragma unroll
        for (int i = 0; i < 4; ++i)
#pragma unroll
            for (int g = 0; g < 4; ++g) { int pq = __builtin_amdgcn_cvt_pk_fp8_f32(t[4 * (4 * i) + g] * c.q8, t[4 * (4 * i + 1) + g] * c.q8, 0, false); pq = __builtin_amdgcn_cvt_pk_fp8_f32(t[4 * (4 * i + 2) + g] * c.q8, t[4 * (4 * i + 3) + g] * c.q8, pq, true);
                T[(64 * g + lane) * 33 + 4 * wave + i] = (unsigned)pq; }
    }
    __syncthreads();
    if (c.kind >= 0 && c.q8 == 0.f) {
        const int cc = lane & 15;
#pragma unroll
        for (int j = 0; j < 8; ++j) { const int nl = 32 * wave + 4 * j + (lane >> 4); const LAS unsigned* sp = T + nl * 65 + 4 * cc;
            v4u o; o.x = sp[0]; o.y = sp[1]; o.z = sp[2]; o.w = sp[3];
            *(GAS v4u*)(c.WT + (size_t)cvt_dest(c.kind, c.Fh, 256 * c.nt + nl) * c.K + 128 * c.kt + 8 * cc) = o; }
    }
    if (c.kind >= 0 && c.q8 != 0.f) {
        const int cc = lane & 7;
#pragma unroll
        for (int j = 0; j < 4; ++j) { const int nl = 32 * wave + 8 * j + (lane >> 3); const LAS unsigned* sp = T + nl * 33 + 4 * cc;
            v4u o; o.x = sp[0]; o.y = sp[1]; o.z = sp[2]; o.w = sp[3];
            *(GAS v4u*)((unsigned char*)c.WT + (size_t)cvt_dest(c.kind, c.Fh, 256 * c.nt + nl) * c.K + 128 * c.kt + 16 * cc) = o; }
    }
    __syncthreads();
}
__device__ __forceinline__ void ph_cvt(const Args& A, Frame& F, int l) {
    const bool moe = (l & 1) != 0;
    {
      LAS unsigned* T = (LAS unsigned*)F.lds;
      const int NB = (moe ? 8 * 8 * 28 + 8 * 28 * 4 : 8 * 22 + 22 * 4) + 8 * 4;
      const int G = gridDim.x;
      float ta[64], tb[64];
      CvtBig ca = cvtbig_decode(A, F, l, blockIdx.x, NB), cb;
      cvtbig_load(ca, ta, F.wave, F.lane);
      for (int it = blockIdx.x; it < NB; it += 2 * G) {
          cb = cvtbig_decode(A, F, l, it + G, NB); cvtbig_load(cb, tb, F.wave, F.lane);
          asm volatile("" ::: "memory");
          cvtbig_store(ca, ta, T, F.wave, F.lane);
          ca = cvtbig_decode(A, F, l, it + 2 * G, NB); cvtbig_load(ca, ta, F.wave, F.lane);
          asm volatile("" ::: "memory");
          cvtbig_store(cb, tb, T, F.wave, F.lane);
      }
      __syncthreads(); }
    LAS float* scr = (LAS float*)(F.lds + F.wave * 16384);
    const int gw = blockIdx.x * NWAVES + F.wave, NGW = gridDim.x * NWAVES;
    const int NIT = 16 * 73 + 2 * 64 + 464;
    { float ta[32], tb[32];
      CvtItem ca = cvt_decode(A, F, l, gw, NIT), cb;
      cvt_load(ca, ta, F.lane);
      for (int it = gw; it < NIT; it += 2 * NGW) {
          cb = cvt_decode(A, F, l, it + NGW, NIT); cvt_load(cb, tb, F.lane);
          asm volatile("" ::: "memory");
          cvt_store(ca, ta, scr, F.lane);
          ca = cvt_decode(A, F, l, it + 2 * NGW, NIT); cvt_load(ca, ta, F.lane);
          asm volatile("" ::: "memory");
          cvt_store(cb, tb, scr, F.lane);
      } }
    if ((int)blockIdx.x >= (int)gridDim.x - 16) {
        __syncthreads();
        const int part16 = (int)gridDim.x - 1 - (int)blockIdx.x;
        LAS float* red = (LAS float*)F.lds;
        const int kv = F.tid >> 8, j = F.tid & 63, part = (F.tid >> 6) & 3;
        const float* w1 = A.in[I_CW1] + (size_t)(l * 2 + kv) * 2048 * 64 + (size_t)(128 * part16 + 32 * part) * 64 + j; const float* pos = A.in[I_CPOS] + (size_t)(l * 2 + kv) * 2048 + 128 * part16 + 32 * part;
        float wv[32], pv[32];
#pragma unroll
        for (int kk = 0; kk < 32; ++kk) { wv[kk] = w1[(size_t)kk * 64]; pv[kk] = pos[kk]; }
        asm volatile("" ::: "memory");
        float sacc = 0.f;
#pragma unroll
        for (int kk = 0; kk < 32; ++kk) sacc += pv[kk] * wv[kk];
        red[part * 128 + kv * 64 + j] = sacc;
        __syncthreads();
        if (F.tid < 128) ((float*)(F.ws + WS_WCMP + 512 * 1024))[part16 * 128 + F.tid] = (red[F.tid] + red[128 + F.tid]) + (red[256 + F.tid] + red[384 + F.tid]);
        __syncthreads();
    }
}
__device__ __forceinline__ void ph_mod0(const Args& A, Frame& F) {
    const int gw = blockIdx.x * NWAVES + F.wave, NGW = gridDim.x * NWAVES;
    const float* MOD = (const float*)(F.ws + WS_MOD); bf16* H = (bf16*)(F.ws + WS_H);
    for (int grp = gw; grp < M / 16; grp += NGW) { const int b = grp >> 7; const float* mod = MOD + (size_t)b * 6 * D;
        f32x4 shq[4], sclq[4];
#pragma unroll
        for (int j = 0; j < 4; ++j) { shq[j] = *((const f32x4*)mod + F.lane + 64 * j); sclq[j] = *((const f32x4*)(mod + D) + F.lane + 64 * j); }
#pragma unroll 1
        for (int m0 = grp * 16; m0 < grp * 16 + 16; m0 += 4) { f32x4 xv[4][4];
#pragma unroll
            for (int u = 0; u < 4; ++u)
#pragma unroll
                for (int j = 0; j < 4; ++j) xv[u][j] = __builtin_nontemporal_load((const f32x4*)(A.in[I_X] + (size_t)(m0 + u) * D) + F.lane + 64 * j);
            asm volatile("" ::: "memory");
#pragma unroll
            for (int u = 0; u < 4; ++u) { const int m = m0 + u;
#pragma unroll
                for (int j = 0; j < 4; ++j) { const f32x4 h = xv[u][j] * (1.f + sclq[j]) + shq[j];
                    if (INPROJ_FP8) { int pq = __builtin_amdgcn_cvt_pk_fp8_f32(h.x, h.y, 0, false); pq = __builtin_amdgcn_cvt_pk_fp8_f32(h.z, h.w, pq, true); *((unsigned*)((unsigned char*)H + (size_t)m * D) + F.lane + 64 * j) = (unsigned)pq; }
                    else *((unsigned long long*)(H + (size_t)m * D) + F.lane + 64 * j) = (unsigned long long)pk2(h.x, h.y) | ((unsigned long long)pk2(h.z, h.w) << 32); } } }
    }
}
__device__ __forceinline__ f32x4 bf4(unsigned long long w) { f32x4 r; r.x = bflo((unsigned)w); r.y = bfhi((unsigned)w); r.z = bflo((unsigned)(w >> 32)); r.w = bfhi((unsigned)(w >> 32)); return r; }
typedef _Float16 h4v_t __attribute__((ext_vector_type(4)));
__device__ __forceinline__ unsigned long long pack_h4(const f32x4 v) { h4v_t h; h[0] = (_Float16)v.x; h[1] = (_Float16)v.y; h[2] = (_Float16)v.z; h[3] = (_Float16)v.w; return __builtin_bit_cast(unsigned long long, h); }
__device__ __forceinline__ f32x4 h4f(unsigned long long w) { const h4v_t h = __builtin_bit_cast(h4v_t, w); f32x4 r; r.x = (float)h[0]; r.y = (float)h[1]; r.z = (float)h[2]; r.w = (float)h[3]; return r; }
__device__ __forceinline__ void ph_ln1(const Args& A, Frame& F, int l) {
    const int gw = blockIdx.x * NWAVES + F.wave, NGW = gridDim.x * NWAVES;
    const float* MODL = (const float*)(F.ws + WS_MOD) + (size_t)l * BATCH * 6 * D; bf16* H = (bf16*)(F.ws + WS_H); bf16* HG = (bf16*)(F.ws + WS_HG);
    const bf16* Y = (const bf16*)(F.ws + WS_Y); const float* xin = A.in[I_X]; bf16* XB = (bf16*)(F.ws + WS_XB);
    const float* lg = A.in[I_LNG] + (size_t)(l * 2 + 0) * D; const float* lb = A.in[I_LNB] + (size_t)(l * 2 + 0) * D;
    const bool moe = (l & 1) != 0; const float* RW = A.in[I_RW] + (size_t)(l >> 1) * D * 8;
    unsigned* ROUTE = (unsigned*)(F.ws + WS_ROUTE); unsigned* cnt = (unsigned*)(F.ctl + CW_CNT) + (l >> 1) * 8 * 64;
    LAS unsigned* cntL = (LAS unsigned*)F.lds;
    LAS float* RWL = (LAS float*)(F.lds + 256);
    if (F.tid < 16) cntL[F.tid] = 0u;
    if (moe) { f32x4 t[4];
#pragma unroll
        for (int i = 0; i < 4; ++i) t[i] = ((const f32x4*)RW)[F.tid + 512 * i];
        asm volatile("" ::: "memory");
#pragma unroll
        for (int i = 0; i < 4; ++i) ((LAS f32x4*)RWL)[F.tid + 512 * i] = t[i]; }
    f32x4 lgv[4], lbv[4];
#pragma unroll
    for (int j = 0; j < 4; ++j) { lgv[j] = *((const f32x4*)lg + F.lane + 64 * j); lbv[j] = *((const f32x4*)lb + F.lane + 64 * j); }
    __syncthreads();
    int bcur = -1; f32x4 g1v[4], shq[4], sclq[4];
    for (int grp = gw; grp < M / 16; grp += NGW) {
      { const int b = grp >> 7;
        if (b != bcur) { bcur = b; const float* mod = MODL + (size_t)b * 6 * D;
#pragma unroll
            for (int j = 0; j < 4; ++j) { const int q4 = F.lane + 64 * j; g1v[j] = *((const f32x4*)(mod + 2 * D) + q4); shq[j] = *((const f32x4*)(mod + 3 * D) + q4); sclq[j] = *((const f32x4*)(mod + 4 * D) + q4); } } }
      f32x4 xv[2][4]; unsigned long long xw[2][4], yw[2][4];
#define LN1_LOAD(M0) do { _Pragma("unroll") for (int u = 0; u < 2; ++u) { const int m_ = (M0) + u; _Pragma("unroll") for (int j = 0; j < 4; ++j) { const int q4 = F.lane + 64 * j; \
          if (l == 0) xv[u][j] = __builtin_nontemporal_load((const f32x4*)(xin + (size_t)m_ * D) + q4); else xw[u][j] = __builtin_nontemporal_load((const unsigned long long*)(XB + (size_t)m_ * D) + q4); \
          yw[u][j] = __builtin_nontemporal_load((const unsigned long long*)(Y + (size_t)m_ * D) + q4); } } } while (0)
      LN1_LOAD(grp * 16);
#pragma unroll 1
      for (int m0 = grp * 16; m0 < grp * 16 + 16; m0 += 2) {
        f32x4 v[2][4]; float s[2] = {0.f, 0.f};
        asm volatile("" ::: "memory");
#pragma unroll
        for (int u = 0; u < 2; ++u)
#pragma unroll
            for (int j = 0; j < 4; ++j) { const f32x4 xval = (l == 0) ? xv[u][j] : h4f(xw[u][j]); v[u][j] = ALPHA * xval + (1.f + g1v[j]) * bf4(yw[u][j]); s[u] += (v[u][j].x + v[u][j].y) + (v[u][j].z + v[u][j].w); }
        if (m0 + 2 < grp * 16 + 16) LN1_LOAD(m0 + 2);
        asm volatile("" ::: "memory");
        float mean[2], s2[2] = {0.f, 0.f}, rstd[2];
#pragma unroll
        for (int u = 0; u < 2; ++u) mean[u] = wave_sum(s[u]) * (1.f / D);
#pragma unroll
        for (int u = 0; u < 2; ++u)
#pragma unroll
            for (int j = 0; j < 4; ++j) { v[u][j] = v[u][j] - mean[u]; s2[u] += (v[u][j].x * v[u][j].x + v[u][j].y * v[u][j].y) + (v[u][j].z * v[u][j].z + v[u][j].w * v[u][j].w); }
#pragma unroll
        for (int u = 0; u < 2; ++u) rstd[u] = 1.f / sqrtf(wave_sum(s2[u]) * (1.f / D) + LN_EPS);
#pragma unroll
        for (int u = 0; u < 2; ++u) { const int m = m0 + u;
            float lgt[8];
#pragma unroll
            for (int e = 0; e < 8; ++e) lgt[e] = 0.f;
#pragma unroll
            for (int j = 0; j < 4; ++j) { const int q4 = F.lane + 64 * j;
                const f32x4 xn = v[u][j] * rstd[u] * lgv[j] + lbv[j]; *((unsigned long long*)(XB + (size_t)m * D) + q4) = pack_h4(xn);
                const f32x4 h = xn * (1.f + sclq[j]) + shq[j];
                if (!moe && !dense_up8(l)) *((unsigned long long*)(H + (size_t)m * D) + q4) = (unsigned long long)pk2(h.x, h.y) | ((unsigned long long)pk2(h.z, h.w) << 32);
                else { int pq = __builtin_amdgcn_cvt_pk_fp8_f32(h.x, h.y, 0, false); pq = __builtin_amdgcn_cvt_pk_fp8_f32(h.z, h.w, pq, true); *((unsigned*)((unsigned char*)H + (size_t)m * D) + q4) = (unsigned)pq; }
                if (moe) {
#pragma unroll
                    for (int k = 0; k < 4; ++k) { const f32x4 r0 = *(const LAS f32x4*)(RWL + (4 * q4 + k) * 8), r1 = *(const LAS f32x4*)(RWL + (4 * q4 + k) * 8 + 4); const float hv = h[k];
                        lgt[0] += hv * r0.x; lgt[1] += hv * r0.y; lgt[2] += hv * r0.z; lgt[3] += hv * r0.w; lgt[4] += hv * r1.x; lgt[5] += hv * r1.y; lgt[6] += hv * r1.z; lgt[7] += hv * r1.w; } }
            }
            if (moe) {
#pragma unroll
                for (int e = 0; e < 8; ++e) lgt[e] = wave_sum(lgt[e]);
                int e1 = 0; float v1 = lgt[0];
#pragma unroll
                for (int e = 1; e < 8; ++e) if (lgt[e] > v1) { v1 = lgt[e]; e1 = e; }
                int e2 = -1; float v2 = 0.f;
#pragma unroll
                for (int e = 0; e < 8; ++e) if (e != e1 && (e2 < 0 || lgt[e] > v2)) { v2 = lgt[e]; e2 = e; }
                const float w2 = 1.f / (1.f + expf(v1 - v2)), w1 = 1.f - w2;
                if (F.lane == 0) { const unsigned p1 = atomicAdd((unsigned*)(cntL + e1), 1u), p2 = atomicAdd((unsigned*)(cntL + e2), 1u);
                    v4u r; r.x = (unsigned)e1; r.y = p1; r.z = (unsigned)e2; r.w = p2; *(v4u*)(ROUTE + (size_t)m * 8) = r; ROUTE[(size_t)m * 8 + 4] = __float_as_uint(w1); ROUTE[(size_t)m * 8 + 5] = __float_as_uint(w2); }
            }
        }
      }
#undef LN1_LOAD
    }
    if (moe) {
        asm volatile("s_waitcnt vmcnt(0) lgkmcnt(0)" ::: "memory"); __syncthreads();
        if (F.tid < 8) cntL[8 + F.tid] = atomicAdd(cnt + F.tid * 64, cntL[F.tid]);
        __syncthreads();
        for (int grp = gw; grp < M / 16; grp += NGW)
#pragma unroll 1
        for (int m0 = grp * 16; m0 < grp * 16 + 16; m0 += 2) {
            v4u r[2]; unsigned hv[2][4];
#pragma unroll
            for (int u = 0; u < 2; ++u) { const int m = m0 + u; r[u] = *(const v4u*)(ROUTE + (size_t)m * 8);
#pragma unroll
                for (int j = 0; j < 4; ++j) hv[u][j] = *((const unsigned*)((const unsigned char*)H + (size_t)m * D) + F.lane + 64 * j); }
#pragma unroll
            for (int u = 0; u < 2; ++u) { const int m = m0 + u;
                r[u].y += cntL[8 + r[u].x]; r[u].w += cntL[8 + r[u].z];
                if (F.lane == 0) { ROUTE[(size_t)m * 8 + 1] = r[u].y; ROUTE[(size_t)m * 8 + 3] = r[u].w; }
                unsigned char* d1 = (unsigned char*)HG + ((size_t)r[u].x * ECAP + r[u].y) * D; unsigned char* d2 = (unsigned char*)HG + ((size_t)r[u].z * ECAP + r[u].w) * D;
#pragma unroll
                for (int j = 0; j < 4; ++j) { *((unsigned*)d1 + F.lane + 64 * j) = hv[u][j]; *((unsigned*)d2 + F.lane + 64 * j) = hv[u][j]; } }
        }
    }
}
__device__ __forceinline__ void ph_ln2(const Args& A, Frame& F, int l) {
    const int gw = blockIdx.x * NWAVES + F.wave, NGW = gridDim.x * NWAVES;
    const float* MODL = (const float*)(F.ws + WS_MOD) + (size_t)l * BATCH * 6 * D; bf16* H = (bf16*)(F.ws + WS_H);
    const bf16* Y = (const bf16*)(F.ws + WS_Y); const bf16* Y2 = (const bf16*)(F.ws + WS_Y2); bf16* XB = (bf16*)(F.ws + WS_XB);
    const float* lg = A.in[I_LNG] + (size_t)(l * 2 + 1) * D; const float* lb = A.in[I_LNB] + (size_t)(l * 2 + 1) * D;
    const bool moe = (l & 1) != 0;
    const unsigned* ROUTE = (const unsigned*)(F.ws + WS_ROUTE); const unsigned* cnt = (const unsigned*)(F.ctl + CW_CNT) + (l >> 1) * 8 * 64;
    int P[8];
    { int p = 0;
#pragma unroll
      for (int e = 0; e < 8; ++e) { P[e] = p; p += moe ? ((__builtin_amdgcn_readfirstlane((int)cnt[e * 64]) + 255) >> 8) : 0; } }
    f32x4 lgv[4], lbv[4];
#pragma unroll
    for (int j = 0; j < 4; ++j) { lgv[j] = *((const f32x4*)lg + F.lane + 64 * j); lbv[j] = *((const f32x4*)lb + F.lane + 64 * j); }
    int bcur = -1; f32x4 g2v[4], shq[4], sclq[4];
    for (int grp = gw; grp < M / 16; grp += NGW) {
      { const int b = grp >> 7;
        if (b != bcur) { bcur = b; const float* mod = MODL + (size_t)b * 6 * D;
#pragma unroll
            for (int j = 0; j < 4; ++j) { const int q4 = F.lane + 64 * j; g2v[j] = *((const f32x4*)(mod + 5 * D) + q4);
                if (l + 1 < DEPTH) { shq[j] = *((const f32x4*)(mod + (size_t)BATCH * 6 * D) + q4); sclq[j] = *((const f32x4*)(mod + (size_t)BATCH * 6 * D + D) + q4); } } } }
      v4u rN[2]; float w1N[2] = {1.f, 1.f}, w2N[2] = {0.f, 0.f};
#pragma unroll
      for (int u = 0; u < 2; ++u) { rN[u] = (v4u){0u, 0u, 0u, 0u};
          if (moe) { const int m_ = grp * 16 + u; rN[u] = *(const v4u*)(ROUTE + (size_t)m_ * 8); w1N[u] = __uint_as_float(ROUTE[(size_t)m_ * 8 + 4]); w2N[u] = __uint_as_float(ROUTE[(size_t)m_ * 8 + 5]); } }
#pragma unroll 1
      for (int m0 = grp * 16; m0 < grp * 16 + 16; m0 += 2) {
        f32x4 v[2][4]; float s[2] = {0.f, 0.f};
        const bf16* f1[2]; const bf16* f2[2]; float w1[2], w2[2];
#pragma unroll
        for (int u = 0; u < 2; ++u) { const int m = m0 + u; f1[u] = Y + (size_t)m * D; f2[u] = f1[u]; w1[u] = 1.f; w2[u] = 0.f;
            if (moe) { const v4u r = rN[u]; w1[u] = w1N[u]; w2[u] = w2N[u];
                int b1 = 0, b2 = 0;
#pragma unroll
                for (int e = 0; e < 8; ++e) { if ((int)r.x == e) b1 = P[e]; if ((int)r.z == e) b2 = P[e]; }
                f1[u] = Y2 + ((size_t)b1 * 256 + r.y) * D; f2[u] = Y2 + ((size_t)b2 * 256 + r.w) * D; } }
        { unsigned long long xw[2][4], ya[2][4], yb[2][4];
#pragma unroll
          for (int u = 0; u < 2; ++u) { const int m = m0 + u;
              if (moe && m0 + 2 < grp * 16 + 16) { const int m_ = m + 2; rN[u] = *(const v4u*)(ROUTE + (size_t)m_ * 8); w1N[u] = __uint_as_float(ROUTE[(size_t)m_ * 8 + 4]); w2N[u] = __uint_as_float(ROUTE[(size_t)m_ * 8 + 5]); }
#pragma unroll
              for (int j = 0; j < 4; ++j) { const int q4 = F.lane + 64 * j; xw[u][j] = __builtin_nontemporal_load((const unsigned long long*)(XB + (size_t)m * D) + q4);
                  ya[u][j] = __builtin_nontemporal_load((const unsigned long long*)f1[u] + q4); yb[u][j] = moe ? __builtin_nontemporal_load((const unsigned long long*)f2[u] + q4) : 0ull; } }
          asm volatile("" ::: "memory");
#pragma unroll
          for (int u = 0; u < 2; ++u)
#pragma unroll
              for (int j = 0; j < 4; ++j) { f32x4 fv = bf4(ya[u][j]); if (moe) fv = w1[u] * fv + w2[u] * bf4(yb[u][j]);
                  v[u][j] = ALPHA * h4f(xw[u][j]) + (1.f + g2v[j]) * fv; s[u] += (v[u][j].x + v[u][j].y) + (v[u][j].z + v[u][j].w); } }
        float mean[2], s2[2] = {0.f, 0.f}, rstd[2];
#pragma unroll
        for (int u = 0; u < 2; ++u) mean[u] = wave_sum(s[u]) * (1.f / D);
#pragma unroll
        for (int u = 0; u < 2; ++u)
#pragma unroll
            for (int j = 0; j < 4; ++j) { v[u][j] = v[u][j] - mean[u]; s2[u] += (v[u][j].x * v[u][j].x + v[u][j].y * v[u][j].y) + (v[u][j].z * v[u][j].z + v[u][j].w * v[u][j].w); }
#pragma unroll
        for (int u = 0; u < 2; ++u) rstd[u] = 1.f / sqrtf(wave_sum(s2[u]) * (1.f / D) + LN_EPS);
#pragma unroll
        for (int u = 0; u < 2; ++u) { const int m = m0 + u;
#pragma unroll
            for (int j = 0; j < 4; ++j) { const int q4 = F.lane + 64 * j;
                const f32x4 xn = v[u][j] * rstd[u] * lgv[j] + lbv[j];
                if (l + 1 < DEPTH) *((unsigned long long*)(XB + (size_t)m * D) + q4) = pack_h4(xn); else *((f32x4*)(F.X + (size_t)m * D) + q4) = xn;
                if (l + 1 < DEPTH) { const f32x4 h = xn * (1.f + sclq[j]) + shq[j];
                    if (INPROJ_FP8) { int pq = __builtin_amdgcn_cvt_pk_fp8_f32(h.x, h.y, 0, false); pq = __builtin_amdgcn_cvt_pk_fp8_f32(h.z, h.w, pq, true); *((unsigned*)((unsigned char*)H + (size_t)m * D) + q4) = (unsigned)pq; }
                    else *((unsigned long long*)(H + (size_t)m * D) + q4) = (unsigned long long)pk2(h.x, h.y) | ((unsigned long long)pk2(h.z, h.w) << 32); } } }
      }
    }
}

__device__ __forceinline__ float gelu_tanh_f(float x) { return 0.5f * x * (1.f + tanhf(0.7978845608028654f * (x + 0.044715f * x * x * x))); }
__device__ __forceinline__ void ph_compress_naive(const Args& A, Frame& F, int l) {
    const int gw = blockIdx.x * NWAVES + F.wave, NGW = gridDim.x * NWAVES;
    const bf16* U = (const bf16*)(F.ws + WS_U);
    for (int it = gw; it < 2 * BATCH * NCP * 2; it += NGW) {
        const int g = it & 1, n = (it >> 1) & 127, b = (it >> 8) & 15, kv = it >> 12;
        bf16* OUT = (bf16*)(F.ws + (kv ? WS_VCMP : WS_KCMP)) + ((size_t)(b * NCP + n) * 2 + g) * 64;
        float out = 0.f;
        if (n < NCMP) {
            const float* w1 = A.in[I_CW1] + (size_t)(l * 2 + kv) * 2048 * 64; const float* pos = A.in[I_CPOS] + (size_t)(l * 2 + kv) * 2048;
            const float* w2 = A.in[I_CW2] + (size_t)(l * 2 + kv) * 64 * 64;
            const bf16* ub = U + ((size_t)b * T + 16 * n) * NU + (kv ? UVC : UKC) + g * 64;
            float pre = 0.f;
            for (int kk = 0; kk < 2048; ++kk) { const float a = bf2f(ub[(size_t)(kk >> 6) * NU + (kk & 63)]) + pos[kk]; pre += a * w1[(size_t)kk * 64 + F.lane]; }
            const float ge = gelu_tanh_f(pre);
            for (int j = 0; j < 64; ++j) out += __shfl(ge, j) * w2[j * 64 + F.lane];
        }
        OUT[F.lane] = (bf16)f2bf(out);
    }
}
__device__ __forceinline__ void ph_conv_naive(const Args& A, Frame& F, int l) {
    LAS float* glu = (LAS float*)F.lds;
    LAS float* red = (LAS float*)(F.lds + 46 * 512 * 4);
    const bf16* U = (const bf16*)(F.ws + WS_U); bf16* CAT = (bf16*)(F.ws + WS_CAT);
    const int c = F.tid;
    float w[31];
#pragma unroll
    for (int k = 0; k < 31; ++k) w[k] = A.in[I_CVW][(size_t)(l * 31 + k) * 512 + c];
    const float cb = A.in[I_CVB][l * 512 + c], lg = A.in[I_CVG][l * 512 + c], lb = A.in[I_CVBE][l * 512 + c];
    for (int it = blockIdx.x; it < M / 16; it += gridDim.x) {
        const int b = it >> 7, t0 = (it & 127) * 16;
        for (int rr = 0; rr < 46; ++rr) { const int tt = t0 - 30 + rr; float v = 0.f;
            if (tt >= 0) { const bf16* ur = U + ((size_t)b * T + tt) * NU; v = bf2f(ur[UCA + c]) * sigmoid_f(bf2f(ur[UCG + c])); }
            glu[rr * 512 + c] = v; }
        LDS_WAIT();
        float y[16];
#pragma unroll
        for (int i = 0; i < 16; ++i) { float a = cb;
#pragma unroll
            for (int k = 0; k < 31; ++k) a += w[k] * glu[(i + k) * 512 + c];
            y[i] = a; }
#pragma unroll
        for (int i = 0; i < 16; ++i) { const float s = wave_sum(y[i]); if (F.lane == 0) red[i * 8 + F.wave] = s; }
        __syncthreads();
        float mean[16];
#pragma unroll
        for (int i = 0; i < 16; ++i) { float s = 0.f;
#pragma unroll
            for (int k = 0; k < 8; ++k) s += red[i * 8 + k];
            mean[i] = s * (1.f / 512.f); }
        __syncthreads();
#pragma unroll
        for (int i = 0; i < 16; ++i) { y[i] -= mean[i]; const float s = wave_sum(y[i] * y[i]); if (F.lane == 0) red[i * 8 + F.wave] = s; }
        __syncthreads();
#pragma unroll
        for (int i = 0; i < 16; ++i) { float s = 0.f;
#pragma unroll
            for (int k = 0; k < 8; ++k) s += red[i * 8 + k];
            const float rstd = 1.f / sqrtf(s * (1.f / 512.f) + LN_EPS); const float z = y[i] * rstd * lg + lb;
            CAT[((size_t)b * T + t0 + i) * D + 512 + c] = (bf16)f2bf(z * sigmoid_f(z)); }
        __syncthreads();
    }
}
__device__ __forceinline__ float dot64(const v4u (&qp)[8], const bf16* kp) {
    float s = 0.f;
#pragma unroll
    for (int c = 0; c < 8; ++c) { const v4u kv = *(const v4u*)(kp + 8 * c);
        s += bflo(qp[c].x) * bflo(kv.x) + bfhi(qp[c].x) * bfhi(kv.x); s += bflo(qp[c].y) * bflo(kv.y) + bfhi(qp[c].y) * bfhi(kv.y);
        s += bflo(qp[c].z) * bflo(kv.z) + bfhi(qp[c].z) * bfhi(kv.z); s += bflo(qp[c].w) * bflo(kv.w) + bfhi(qp[c].w) * bfhi(kv.w); }
    return s;
}
__device__ __forceinline__ void axpy64(float (&O)[64], float e, const bf16* vp) {
#pragma unroll
    for (int c = 0; c < 8; ++c) { const v4u vv = *(const v4u*)(vp + 8 * c);
        O[8 * c + 0] += e * bflo(vv.x); O[8 * c + 1] += e * bfhi(vv.x); O[8 * c + 2] += e * bflo(vv.y); O[8 * c + 3] += e * bfhi(vv.y);
        O[8 * c + 4] += e * bflo(vv.z); O[8 * c + 5] += e * bfhi(vv.z); O[8 * c + 6] += e * bflo(vv.w); O[8 * c + 7] += e * bfhi(vv.w); }
}
__device__ __forceinline__ void ph_attn_naive(const Args& A, Frame& F, int l) {
    (void)l;
    LAS float* impH = (LAS float*)F.lds;
    LAS unsigned* selm = (LAS unsigned*)(F.lds + 32768);
    LAS float* WOUT = (LAS float*)(F.lds + 32768 + 256);
    const bf16* U = (const bf16*)(F.ws + WS_U); bf16* CAT = (bf16*)(F.ws + WS_CAT);
    const bf16* KC = (const bf16*)(F.ws + WS_KCMP); const bf16* VC = (const bf16*)(F.ws + WS_VCMP);
    const float* TBL = (const float*)(F.ws + WS_TBL);
    const float NEG = -INFINITY;
    for (int it = blockIdx.x; it < BATCH * 2 * 32; it += gridDim.x) {
        const int tb = it & 31, g = (it >> 5) & 1, b = it >> 6;
        const int t0 = tb * 64, i = F.tid & 63, r = F.wave & 3, t = t0 + i, h = g * 4 + r;
        const size_t m = (size_t)b * T + t;
        const bf16* urow = U + m * NU;
        v4u qp[8];
#pragma unroll
        for (int c = 0; c < 8; ++c) qp[c] = *(const v4u*)(urow + UQ + h * 64 + 8 * c);
        const float* tb_h = TBL + h * 128;
        const float gl0 = sigmoid_f(bf2f(urow[UGL + g * 12 + r * 3 + 0])), gl1 = sigmoid_f(bf2f(urow[UGL + g * 12 + r * 3 + 1])), gl2 = sigmoid_f(bf2f(urow[UGL + g * 12 + r * 3 + 2]));
        LAS float* acc = WOUT + (r * 64 + i) * 64;
        float O[64]; float wsc = 0.f;
        if (F.wave < 4) {
            float mx = NEG;
            for (int n = 0; n < NCMP; ++n) { const int dist = t - (16 * n + 31);
                if (dist >= 0) { const float s = dot64(qp, KC + ((size_t)(b * NCP + n) * 2 + g) * 64) + tb_h[dist < 127 ? dist : 127]; mx = fmaxf(mx, s); } }
            float ls = 0.f;
#pragma unroll
            for (int d = 0; d < 64; ++d) O[d] = 0.f;
            LAS float* imp = impH + (r * 64 + i) * 32;
            for (int j = 0; j < 32; ++j) imp[j] = 0.f;
            for (int n = 0; n < NCMP; ++n) { const int dist = t - (16 * n + 31);
                if (dist >= 0) { const float s = dot64(qp, KC + ((size_t)(b * NCP + n) * 2 + g) * 64) + tb_h[dist < 127 ? dist : 127];
                    const float e = exp2f(s - mx); ls += e; axpy64(O, e, VC + ((size_t)(b * NCP + n) * 2 + g) * 64);
                    imp[n >> 2] += e; if ((n & 3) == 3) imp[(n + 1) >> 2] += e; } }
            const float invl = ls > 0.f ? 1.f / ls : 0.f;
            for (int j = 0; j < 32; ++j) imp[j] *= invl;
#pragma unroll
            for (int d = 0; d < 64; ++d) acc[d] = gl0 * invl * O[d];
        } else {
            float mx = NEG, ls = 0.f;
#pragma unroll
            for (int d = 0; d < 64; ++d) O[d] = 0.f;
            const int p0 = t0 - 511 > 0 ? t0 - 511 : 0;
            for (int pos = p0; pos < t0 + 64; ++pos) { const int dist = t - pos;
                if (dist >= 0 && dist < 512) { const bf16* kr = U + ((size_t)b * T + pos) * NU;
                    const float s = dot64(qp, kr + UKW + g * 64) + tb_h[dist < 127 ? dist : 127];
                    if (s > mx) { const float sc = exp2f(mx - s); ls *= sc;
#pragma unroll
                        for (int d = 0; d < 64; ++d) O[d] *= sc;
                        mx = s; }
                    const float e = exp2f(s - mx); ls += e; axpy64(O, e, kr + UVW + g * 64); } }
            wsc = gl2 / ls;
        }
        __syncthreads();
        if (F.wave >= 4) {
#pragma unroll
            for (int d = 0; d < 64; ++d) acc[d] += wsc * O[d];
        }
        if (F.wave == 0) {
            LAS float* sc = impH + i * 32;
            for (int j = 0; j < 32; ++j) { float s = impH[(0 * 64 + i) * 32 + j] + impH[(1 * 64 + i) * 32 + j] + impH[(2 * 64 + i) * 32 + j] + impH[(3 * 64 + i) * 32 + j];
                if (j > tb) s = NEG; else if (j == 0 || j == tb || j == tb - 1) s = INFINITY;
                sc[j] = s; }
            unsigned mask = 0u;
            for (int k = 0; k < 8; ++k) { int best = -1; float bv = 0.f;
                for (int j = 0; j < 32; ++j) if (!((mask >> j) & 1u)) { const float v = sc[j]; if (best < 0 || v > bv) { best = j; bv = v; } }
                mask |= 1u << best; }
            mask &= (tb == 31) ? 0xffffffffu : ((1u << (tb + 1)) - 1u);
            selm[i] = mask;
        }
        __syncthreads();
        if (F.wave < 4) {
            const unsigned mask = selm[i];
            float mx = NEG, ls = 0.f;
#pragma unroll
            for (int d = 0; d < 64; ++d) O[d] = 0.f;
            for (int j = 0; j <= tb; ++j) { const bool sel = (mask >> j) & 1u;
                if (!__any(sel)) continue;
                for (int kk = 0; kk < 64; ++kk) { const int pos = 64 * j + kk, dist = t - pos;
                    if (sel && dist >= 0) { const bf16* kr = U + ((size_t)b * T + pos) * NU;
                        const float s = dot64(qp, kr + UKS + g * 64) + tb_h[dist < 127 ? dist : 127];
                        if (s > mx) { const float sc = exp2f(mx - s); ls *= sc;
#pragma unroll
                            for (int d = 0; d < 64; ++d) O[d] *= sc;
                            mx = s; }
                        const float e = exp2f(s - mx); ls += e; axpy64(O, e, kr + UVS + g * 64); } } }
            const float sc = gl1 / ls;
            bf16* orow = CAT + m * D + h * 64;
#pragma unroll
            for (int c = 0; c < 8; ++c) { float o[8];
#pragma unroll
                for (int k = 0; k < 8; ++k) o[k] = acc[8 * c + k] + sc * O[8 * c + k];
                v4u w; w.x = pk2(o[0], o[1]); w.y = pk2(o[2], o[3]); w.z = pk2(o[4], o[5]); w.w = pk2(o[6], o[7]); *(v4u*)(orow + 8 * c) = w; }
        }
        __syncthreads();
    }
}

namespace att {
using f32x16 = __attribute__((ext_vector_type(16))) float;
using s16x4 = __attribute__((ext_vector_type(4))) short;
typedef short v4i16_t __attribute__((ext_vector_type(4)));
constexpr int SLOTB = 8192;
constexpr int NSLOT = 3;
constexpr int L_K = 0, L_V = NSLOT * SLOTB, L_WSF = 2 * NSLOT * SLOTB, L_OST = L_WSF + 8 * 256, L_TB = L_OST + 8 * 8192, L_IMP = L_TB + 4096, L_MSK = L_IMP + 8 * 1024, L_END = L_MSK + 256;
__device__ __forceinline__ int crow(int r, int hi) { return (r & 3) + 8 * (r >> 2) + 4 * hi; }
__device__ __forceinline__ void glds16(const void* gsrc, unsigned lds_dst) { unsigned keep;
    asm volatile("s_mov_b32 %0, m0\n\ts_mov_b32 m0, %2\n\ts_nop 0\n\tglobal_load_lds_dwordx4 %1, off\n\ts_mov_b32 m0, %0" : "=&s"(keep) : "v"(gsrc), "s"(lds_dst) : "memory"); }
__device__ __forceinline__ unsigned cvtpk(float lo, float hi) { unsigned r; asm volatile("v_cvt_pk_bf16_f32 %0, %1, %2" : "=v"(r) : "v"(lo), "v"(hi)); return r; }
__device__ __forceinline__ void qkt(f32x16& p0, f32x16& p1, const LAS char* Kslot, const bf16x8 (&qr)[4], int r32, int hi, float cinit) {
    const LAS char* kb = Kslot + hi * 1024 + r32 * 16;
    f32x16 z;
#pragma unroll
    for (int r = 0; r < 16; ++r) z[r] = cinit;
    bf16x8 b0[4], b1[4];
#pragma unroll
    for (int d0 = 0; d0 < 4; ++d0) { b0[d0] = *(const LAS bf16x8*)(kb + d0 * 2048); b1[d0] = *(const LAS bf16x8*)(kb + d0 * 2048 + 512); }
    asm volatile("" ::: "memory");
    p0 = __builtin_amdgcn_mfma_f32_32x32x16_bf16(b0[0], qr[0], z, 0, 0, 0); p1 = __builtin_amdgcn_mfma_f32_32x32x16_bf16(b1[0], qr[0], z, 0, 0, 0);
#pragma unroll
    for (int d0 = 1; d0 < 4; ++d0) { p0 = __builtin_amdgcn_mfma_f32_32x32x16_bf16(b0[d0], qr[d0], p0, 0, 0, 0); p1 = __builtin_amdgcn_mfma_f32_32x32x16_bf16(b1[d0], qr[d0], p1, 0, 0, 0); }
}
__device__ __forceinline__ void pv(f32x16 (&o)[2], int vb, bf16x8 pa0, bf16x8 pa1, bf16x8 pa2, bf16x8 pa3) {
    s16x4 lo[2][4], hi[2][4];
#pragma unroll
    for (int d0 = 0; d0 < 2; ++d0)
#pragma unroll
        for (int ks = 0; ks < 4; ++ks) {
            asm volatile("ds_read_b64_tr_b16 %0,%1 offset:%c2" : "=&v"(lo[d0][ks]) : "v"(vb), "i"(d0 * 4096 + ks * 1024) : "memory");
            asm volatile("ds_read_b64_tr_b16 %0,%1 offset:%c2" : "=&v"(hi[d0][ks]) : "v"(vb), "i"(d0 * 4096 + ks * 1024 + 512) : "memory"); }
#define PK(d, k) (bf16x8){lo[d][k][0], lo[d][k][1], lo[d][k][2], lo[d][k][3], hi[d][k][0], hi[d][k][1], hi[d][k][2], hi[d][k][3]}
    asm volatile("s_waitcnt lgkmcnt(8)" : "+v"(lo[0][0]), "+v"(lo[0][1]), "+v"(lo[0][2]), "+v"(lo[0][3]), "+v"(hi[0][0]), "+v"(hi[0][1]), "+v"(hi[0][2]), "+v"(hi[0][3]) :: "memory"); __builtin_amdgcn_sched_barrier(0);
    o[0] = __builtin_amdgcn_mfma_f32_32x32x16_bf16(pa0, PK(0, 0), o[0], 0, 0, 0);
    o[0] = __builtin_amdgcn_mfma_f32_32x32x16_bf16(pa1, PK(0, 1), o[0], 0, 0, 0);
    o[0] = __builtin_amdgcn_mfma_f32_32x32x16_bf16(pa2, PK(0, 2), o[0], 0, 0, 0);
    o[0] = __builtin_amdgcn_mfma_f32_32x32x16_bf16(pa3, PK(0, 3), o[0], 0, 0, 0);
    asm volatile("s_waitcnt lgkmcnt(0)" : "+v"(lo[1][0]), "+v"(lo[1][1]), "+v"(lo[1][2]), "+v"(lo[1][3]), "+v"(hi[1][0]), "+v"(hi[1][1]), "+v"(hi[1][2]), "+v"(hi[1][3]) :: "memory"); __builtin_amdgcn_sched_barrier(0);
    o[1] = __builtin_amdgcn_mfma_f32_32x32x16_bf16(pa0, PK(1, 0), o[1], 0, 0, 0);
    o[1] = __builtin_amdgcn_mfma_f32_32x32x16_bf16(pa1, PK(1, 1), o[1], 0, 0, 0);
    o[1] = __builtin_amdgcn_mfma_f32_32x32x16_bf16(pa2, PK(1, 2), o[1], 0, 0, 0);
    o[1] = __builtin_amdgcn_mfma_f32_32x32x16_bf16(pa3, PK(1, 3), o[1], 0, 0, 0);
#undef PK
}
__device__ __forceinline__ float xhalf_max(float m) { auto rr = __builtin_amdgcn_permlane32_swap(__float_as_uint(m), __float_as_uint(m), false, false); return fmaxf(__uint_as_float(rr[0]), __uint_as_float(rr[1])); }
__device__ __forceinline__ float xhalf_sum(float m) { auto rr = __builtin_amdgcn_permlane32_swap(__float_as_uint(m), __float_as_uint(m), false, false); return __uint_as_float(rr[0]) + __uint_as_float(rr[1]); }
__device__ __forceinline__ float xhalf_other(float m, int hi) { auto rr = __builtin_amdgcn_permlane32_swap(__float_as_uint(m), __float_as_uint(m), false, false); const float a = __uint_as_float(rr[0]), b = __uint_as_float(rr[1]); return hi ? a : b; }
__device__ __forceinline__ float dpp_xor1(float v) { return __uint_as_float((unsigned)__builtin_amdgcn_update_dpp(0, (int)__float_as_uint(v), 0xB1, 0xF, 0xF, true)); }
__device__ __forceinline__ float dpp_xor2(float v) { return __uint_as_float((unsigned)__builtin_amdgcn_update_dpp(0, (int)__float_as_uint(v), 0x4E, 0xF, 0xF, true)); }
__device__ __forceinline__ float dpp_hmir(float v) { return __uint_as_float((unsigned)__builtin_amdgcn_update_dpp(0, (int)__float_as_uint(v), 0x141, 0xF, 0xF, true)); }
__device__ __forceinline__ int dpp_xor1i(int v) { return __builtin_amdgcn_update_dpp(0, v, 0xB1, 0xF, 0xF, true); }
__device__ __forceinline__ int dpp_xor2i(int v) { return __builtin_amdgcn_update_dpp(0, v, 0x4E, 0xF, 0xF, true); }
__device__ __forceinline__ int dpp_hmiri(int v) { return __builtin_amdgcn_update_dpp(0, v, 0x141, 0xF, 0xF, true); }
}

__device__ __forceinline__ void ph_attn(const Args& A, Frame& F, int l) {
    using namespace att; (void)l; (void)A;
    const int lane = F.lane, w = F.wave, r32 = lane & 31, hi = lane >> 5;
    const bf16* U = (const bf16*)(F.ws + WS_U); bf16* CAT = (bf16*)(F.ws + WS_CAT);
    const bf16* KC = (const bf16*)(F.ws + WS_KCMP); const bf16* VC = (const bf16*)(F.ws + WS_VCMP);
    const float* TBL = (const float*)(F.ws + WS_TBL);
    const LAS char* ldsb = (const LAS char*)F.lds;
    const unsigned lds0 = (unsigned)(size_t)F.lds;
    LAS float* wsf = (LAS float*)(F.lds + L_WSF) + w * 64;
    LAS float* tb4 = (LAS float*)(F.lds + L_TB);
    LAS float* impw = (LAS float*)(F.lds + L_IMP) + w * 256;
    LAS unsigned* mskw = (LAS unsigned*)(F.lds + L_MSK) + w * 8;
    const float NEG = -INFINITY;
    const int vbl = ((lane >> 4) & 1) * 32 + (lane & 3) * 8 + (4 * hi + ((lane & 15) >> 2)) * 64;
#ifdef ATT_ECHO
    unsigned long long ec_wait = 0, ec_s1 = 0, ec_pv = 0, ec_t = 0;
#define EC_MARK() (ec_t = __builtin_amdgcn_s_memtime())
#define EC_ADD(x) do { const unsigned long long n_ = __builtin_amdgcn_s_memtime(); x += n_ - ec_t; ec_t = n_; } while (0)
#else
#define EC_MARK() do {} while (0)
#define EC_ADD(x) do {} while (0)
#endif
    const int tok = 8 * w + (r32 >> 2), hr = r32 & 3;
    bf16x8 qn[4]; bf16 gq0 = 0, gq1 = 0, gq2 = 0; int gtab = -1;
#pragma unroll
    for (int d0 = 0; d0 < 4; ++d0) qn[d0] = (bf16x8){0, 0, 0, 0, 0, 0, 0, 0};
#define UNIT_PRE(P) do { const int p_ = (P); const int ui_ = p_ >> 8, v_ = p_ & 255, bg_ = v_ >> 3, s8_ = v_ & 7; \
        const int tb_ = (ui_ == 0) ? s8_ : (ui_ == 1) ? 15 - s8_ : (ui_ == 2) ? 16 + s8_ : 31 - s8_; const int b_ = bg_ >> 1, g_ = bg_ & 1; \
        const bool ld_ = g_ != gtab; float t0_ = 0.f, t1_ = 0.f; if (ld_) { t0_ = TBL[(size_t)(4 * g_) * 256 + F.tid]; t1_ = TBL[(size_t)(4 * g_) * 256 + F.tid + 512]; } \
        const bf16* ur_ = U + ((size_t)b_ * T + tb_ * 64 + tok) * NU; \
        _Pragma("unroll") for (int d0 = 0; d0 < 4; ++d0) qn[d0] = *(const bf16x8*)(ur_ + UQ + (4 * g_ + hr) * 64 + d0 * 16 + hi * 8); \
        gq0 = ur_[UGL + g_ * 12 + hr * 3 + 0]; gq1 = ur_[UGL + g_ * 12 + hr * 3 + 1]; gq2 = ur_[UGL + g_ * 12 + hr * 3 + 2]; \
        asm volatile("" ::: "memory"); \
        const size_t rkc_ = ((size_t)(b_ * NCP) * 2 + g_) * 64; const bf16* kc_ = KC + rkc_ + (size_t)lane * 128 + w * 8; const bf16* vc_ = VC + rkc_ + (size_t)(16 * (w & 3) + (lane >> 2)) * 128 + (w >> 2) * 32 + (lane & 3) * 8; \
        glds16(kc_, (unsigned)__builtin_amdgcn_readfirstlane(lds0 + L_K + w * 1024)); glds16(vc_, (unsigned)__builtin_amdgcn_readfirstlane(lds0 + L_V + w * 1024)); \
        glds16(kc_ + 64 * 128, (unsigned)__builtin_amdgcn_readfirstlane(lds0 + L_K + SLOTB + w * 1024)); glds16(vc_ + 64 * 128, (unsigned)__builtin_amdgcn_readfirstlane(lds0 + L_V + SLOTB + w * 1024)); \
        if (ld_) { tb4[F.tid] = t0_; tb4[F.tid + 512] = t1_; gtab = g_; }     \
        asm volatile("" ::: "memory"); } while (0)
    if ((int)blockIdx.x < BATCH * 2 * 32) UNIT_PRE((int)blockIdx.x);
    for (int p = blockIdx.x; p < BATCH * 2 * 32; p += gridDim.x) {
        const int ui = p >> 8, v = p & 255, bg = v >> 3, s8 = v & 7;
        const int tb = (ui == 0) ? s8 : (ui == 1) ? 15 - s8 : (ui == 2) ? 16 + s8 : 31 - s8;
        const int b = bg >> 1, g = bg & 1, t0 = tb * 64;
        const int t = t0 + tok;
        const int nwin = tb + 1 < 9 ? tb + 1 : 9, nsel = tb + 1, ntile = 2 + nwin + nsel;
        const bf16* ubg = U + (size_t)b * T * NU + g * 64;
        const bf16* kbU = ubg + (size_t)lane * NU + w * 8; const bf16* vbU = ubg + (size_t)(16 * (w & 3) + (lane >> 2)) * NU + (w >> 2) * 32 + (lane & 3) * 8;
#define TILE_DMA(i) do { const int i_ = (i); const bf16* kp_; const bf16* vp_; \
            { const bool win_ = i_ < 2 + nwin; const int kt_ = win_ ? tb - (i_ - 2) : i_ - 2 - nwin; const size_t o_ = (size_t)kt_ * (64 * NU) + (win_ ? UKW : UKS); kp_ = kbU + o_; vp_ = vbU + o_ + (UVW - UKW); } \
            const unsigned so_ = (unsigned)(i_ % NSLOT) * SLOTB; \
            glds16(kp_, (unsigned)__builtin_amdgcn_readfirstlane(lds0 + L_K + so_ + w * 1024)); glds16(vp_, (unsigned)__builtin_amdgcn_readfirstlane(lds0 + L_V + so_ + w * 1024)); } while (0)
        bf16x8 qr[4];
#pragma unroll
        for (int d0 = 0; d0 < 4; ++d0) qr[d0] = qn[d0];
        const float gl0 = sigmoid_f(bf2f(gq0)), gl1 = sigmoid_f(bf2f(gq1)), gl2 = sigmoid_f(bf2f(gq2));
        const LAS float* tbh = tb4 + hr * 256;
        const bool pre_unit = p != (int)blockIdx.x;
        f32x16 o[2];
#pragma unroll
        for (int r = 0; r < 16; ++r) { o[0][r] = 0.f; o[1][r] = 0.f; }
        LAS float* accw = (LAS float*)(F.lds + L_OST) + w * 2048 + lane;
        float cg[8], cl[8];
#pragma unroll
        for (int k = 0; k < 8; ++k) { cg[k] = 0.f; cl[k] = 0.f; }
        float mref = 0.f, lrun = 0.f; unsigned selmask = 0u;
#define FOLD(cf_, MODE) do { if (hi == 0) wsf[r32] = (cf_); asm volatile("s_waitcnt lgkmcnt(0)" ::: "memory"); \
            float f_[16]; _Pragma("unroll") for (int r = 0; r < 16; ++r) f_[r] = wsf[crow(r, hi)]; \
            if ((MODE) == 0) { _Pragma("unroll") for (int r = 0; r < 16; ++r) { accw[(2 * r) * 64] = f_[r] * o[0][r]; accw[(2 * r + 1) * 64] = f_[r] * o[1][r]; o[0][r] = 0.f; o[1][r] = 0.f; } } \
            else { float a0_[16], a1_[16]; _Pragma("unroll") for (int r = 0; r < 16; ++r) { a0_[r] = accw[(2 * r) * 64]; a1_[r] = accw[(2 * r + 1) * 64]; } \
                if ((MODE) == 1) { _Pragma("unroll") for (int r = 0; r < 16; ++r) { accw[(2 * r) * 64] = a0_[r] + f_[r] * o[0][r]; accw[(2 * r + 1) * 64] = a1_[r] + f_[r] * o[1][r]; o[0][r] = 0.f; o[1][r] = 0.f; } } \
                else { _Pragma("unroll") for (int r = 0; r < 16; ++r) { o[0][r] = a0_[r] + f_[r] * o[0][r]; o[1][r] = a1_[r] + f_[r] * o[1][r]; } } } \
            asm volatile("s_waitcnt lgkmcnt(0)" ::: "memory"); mref = 0.f; lrun = 0.f; } while (0)
        for (int i = 0; i < ntile; ++i) {
            EC_MARK();
            if (i == 0 && pre_unit) asm volatile("s_waitcnt vmcnt(6)" ::: "memory");
            else if (i + 1 < ntile) asm volatile("s_waitcnt vmcnt(2)" ::: "memory"); else asm volatile("s_waitcnt vmcnt(0)" ::: "memory");
            asm volatile("s_waitcnt lgkmcnt(0)" ::: "memory"); __builtin_amdgcn_s_barrier(); asm volatile("" ::: "memory");
            EC_ADD(ec_wait);
            if (i + 2 < ntile) TILE_DMA(i + 2);
            const unsigned so = (unsigned)(i % NSLOT) * SLOTB;
            const LAS char* Ks = ldsb + L_K + so; const int vb = (int)(lds0 + L_V + so) + vbl;
            const int kind = i < 2 ? 0 : (i < 2 + nwin ? 1 : 2);
            const int kt = kind == 0 ? i : (kind == 1 ? tb - (i - 2) : i - 2 - nwin);
            if (i == 2 + nwin) { const float lt = xhalf_sum(lrun); FOLD(gl2 / lt, 1); }
            const bool rowok = kind == 2 ? ((selmask >> kt) & 1u) != 0u : true;
            if (__any(rowok)) {
                const bool cfar = kind == 0 && kt == 0 && t0 >= 1152;
                const bool near = (kind == 0 && !cfar) || (kind != 0 && kt + 2 >= tb); const float b31 = tbh[191 - 127];
                const bool first = (i == 0) || (i == 2) || (i == 2 + nwin);
                const bool diag = kind != 0 && kt == tb, wedge = kind == 1 && (kt == tb - 8);
                f32x16 p0, p1; qkt(p0, p1, Ks, qr, r32, hi, (near ? 0.f : b31) - mref);
                if (kind == 0 && !cfar) {
                    const int dbase = t - 31 - 1024 * kt - 64 * hi;
#pragma unroll
                    for (int r = 0; r < 16; ++r) { const int cc = (r & 3) + 8 * (r >> 2); const int d0 = dbase - 16 * cc, d1 = d0 - 512;
                        p0[r] += tbh[191 - (int)min((unsigned)d0, 127u)]; p1[r] += tbh[191 - (int)min((unsigned)d1, 127u)]; }
                    asm volatile("" ::: "memory");
#pragma unroll
                    for (int r = 0; r < 16; ++r) { const int cc = (r & 3) + 8 * (r >> 2); const int d0 = dbase - 16 * cc, d1 = d0 - 512;
                        p0[r] = d0 >= 0 ? p0[r] : NEG; p1[r] = d1 >= 0 ? p1[r] : NEG; }
                } else if (near && kind != 0) {
                    const int dbase = t - 64 * kt - 4 * hi;
                    const LAS float* bp = tbh + (191 - dbase);
#pragma unroll
                    for (int r = 0; r < 16; ++r) { const int cc = (r & 3) + 8 * (r >> 2); p0[r] += bp[cc]; p1[r] += bp[cc + 32]; }
                    if (diag) {
                        asm volatile("" ::: "memory");
#pragma unroll
                        for (int r = 0; r < 16; ++r) { const int cc = (r & 3) + 8 * (r >> 2); const int d0 = dbase - cc, d1 = d0 - 32;
                            p0[r] = d0 >= 0 ? p0[r] : NEG; p1[r] = d1 >= 0 ? p1[r] : NEG; }
                    }
                } else if (wedge) {
                    const int dbase = t - 64 * kt - 4 * hi;
#pragma unroll
                    for (int r = 0; r < 16; ++r) { const int cc = (r & 3) + 8 * (r >> 2); const int d0 = dbase - cc, d1 = d0 - 32;
                        if (d0 >= 512) p0[r] = NEG; if (d1 >= 512) p1[r] = NEG; }
                }
                float alpha = 1.f;
                if (first) {
                    float mx;
                    { float m0 = fmaxf(fmaxf(p0[0], p0[1]), p0[2]), m1 = fmaxf(fmaxf(p1[0], p1[1]), p1[2]);
#pragma unroll
                      for (int r = 3; r < 15; r += 2) { m0 = fmaxf(fmaxf(m0, p0[r]), p0[r + 1]); m1 = fmaxf(fmaxf(m1, p1[r]), p1[r + 1]); }
                      mx = fmaxf(fmaxf(m0, m1), fmaxf(p0[15], p1[15])); }
                    mx = xhalf_max(mx);
                    const float dl = (mx == NEG) ? 0.f : mx;
                    mref += dl;
#pragma unroll
                    for (int r = 0; r < 16; ++r) { p0[r] -= dl; p1[r] -= dl; }
                }
#pragma unroll
                for (int r = 0; r < 16; ++r) { p0[r] = __builtin_amdgcn_exp2f(p0[r]); p1[r] = __builtin_amdgcn_exp2f(p1[r]); }
                float ls;
                { const f32x16 sv = p0 + p1; ls = ((sv[0] + sv[1]) + (sv[2] + sv[3])) + ((sv[4] + sv[5]) + (sv[6] + sv[7])) + (((sv[8] + sv[9]) + (sv[10] + sv[11])) + ((sv[12] + sv[13]) + (sv[14] + sv[15]))); }
                if (!rowok) ls = 0.f;
                const float lsr = first ? 0.f : xhalf_sum(ls);
                if (!first && __any(lsr > 1048576.f)) {
                    const float dl = lsr > 1048576.f ? __builtin_amdgcn_logf(lsr) : 0.f;
                    mref += dl; alpha = __builtin_amdgcn_exp2f(-dl);
#pragma unroll
                    for (int r = 0; r < 16; ++r) { p0[r] *= alpha; p1[r] *= alpha; }
                    ls *= alpha; lrun *= alpha;
                    if (hi == 0) wsf[r32] = alpha; asm volatile("s_waitcnt lgkmcnt(0)" ::: "memory");
#pragma unroll
                    for (int r = 0; r < 16; ++r) { const float f = wsf[crow(r, hi)]; o[0][r] *= f; o[1][r] *= f; }
                    asm volatile("s_waitcnt lgkmcnt(0)" ::: "memory");
                }
                lrun += ls;
                v4u pw0, pw1, pw2, pw3;
                pw0.x = cvtpk(p0[0], p0[1]); pw0.y = cvtpk(p0[2], p0[3]); pw0.z = cvtpk(p0[4], p0[5]); pw0.w = cvtpk(p0[6], p0[7]);
                pw1.x = cvtpk(p0[8], p0[9]); pw1.y = cvtpk(p0[10], p0[11]); pw1.z = cvtpk(p0[12], p0[13]); pw1.w = cvtpk(p0[14], p0[15]);
                pw2.x = cvtpk(p1[0], p1[1]); pw2.y = cvtpk(p1[2], p1[3]); pw2.z = cvtpk(p1[4], p1[5]); pw2.w = cvtpk(p1[6], p1[7]);
                pw3.x = cvtpk(p1[8], p1[9]); pw3.y = cvtpk(p1[10], p1[11]); pw3.z = cvtpk(p1[12], p1[13]); pw3.w = cvtpk(p1[14], p1[15]);
                if (kind == 2 && !__all(rowok)) { const unsigned km = rowok ? 0xffffffffu : 0u;
                    pw0.x &= km; pw0.y &= km; pw0.z &= km; pw0.w &= km; pw1.x &= km; pw1.y &= km; pw1.z &= km; pw1.w &= km;
                    pw2.x &= km; pw2.y &= km; pw2.z &= km; pw2.w &= km; pw3.x &= km; pw3.y &= km; pw3.z &= km; pw3.w &= km; }
                asm volatile("" ::: "memory"); EC_ADD(ec_s1);
                pv(o, vb, __builtin_bit_cast(bf16x8, pw0), __builtin_bit_cast(bf16x8, pw1), __builtin_bit_cast(bf16x8, pw2), __builtin_bit_cast(bf16x8, pw3));
                asm volatile("s_nop 0" ::: "memory"); EC_ADD(ec_pv);
                if (i == 0) {
#pragma unroll
                    for (int a = 0; a < 4; ++a) { cg[a] = (p0[4 * a] + p0[4 * a + 1]) + (p0[4 * a + 2] + p0[4 * a + 3]); cl[a] = p0[4 * a + 3]; cg[4 + a] = (p1[4 * a] + p1[4 * a + 1]) + (p1[4 * a + 2] + p1[4 * a + 3]); cl[4 + a] = p1[4 * a + 3]; } }
                if (i == 1) {
                    const float lt = xhalf_sum(lrun); const float inv = lt > 0.f ? 1.f / lt : 0.f;
                    const float ia = inv * alpha;
                    { float prev = 0.f;
#pragma unroll
                      for (int k = 0; k < 16; ++k) { float gsum, lst;
                          if (k < 8) { gsum = cg[k] * ia; lst = cl[k] * ia; }
                          else if (k < 12) { const int a = k - 8; gsum = ((p0[4 * a] + p0[4 * a + 1]) + (p0[4 * a + 2] + p0[4 * a + 3])) * inv; lst = p0[4 * a + 3] * inv; }
                          else { const int a = k - 12; gsum = ((p1[4 * a] + p1[4 * a + 1]) + (p1[4 * a + 2] + p1[4 * a + 3])) * inv; lst = p1[4 * a + 3] * inv; }
                          const float ot = xhalf_other(lst, hi); gsum += hi ? ot : prev; prev = ot;
                          gsum += dpp_xor1(gsum); gsum += dpp_xor2(gsum);
                          if (hr == 0) impw[(r32 >> 2) * 32 + 2 * k + hi] = gsum; } }
                    asm volatile("s_waitcnt lgkmcnt(0)" ::: "memory");
                    {
                      const int tk = lane >> 3, sub = lane & 7;
                      const f32x4 sv = *(const LAS f32x4*)(impw + tk * 32 + sub * 4);
                      float sc4[4];
#pragma unroll
                      for (int q = 0; q < 4; ++q) { const int j = sub * 4 + q; sc4[q] = j > tb ? -1.f : ((j == 0 || j == tb || j == tb - 1) ? INFINITY : sv[q]); }
                      unsigned mask = 0u;
#pragma unroll 1
                      for (int k = 0; k < 8; ++k) {
                          float bv = sc4[0]; int gj = sub * 4;
#pragma unroll
                          for (int q = 1; q < 4; ++q) if (sc4[q] > bv) { bv = sc4[q]; gj = sub * 4 + q; }
                          { float ov = dpp_xor1(bv); int oj = dpp_xor1i(gj); if (ov > bv || (ov == bv && oj < gj)) { bv = ov; gj = oj; }
                            ov = dpp_xor2(bv); oj = dpp_xor2i(gj); if (ov > bv || (ov == bv && oj < gj)) { bv = ov; gj = oj; }
                            ov = dpp_hmir(bv); oj = dpp_hmiri(gj); if (ov > bv || (ov == bv && oj < gj)) { bv = ov; gj = oj; } }
                          mask |= 1u << gj;
#pragma unroll
                          for (int q = 0; q < 4; ++q) if (gj == sub * 4 + q) sc4[q] = NEG;
                      }
                      mask &= (tb == 31) ? 0xffffffffu : ((1u << (tb + 1)) - 1u);
                      selmask = (unsigned)__shfl((int)mask, (r32 >> 2) * 8); }
                    FOLD(gl0 * inv, 0);
                }
            }
        }
        asm volatile("s_waitcnt lgkmcnt(0)" ::: "memory"); __builtin_amdgcn_s_barrier(); asm volatile("" ::: "memory");
        if (p + (int)gridDim.x < BATCH * 2 * 32) UNIT_PRE(p + (int)gridDim.x);
        { const float lt = xhalf_sum(lrun); FOLD(gl1 / lt, 2); }
        { LAS bf16* stg = (LAS bf16*)(F.lds + L_OST + w * 8192);
#pragma unroll
          for (int r = 0; r < 16; ++r) { const int orow = crow(r, hi);
#pragma unroll
              for (int d0 = 0; d0 < 2; ++d0) stg[orow * 64 + d0 * 32 + r32] = (bf16)f2bf(o[d0][r]); }
          asm volatile("s_waitcnt lgkmcnt(0)" ::: "memory");
#pragma unroll
          for (int i2 = 0; i2 < 4; ++i2) { const int row = i2 * 8 + (lane >> 3), ch = lane & 7; const v4u vv = *(const LAS v4u*)(stg + row * 64 + ch * 8);
              *(v4u*)(CAT + ((size_t)b * T + t0 + 8 * w + (row >> 2)) * D + (4 * g + (row & 3)) * 64 + ch * 8) = vv; }
          asm volatile("s_waitcnt lgkmcnt(0)" ::: "memory"); }
#undef FOLD
#undef TILE_DMA
    }
#undef UNIT_PRE
#ifdef ATT_ECHO
    { const unsigned long long dur = (ATT_ECHO == 1) ? ec_wait : (ATT_ECHO == 2) ? ec_s1 : ec_pv;
      if (w == 0) { const unsigned long long t0_ = __builtin_amdgcn_s_memtime(); while (__builtin_amdgcn_s_memtime() - t0_ < dur) __builtin_amdgcn_s_sleep(4); }
      __syncthreads(); }
#endif
}

__device__ __forceinline__ void ph_compress(const Args& A, Frame& F, int l) {
    LAS float* P = (LAS float*)F.lds;
    LAS float* G = (LAS float*)(F.lds + 17408);
    LAS float* W2 = (LAS float*)(F.lds + 25600);
    const bf16* U = (const bf16*)(F.ws + WS_U);
    const int lane = F.lane, w = F.wave, rt = w & 1, hf = (w >> 1) & 1, ch = w >> 2;
    for (int it = blockIdx.x; it < 256; it += gridDim.x) {
        const int q = it & 3, g = (it >> 2) & 1, b = (it >> 3) & 15, kv = it >> 7;
        const bf16* WT = (const bf16*)(F.ws + WS_WCMP) + (size_t)kv * 64 * 2048;
        const float* w2 = A.in[I_CW2] + (size_t)(l * 2 + kv) * 64 * 64;
        float posb = 0.f;
        { const float* pp = (const float*)(F.ws + WS_WCMP + 512 * 1024) + kv * 64 + (F.tid & 63); float pt[16];
#pragma unroll
          for (int i = 0; i < 16; ++i) pt[i] = pp[i * 128];
#pragma unroll
          for (int i = 0; i < 16; ++i) posb += pt[i]; }
        { f32x4 t[2];
#pragma unroll
          for (int i = 0; i < 2; ++i) t[i] = ((const f32x4*)w2)[F.tid + 512 * i];
          asm volatile("" ::: "memory");
#pragma unroll
          for (int i = 0; i < 2; ++i) ((LAS f32x4*)W2)[F.tid + 512 * i] = t[i]; }
        f32x4 acc[2] = {(f32x4){0.f, 0.f, 0.f, 0.f}, (f32x4){0.f, 0.f, 0.f, 0.f}};
        const int kq = lane >> 4, rc = lane & 15;
        int chunk = 32 * q + 16 * rt + rc + hf; chunk = chunk < 128 ? chunk : 127;
        const bf16* ap = U + ((size_t)b * T + 16 * chunk) * NU + (kv ? UVC : UKC) + g * 64 + 8 * kq;
        const bf16* bp = WT + (size_t)(32 * ch + rc) * 2048 + 1024 * hf + 8 * kq;
        for (int ks0 = 0; ks0 < 32; ks0 += 8) {
            bf16x8 a[8], bb[8][2];
#pragma unroll
            for (int u = 0; u < 8; ++u) { const int ks = ks0 + u; a[u] = *(const bf16x8*)(ap + (size_t)(ks >> 1) * NU + (ks & 1) * 32);
                bb[u][0] = *(const bf16x8*)(bp + 32 * ks); bb[u][1] = *(const bf16x8*)(bp + (size_t)16 * 2048 + 32 * ks); }
            asm volatile("" ::: "memory");
#pragma unroll
            for (int u = 0; u < 8; ++u) { acc[0] = __builtin_amdgcn_mfma_f32_16x16x32_bf16(a[u], bb[u][0], acc[0], 0, 0, 0); acc[1] = __builtin_amdgcn_mfma_f32_16x16x32_bf16(a[u], bb[u][1], acc[1], 0, 0, 0); } }
#pragma unroll
        for (int ct = 0; ct < 2; ++ct)
#pragma unroll
            for (int r = 0; r < 4; ++r) P[(hf * 32 + 16 * rt + kq * 4 + r) * 68 + 32 * ch + 16 * ct + rc] = acc[ct][r];
        __syncthreads();
#pragma unroll
        for (int i = 0; i < 4; ++i) { const int idx = F.tid + 512 * i, n = idx >> 6, j = idx & 63; G[idx] = gelu_tanh_f(P[n * 68 + j] + P[(32 + n) * 68 + j] + posb); }
        __syncthreads();
        { const int j2 = F.tid & 63, ng = F.tid >> 6;
          bf16* OUT = (bf16*)(F.ws + (kv ? WS_VCMP : WS_KCMP));
          float sacc[4] = {0.f, 0.f, 0.f, 0.f};
#pragma unroll 1
          for (int jc = 0; jc < 4; ++jc) { float wv[16]; f32x4 gv[4][4];
#pragma unroll
              for (int i = 0; i < 16; ++i) wv[i] = W2[(16 * jc + i) * 64 + j2];
#pragma unroll
              for (int i = 0; i < 4; ++i)
#pragma unroll
                  for (int q4 = 0; q4 < 4; ++q4) gv[i][q4] = *(const LAS f32x4*)(G + (ng + 8 * i) * 64 + 16 * jc + 4 * q4);
              asm volatile("" ::: "memory");
#pragma unroll
              for (int i = 0; i < 4; ++i)
#pragma unroll
                  for (int q4 = 0; q4 < 4; ++q4) sacc[i] += gv[i][q4].x * wv[4 * q4] + gv[i][q4].y * wv[4 * q4 + 1] + gv[i][q4].z * wv[4 * q4 + 2] + gv[i][q4].w * wv[4 * q4 + 3]; }
#pragma unroll
          for (int i = 0; i < 4; ++i) { const int nl = ng + 8 * i, n = 32 * q + nl; OUT[((size_t)(b * NCP + n) * 2 + g) * 64 + j2] = (bf16)f2bf(n < NCMP ? sacc[i] : 0.f); } }
        __syncthreads();
    }
}

__device__ __forceinline__ void ph_conv(const Args& A, Frame& F, int l) {
    typedef _Float16 h8 __attribute__((ext_vector_type(8)));
    typedef _Float16 h4 __attribute__((ext_vector_type(4)));
    LAS _Float16* taps = (LAS _Float16*)F.lds;
    LAS _Float16* glu = (LAS _Float16*)(F.lds + 31 * 512 * 2);
    const bf16* U = (const bf16*)(F.ws + WS_U); bf16* CAT = (bf16*)(F.ws + WS_CAT);
    const int lane = F.lane, w = F.wave, c0 = 8 * lane;
    { const f32x4* src = (const f32x4*)(A.in[I_CVW] + (size_t)l * 31 * 512); f32x4 t[8];
#pragma unroll
      for (int i = 0; i < 8; ++i) { const int q = F.tid + 512 * i; t[i] = q < 31 * 128 ? src[q] : (f32x4){0.f, 0.f, 0.f, 0.f}; }
      asm volatile("" ::: "memory");
#pragma unroll
      for (int i = 0; i < 8; ++i) { const int q = F.tid + 512 * i; if (q < 31 * 128) { h4 o; o[0] = (_Float16)t[i].x; o[1] = (_Float16)t[i].y; o[2] = (_Float16)t[i].z; o[3] = (_Float16)t[i].w; ((LAS h4*)taps)[q] = o; } } }
    f32x4 cb[2], lg[2], lb[2];
#pragma unroll
    for (int h = 0; h < 2; ++h) { cb[h] = *(const f32x4*)(A.in[I_CVB] + l * 512 + c0 + 4 * h); lg[h] = *(const f32x4*)(A.in[I_CVG] + l * 512 + c0 + 4 * h); lb[h] = *(const f32x4*)(A.in[I_CVBE] + l * 512 + c0 + 4 * h); }
    __syncthreads();
    for (int it = blockIdx.x; it < M / 32; it += gridDim.x) {
        const int b = it >> 6, t0 = (it & 63) * 32;
        { v4u av[8], gv[8];
#pragma unroll
          for (int i = 0; i < 8; ++i) { const int q = F.tid + 512 * i; const int rr = q >> 6, ch = (q & 63) * 8; const int tt = t0 - 30 + rr; const bool ok = q < 62 * 64 && tt >= 0;
              const bf16* ur = U + ((size_t)b * T + (ok ? tt : 0)) * NU; av[i] = *(const v4u*)(ur + UCA + ch); gv[i] = *(const v4u*)(ur + UCG + ch); }
          asm volatile("" ::: "memory");
#pragma unroll
          for (int i = 0; i < 8; ++i) { const int q = F.tid + 512 * i; const int rr = q >> 6, ch = (q & 63) * 8; const int tt = t0 - 30 + rr;
              if (q < 62 * 64) { h8 o;
                  if (tt >= 0) { o[0] = (_Float16)(bflo(av[i].x) * sigmoid_f(bflo(gv[i].x))); o[1] = (_Float16)(bfhi(av[i].x) * sigmoid_f(bfhi(gv[i].x))); o[2] = (_Float16)(bflo(av[i].y) * sigmoid_f(bflo(gv[i].y))); o[3] = (_Float16)(bfhi(av[i].y) * sigmoid_f(bfhi(gv[i].y)));
                      o[4] = (_Float16)(bflo(av[i].z) * sigmoid_f(bflo(gv[i].z))); o[5] = (_Float16)(bfhi(av[i].z) * sigmoid_f(bfhi(gv[i].z))); o[6] = (_Float16)(bflo(av[i].w) * sigmoid_f(bflo(gv[i].w))); o[7] = (_Float16)(bfhi(av[i].w) * sigmoid_f(bfhi(gv[i].w))); }
                  else {
#pragma unroll
                      for (int k = 0; k < 8; ++k) o[k] = (_Float16)0.f; }
                  *(LAS h8*)(glu + rr * 512 + ch) = o; } } }
        __syncthreads();
        h8 y16[4];
        { h8 cb16; cb16[0] = (_Float16)cb[0].x; cb16[1] = (_Float16)cb[0].y; cb16[2] = (_Float16)cb[0].z; cb16[3] = (_Float16)cb[0].w; cb16[4] = (_Float16)cb[1].x; cb16[5] = (_Float16)cb[1].y; cb16[6] = (_Float16)cb[1].z; cb16[7] = (_Float16)cb[1].w;
#pragma unroll
          for (int i = 0; i < 4; ++i) y16[i] = cb16; }
        h8 wk[11];
#pragma unroll
        for (int c8 = 0; c8 < 34; c8 += 8) {
            h8 gh[8];
#pragma unroll
            for (int i = 0; i < 8; ++i) { const int rho = c8 + i;
                if (rho < 34) gh[i] = *(const LAS h8*)(glu + (4 * w + rho) * 512 + c0);
                if (rho < 31) wk[3 + i] = *(const LAS h8*)(taps + rho * 512 + c0); }
            asm volatile("" ::: "memory");
#pragma unroll
            for (int i = 0; i < 8; ++i) { const int rho = c8 + i;
                if (rho < 34) {
#pragma unroll
                    for (int t = 0; t < 4; ++t) { const int k = rho - t; if (k >= 0 && k < 31) y16[t] += wk[3 + i - t] * gh[i]; } } }
#pragma unroll
            for (int t = 0; t < 3; ++t) wk[t] = wk[8 + t];
        }
        f32x4 y[4][2];
#pragma unroll
        for (int i = 0; i < 4; ++i) { y[i][0] = (f32x4){(float)y16[i][0], (float)y16[i][1], (float)y16[i][2], (float)y16[i][3]}; y[i][1] = (f32x4){(float)y16[i][4], (float)y16[i][5], (float)y16[i][6], (float)y16[i][7]}; }
#pragma unroll
        for (int i = 0; i < 4; ++i) {
            float s = (y[i][0].x + y[i][0].y) + (y[i][0].z + y[i][0].w) + (y[i][1].x + y[i][1].y) + (y[i][1].z + y[i][1].w);
            const float mean = wave_sum(s) * (1.f / 512.f);
            const f32x4 d0 = y[i][0] - mean, d1 = y[i][1] - mean;
            float q = (d0.x * d0.x + d0.y * d0.y) + (d0.z * d0.z + d0.w * d0.w) + (d1.x * d1.x + d1.y * d1.y) + (d1.z * d1.z + d1.w * d1.w);
            const float rstd = 1.f / sqrtf(wave_sum(q) * (1.f / 512.f) + LN_EPS);
            const f32x4 z0 = d0 * rstd * lg[0] + lb[0], z1 = d1 * rstd * lg[1] + lb[1];
            v4u o; o.x = pk2(z0.x * sigmoid_f(z0.x), z0.y * sigmoid_f(z0.y)); o.y = pk2(z0.z * sigmoid_f(z0.z), z0.w * sigmoid_f(z0.w));
            o.z = pk2(z1.x * sigmoid_f(z1.x), z1.y * sigmoid_f(z1.y)); o.w = pk2(z1.z * sigmoid_f(z1.z), z1.w * sigmoid_f(z1.w));
            *(v4u*)(CAT + ((size_t)b * T + t0 + 4 * w + i) * D + 512 + c0) = o; }
        __syncthreads();
    }
}

constexpr int NSTEP_PRO = 2, NSTEP_LAYER = 8, NSTEPS = NSTEP_PRO + DEPTH * NSTEP_LAYER;
#define IN(k) (lo <= (k) && (k) < hi)
#define SEAM(k) do { if (IN(k) && IN((k) + 1)) xcd_barrier(bar); } while (0)
#define FRESH() do { int t_ = (int)__builtin_amdgcn_mbcnt_hi(~0u, __builtin_amdgcn_mbcnt_lo(~0u, 0u)) + 64 * F.wave0; asm volatile("" : "+v"(t_)); F.tid = t_; F.lane = t_ & 63; F.wave = __builtin_amdgcn_readfirstlane(t_ >> 6); \
        size_t z_ = 0; asm volatile("" : "+s"(z_)); F.ws = args.ws + z_; F.ctl = (gu32*)(F.ws + WS_CTL); F.X = args.out + z_; } while (0)

template <int L> __device__ __forceinline__ void layer_steps(const Args& args, Frame& F, const XcdBarrier& bar, const int lo, const int hi) {
    constexpr int l = L;
        constexpr int base = NSTEP_PRO + l * NSTEP_LAYER; constexpr bool moe = (l & 1) != 0;
        if (IN(base + 0)) { FRESH();
            pg8::Gemm g{(const pg8::bf16_t*)(F.ws + WS_H), (const pg8::bf16_t*)(F.ws + WS_WIN), M, NU, D}; pg8::StaticOrder S; S.init(M, NU, F.G, (int)blockIdx.x);
            pg8::EpiU E{(pg8::bf16_t*)(F.ws + WS_U), NU, 2, INPROJ_FP8 ? C2 / 32.f : C2, INPROJ_FP8 ? 1.f / 32.f : 1.f};
            pg8::gemm_phase<pg8::EpiU, pg8::StaticOrder, true, true, INPROJ_FP8 != 0>(F.lds + RING_OFF, g, S, E, F.tid);
        }
        SEAM(base + 0);
        if (IN(base + 1)) { FRESH(); ph_compress(args, F, l); FRESH(); ph_conv(args, F, l); }
        SEAM(base + 1);
        if (IN(base + 2)) { FRESH();
#ifdef USE_NAIVE_ATTN
            ph_attn_naive(args, F, l);
#else
            ph_attn(args, F, l);
#endif
        }
        SEAM(base + 2);
        if (IN(base + 3)) { FRESH();
            pg8::Gemm g{(const pg8::bf16_t*)(F.ws + WS_CAT), (const pg8::bf16_t*)(F.ws + WS_WO), M, D, D}; pg8::StaticOrder S; S.init(M, D, F.G, (int)blockIdx.x);
            pg8::EpiBf E{(pg8::bf16_t*)(F.ws + WS_Y), D, 4, 1.f};
            pg8::gemm_phase<pg8::EpiBf, pg8::StaticOrder, true, true>(F.lds + RING_OFF, g, S, E, F.tid);
        }
        SEAM(base + 3);
        if (IN(base + 4)) { FRESH(); ph_ln1(args, F, l); }
        SEAM(base + 4);
        if (IN(base + 5)) { FRESH();
            pg8::MoeOrder S;
            if constexpr (moe) S.init_moe((unsigned*)(F.ctl + CW_CNT) + (l >> 1) * 8 * 64, 2 * FFE / 256, F.G, (int)blockIdx.x, 1); else S.init_dense(M / 256, 2 * FF / 256, F.G, (int)blockIdx.x);
            pg8::Gemm g{(const pg8::bf16_t*)(F.ws + (moe ? WS_HG : WS_H)), (const pg8::bf16_t*)(F.ws + WS_W1), M, 0, D};
            if constexpr (moe || dense_up8(l)) { pg8::EpiSwiGLU8 E{(unsigned char*)(F.ws + WS_HID), moe ? FFE : FF, moe ? 2 * FFE / 256 : 2 * FF / 256, 1.f / 32.f};
                pg8::gemm_phase<pg8::EpiSwiGLU8, pg8::MoeOrder, true, true, true>(F.lds + RING_OFF, g, S, E, F.tid); }
            else if constexpr (DENSE_FP8 == 2) { pg8::EpiSwiGLU8 E{(unsigned char*)(F.ws + WS_HID), FF, 2 * FF / 256, 1.f};
                pg8::gemm_phase<pg8::EpiSwiGLU8, pg8::MoeOrder, true, true>(F.lds + RING_OFF, g, S, E, F.tid); }
            else { pg8::EpiSwiGLU E{(pg8::bf16_t*)(F.ws + WS_HID), FF, 2 * FF / 256};
                pg8::gemm_phase<pg8::EpiSwiGLU, pg8::MoeOrder, true, true>(F.lds + RING_OFF, g, S, E, F.tid); }
        }
        SEAM(base + 5);
        if (IN(base + 6)) { FRESH();
            pg8::MoeOrder S;
            if constexpr (moe) S.init_moe((unsigned*)(F.ctl + CW_CNT) + (l >> 1) * 8 * 64, 4, F.G, (int)blockIdx.x, 0); else S.init_dense(M / 256, 4, F.G, (int)blockIdx.x);
            pg8::Gemm g{(const pg8::bf16_t*)(F.ws + WS_HID), (const pg8::bf16_t*)(F.ws + WS_W2), M, D, moe ? FFE : FF};
            if constexpr (moe) {
                const int n_units = S.so.nwg, n_full = (n_units / F.G) * F.G, tail = n_units - n_full;
                const int chunks = tail == 0 ? 1 : (tail * 7 <= F.G ? 7 : (tail * 2 <= F.G ? 2 : 1));
                if (chunks > 1) S.so.nwg = n_full;
                { pg8::EpiBf E{(pg8::bf16_t*)(F.ws + WS_Y2), D, 4, 1.f / 128.f};
                  pg8::gemm_phase<pg8::EpiBf, pg8::MoeOrder, true, true, true>(F.lds + RING_OFF, g, S, E, F.tid); }
                if (chunks > 1) {
                    asm volatile("s_waitcnt vmcnt(0) lgkmcnt(0)" ::: "memory"); __syncthreads();
                    FRESH();
                    const int kb = FFE / chunks;
                    pg8::OneUnit S1; S1.have = 0; S1.u.pm = 0; S1.u.pn = 0; S1.u.pa = 0; int cch = 0;
                    if ((int)blockIdx.x < tail * chunks) { const int tu = (int)blockIdx.x / chunks; cch = (int)blockIdx.x % chunks; pg8::Unit t; S.unit_of(n_full + tu, t);
                        S1.have = 1; S1.u.pm = tu * chunks + cch; S1.u.pn = t.pn; S1.u.pa = t.pa; }
                    pg8::Gemm g1{(const pg8::bf16_t*)(F.ws + WS_HID + (size_t)cch * kb), (const pg8::bf16_t*)(F.ws + WS_W2 + (size_t)cch * kb), M, D, kb, FFE};
                    pg8::EpiF32P E1{(float*)(F.ws + WS_H), 256};
                    pg8::gemm_phase<pg8::EpiF32P, pg8::OneUnit, true, true, true>(F.lds + RING_OFF, g1, S1, E1, F.tid);
                    xcd_barrier(bar);
                    FRESH();
                    { const float* Pp = (const float*)(F.ws + WS_H); bf16* Y2o = (bf16*)(F.ws + WS_Y2);
                      const int gw = (int)blockIdx.x * NWAVES + F.wave, NGW = F.G * NWAVES;
                      for (int rr = gw; rr < tail * 256; rr += NGW) { const int tu = rr >> 8, r = rr & 255; pg8::Unit t; S.unit_of(n_full + tu, t);
                          f32x4 a = {0.f, 0.f, 0.f, 0.f};
                          for (int c2 = 0; c2 < chunks; ++c2) a += *((const f32x4*)(Pp + ((size_t)(tu * chunks + c2) * 256 + r) * 256) + F.lane);
                          a = a * (1.f / 128.f);
                          *((unsigned long long*)(Y2o + ((size_t)t.pm * 256 + r) * D + (t.pn & 3) * 256) + F.lane) = (unsigned long long)pk2(a.x, a.y) | ((unsigned long long)pk2(a.z, a.w) << 32); } }
                }
            } else if constexpr (DENSE_FP8 != 0) { pg8::EpiBf E{(pg8::bf16_t*)(F.ws + WS_Y), D, 4, 1.f / 128.f};
                pg8::gemm_phase<pg8::EpiBf, pg8::MoeOrder, true, true, true>(F.lds + RING_OFF, g, S, E, F.tid); }
            else { pg8::EpiBf E{(pg8::bf16_t*)(F.ws + WS_Y), D, 4, 1.f};
                pg8::gemm_phase<pg8::EpiBf, pg8::MoeOrder, true, true>(F.lds + RING_OFF, g, S, E, F.tid); }
        }
        SEAM(base + 6);
        if (IN(base + 7)) { FRESH(); ph_ln2(args, F, l); FRESH(); if (l + 1 < DEPTH) ph_cvt(args, F, l + 1); }
        SEAM(base + 7);
}
__global__ void __launch_bounds__(NWAVES * 64, 2) fwd(Args args) {
    extern __shared__ __attribute__((aligned(16))) unsigned char lds[];
    Frame F;
    F.lds = (LAS unsigned char*)lds;
    F.MISC = (volatile LAS unsigned*)(F.lds + MISC_OFF);
    F.tid = threadIdx.x; F.lane = F.tid & 63; F.wave = __builtin_amdgcn_readfirstlane(F.tid >> 6); F.wave0 = F.wave;
    F.G = gridDim.x;
    F.ws = args.ws; F.ctl = (gu32*)(args.ws + WS_CTL); F.X = args.out;
    for (int u = F.tid; u < (LDS_BYTES - LDSCTL_OFF) / 4; u += NWAVES * 64) ((LAS unsigned*)(F.lds + LDSCTL_OFF))[u] = 0u;
    __syncthreads();
    const int lo = args.ph_lo, hi = args.ph_hi;
    XcdBarrier bar; bar.bar = (unsigned*)(F.ctl + CW_BAR); bar.x = 0; bar.st = nullptr; bar.w0 = F.wave0;
    if (hi - lo > 1) { bar = xcd_barrier_post((unsigned*)(F.ctl + CW_BAR), F.MISC + 8); bar.w0 = F.wave0; }
    if (IN(0)) { ph_ada(args, F); ph_tbl(args, F); ph_cvt(args, F, 0); }
    SEAM(0);
    if (IN(1)) { ph_mod0(args, F); }
    SEAM(1);
    layer_steps<0>(args, F, bar, lo, hi); layer_steps<1>(args, F, bar, lo, hi); layer_steps<2>(args, F, bar, lo, hi); layer_steps<3>(args, F, bar, lo, hi);
#undef IN
#undef SEAM
}

extern "C" void kernel_launch(void* const* d_in, const int* in_sizes, int n_in, void* d_out, int out_size, void* d_ws, size_t ws_size, hipStream_t stream) {
    static int grid = 0;
    if (grid == 0) {
        if (n_in != 21 || out_size != M * D || ws_size < WS_END) { fprintf(stderr, "kernel_launch: unexpected shapes (n_in %d out %d ws %zu)\n", n_in, out_size, ws_size); grid = -1; return; }
        int dev = 0, cus = 0, per_cu = 0;
        if (hipGetDevice(&dev) != hipSuccess || hipDeviceGetAttribute(&cus, hipDeviceAttributeMultiprocessorCount, dev) != hipSuccess) { grid = -1; return; }
        if (hipFuncSetAttribute((const void*)fwd, hipFuncAttributeMaxDynamicSharedMemorySize, LDS_BYTES) != hipSuccess) { fprintf(stderr, "kernel_launch: hipFuncSetAttribute failed\n"); grid = -1; return; }
        if (hipOccupancyMaxActiveBlocksPerMultiprocessor(&per_cu, (const void*)fwd, NWAVES * 64, LDS_BYTES) != hipSuccess || per_cu < 1) fprintf(stderr, "kernel_launch: occupancy query reports %d\n", per_cu);
        (void)hipGetLastError();
        grid = cus;
    }
    if (grid < 0) return;
    (void)in_sizes;
    if (hipMemsetAsync((char*)d_ws + WS_CTL, 0, CTL_ZERO_BYTES, stream) != hipSuccess) return;
    Args a{};
    for (int i = 0; i < 21; ++i) a.in[i] = (const float*)d_in[i];
    a.out = (float*)d_out; a.ws = (unsigned char*)d_ws;
#ifndef MK_ONE_LAUNCH
    for (int s = 0; s < NSTEPS; ++s) { a.ph_lo = s; a.ph_hi = s + 1; hipLaunchKernelGGL(fwd, dim3(grid), dim3(NWAVES * 64), LDS_BYTES, stream, a); }
#else
    a.ph_lo = 0; a.ph_hi = NSTEPS; hipLaunchKernelGGL(fwd, dim3(grid), dim3(NWAVES * 64), LDS_BYTES, stream, a);
#endif
}
```

```cpp
#define MK_ONE_LAUNCH 1
#include <hip/hip_runtime.h>
#include <cstdio>
#include <cstdint>
#include <cmath>
namespace pg8 {
#define PG8_LAS __attribute__((address_space(3)))
typedef unsigned short bf16_t;
typedef short bf16x8 __attribute__((ext_vector_type(8)));
typedef float f32x4 __attribute__((ext_vector_type(4)));
typedef unsigned u32x4 __attribute__((ext_vector_type(4)));
constexpr int BM = 256, BK = 64, HALF = 128, HTB = HALF * BK * 2  , STAGE_BYTES = 8 * HTB, NXCD = 8, WGM = 8;

__host__ __device__ __forceinline__ int lds_byte(int r, int c) { const int st = (r >> 4) * 2 + (c >> 5), rr = r & 15, cc = c & 31, ob = rr * 64 + cc * 2; return st * 1024 + (ob ^ (((ob >> 9) & 1) << 5)); }
__host__ __device__ __forceinline__ void stage_rc(int b, int& R, int& C) { const int st = b / 1024, sb = b % 1024, swz = sb ^ (((sb >> 9) & 1) << 5); R = (st >> 1) * 16 + swz / 64; C = (st & 1) * 32 + (swz % 64) / 2; }
__host__ __device__ __forceinline__ int perm32(int rho) { const int n = rho >> 4, i = rho & 15; return 8 * (i >> 2) + 4 * n + (i & 3); }

struct Unit { int pm, pn, pa; };
struct Gemm { const bf16_t* A; const bf16_t* Bt; int M, N, K; int ldk; };

struct StaticOrder {
    int nM, nN, nwg, G, c;
    __host__ __device__ void init(int M, int N, int G_, int c_) { nM = M / BM; nN = N / BM; nwg = nM * nN; G = G_; c = c_; }
    __host__ __device__ bool next(int i, Unit& u) const {
        const long L = (long)i * G + c; if (L >= nwg) return false;
        int wgid = (int)L; { const int q = nwg / NXCD, r = nwg % NXCD, xcd = wgid % NXCD, off = wgid / NXCD; wgid = (xcd < r ? xcd * (q + 1) : r * (q + 1) + (xcd - r) * q) + off; }
        const int nig = WGM * nN, gid = wgid / nig, fm = gid * WGM, gsz = (nM - fm) < WGM ? (nM - fm) : WGM;
        u.pm = fm + ((wgid % nig) % gsz); u.pn = (wgid % nig) / gsz; u.pa = u.pm; return true;
    }
    __device__ __forceinline__ void a_ready(const Unit&) const {}
    __device__ __forceinline__ void done(const Unit&) const {}
};


__device__ __forceinline__ unsigned cvt_pk_bf16(float lo, float hi) { unsigned r; asm volatile("v_cvt_pk_bf16_f32 %0, %1, %2" : "=v"(r) : "v"(lo), "v"(hi)); return r; }

struct EpiU {
    static constexpr bool PERM = true, AFTER_DRAIN = false;
    bf16_t* O; int ldc; int nscale; float scale0, scale1;
    __device__ __forceinline__ void operator()(const f32x4 (&acc)[2][2][4][2], const Unit& u, int wr, int wc, int fr, int fq) const {
        const int row0 = u.pm * BM + wr * 64 + fr; const int col0 = u.pn * BM + wc * 32 + 8 * fq;
        const float sc = (u.pn < nscale) ? scale0 : scale1;
#pragma unroll
        for (int ai = 0; ai < 2; ++ai)
#pragma unroll
            for (int m = 0; m < 4; ++m) { bf16_t* rowp = O + (size_t)(row0 + ai * HALF + m * 16) * ldc + col0;
#pragma unroll
                for (int bj = 0; bj < 2; ++bj) { f32x4 v0 = acc[ai][bj][m][0] * sc, v1 = acc[ai][bj][m][1] * sc;
                    u32x4 w; w.x = cvt_pk_bf16(v0[0], v0[1]); w.y = cvt_pk_bf16(v0[2], v0[3]); w.z = cvt_pk_bf16(v1[0], v1[1]); w.w = cvt_pk_bf16(v1[2], v1[3]);
                    *(u32x4*)(rowp + bj * HALF) = w; } }
    }
};
__device__ __forceinline__ float silu_f(float x) { return x * __builtin_amdgcn_rcpf(1.f + __builtin_amdgcn_exp2f(-1.4426950408889634f * x)); }
struct EpiSwiGLU {
    static constexpr bool PERM = true, AFTER_DRAIN = false;
    bf16_t* O; int ldo; int nNl;
    __device__ __forceinline__ void operator()(const f32x4 (&acc)[2][2][4][2], const Unit& u, int wr, int wc, int fr, int fq) const {
        const int row0 = u.pm * BM + wr * 64 + fr; const int hc0 = (u.pn % nNl) * HALF + wc * 32 + 8 * fq;
#pragma unroll
        for (int ai = 0; ai < 2; ++ai)
#pragma unroll
            for (int m = 0; m < 4; ++m) { bf16_t* rowp = O + (size_t)(row0 + ai * HALF + m * 16) * ldo + hc0;
                const f32x4 g0 = acc[ai][0][m][0], g1 = acc[ai][0][m][1], u0 = acc[ai][1][m][0], u1 = acc[ai][1][m][1];
                u32x4 w; w.x = cvt_pk_bf16(silu_f(g0[0]) * u0[0], silu_f(g0[1]) * u0[1]); w.y = cvt_pk_bf16(silu_f(g0[2]) * u0[2], silu_f(g0[3]) * u0[3]);
                w.z = cvt_pk_bf16(silu_f(g1[0]) * u1[0], silu_f(g1[1]) * u1[1]); w.w = cvt_pk_bf16(silu_f(g1[2]) * u1[2], silu_f(g1[3]) * u1[3]);
                *(u32x4*)rowp = w; }
    }
};
__device__ __forceinline__ f32x4 swiglu4(const f32x4 g, const f32x4 u, const float s) {
    const f32x4 t = g * (-1.4426950408889634f * s);
    f32x4 e; e[0] = __builtin_amdgcn_exp2f(t[0]); e[1] = __builtin_amdgcn_exp2f(t[1]); e[2] = __builtin_amdgcn_exp2f(t[2]); e[3] = __builtin_amdgcn_exp2f(t[3]);
    const f32x4 d = e + 1.f;
    f32x4 r; r[0] = __builtin_amdgcn_rcpf(d[0]); r[1] = __builtin_amdgcn_rcpf(d[1]); r[2] = __builtin_amdgcn_rcpf(d[2]); r[3] = __builtin_amdgcn_rcpf(d[3]);
    return (g * u) * (r * (s * s));
}
struct EpiSwiGLU8 {
    static constexpr bool PERM = true, AFTER_DRAIN = false;
    unsigned char* O; int ldo; int nNl; float s;
    __device__ __forceinline__ void operator()(const f32x4 (&acc)[2][2][4][2], const Unit& u, int wr, int wc, int fr, int fq) const {
        const int row0 = u.pm * BM + wr * 64 + fr; const int hc0 = (u.pn % nNl) * HALF + wc * 32 + 8 * fq;
        typedef unsigned u32x2 __attribute__((ext_vector_type(2)));
#pragma unroll
        for (int ai = 0; ai < 2; ++ai)
#pragma unroll
            for (int m = 0; m < 4; ++m) { unsigned char* rowp = O + (size_t)(row0 + ai * HALF + m * 16) * ldo + hc0;
                const f32x4 h0 = swiglu4(acc[ai][0][m][0], acc[ai][1][m][0], s), h1 = swiglu4(acc[ai][0][m][1], acc[ai][1][m][1], s);
                int p0 = __builtin_amdgcn_cvt_pk_fp8_f32(h0[0], h0[1], 0, false); p0 = __builtin_amdgcn_cvt_pk_fp8_f32(h0[2], h0[3], p0, true);
                int p1 = __builtin_amdgcn_cvt_pk_fp8_f32(h1[0], h1[1], 0, false); p1 = __builtin_amdgcn_cvt_pk_fp8_f32(h1[2], h1[3], p1, true);
                u32x2 w; w.x = (unsigned)p0; w.y = (unsigned)p1; *(u32x2*)rowp = w; __builtin_amdgcn_sched_barrier(0); }
    }
};
struct EpiBf {
    static constexpr bool PERM = true, AFTER_DRAIN = false;
    bf16_t* O; int ldc; int nNl; float s;
    __device__ __forceinline__ void operator()(const f32x4 (&acc)[2][2][4][2], const Unit& u, int wr, int wc, int fr, int fq) const {
        const int row0 = u.pm * BM + wr * 64 + fr; const int col0 = (u.pn % nNl) * BM + wc * 32 + 8 * fq;
#pragma unroll
        for (int ai = 0; ai < 2; ++ai)
#pragma unroll
            for (int m = 0; m < 4; ++m) { bf16_t* rowp = O + (size_t)(row0 + ai * HALF + m * 16) * ldc + col0;
#pragma unroll
                for (int bj = 0; bj < 2; ++bj) { const f32x4 v0 = acc[ai][bj][m][0] * s, v1 = acc[ai][bj][m][1] * s;
                    u32x4 w; w.x = cvt_pk_bf16(v0[0], v0[1]); w.y = cvt_pk_bf16(v0[2], v0[3]); w.z = cvt_pk_bf16(v1[0], v1[1]); w.w = cvt_pk_bf16(v1[2], v1[3]);
                    *(u32x4*)(rowp + bj * HALF) = w; } }
    }
};
struct EpiF32 {
    static constexpr bool PERM = false, AFTER_DRAIN = false;
    float* O; int ldc; int nNl;
    __device__ __forceinline__ void operator()(const f32x4 (&acc)[2][2][4][2], const Unit& u, int wr, int wc, int fr, int fq) const {
        const int row0 = u.pm * BM + wr * 64 + fr; const int col0 = (u.pn % nNl) * BM + wc * 32 + 4 * fq;
#pragma unroll
        for (int ai = 0; ai < 2; ++ai)
#pragma unroll
            for (int m = 0; m < 4; ++m) { float* rowp = O + (size_t)(row0 + ai * HALF + m * 16) * ldc + col0;
#pragma unroll
                for (int bj = 0; bj < 2; ++bj)
#pragma unroll
                    for (int n = 0; n < 2; ++n) *(f32x4*)(rowp + bj * HALF + n * 16) = acc[ai][bj][m][n]; }
    }
};
struct EpiF32P {
    static constexpr bool PERM = true, AFTER_DRAIN = false;
    float* O; int ldc;
    __device__ __forceinline__ void operator()(const f32x4 (&acc)[2][2][4][2], const Unit& u, int wr, int wc, int fr, int fq) const {
        const int row0 = u.pm * BM + wr * 64 + fr; const int col0 = wc * 32 + 8 * fq;
#pragma unroll
        for (int ai = 0; ai < 2; ++ai)
#pragma unroll
            for (int m = 0; m < 4; ++m) { float* rowp = O + (size_t)(row0 + ai * HALF + m * 16) * ldc + col0;
#pragma unroll
                for (int bj = 0; bj < 2; ++bj) { *(f32x4*)(rowp + bj * HALF) = acc[ai][bj][m][0]; *(f32x4*)(rowp + bj * HALF + 4) = acc[ai][bj][m][1]; } }
    }
};
struct OneUnit {
    Unit u; int have;
    __device__ __forceinline__ bool next(int i, Unit& o) const { if (i != 0 || !have) return false; o = u; return true; }
    __device__ __forceinline__ void a_ready(const Unit&) const {}
    __device__ __forceinline__ void done(const Unit&) const {}
};
struct MoeOrder {
    StaticOrder so; int P1, P2, P3, P4, P5, P6, P7; int nNl, a_sparse;
    __device__ __forceinline__ void init_dense(int nM, int nNl_, int G, int c) { so.nM = nM; so.nN = nNl_; so.nwg = nM * nNl_; so.G = G; so.c = c; nNl = nNl_; a_sparse = 0; P1 = P2 = P3 = P4 = P5 = P6 = P7 = nM; }
    __device__ __forceinline__ void init_moe(const unsigned* cnt  , int nNl_, int G, int c, int a_sparse_) {
        int p = 0; p += ((int)cnt[0] + 255) >> 8; P1 = p; p += ((int)cnt[64] + 255) >> 8; P2 = p; p += ((int)cnt[128] + 255) >> 8; P3 = p; p += ((int)cnt[192] + 255) >> 8; P4 = p;
        p += ((int)cnt[256] + 255) >> 8; P5 = p; p += ((int)cnt[320] + 255) >> 8; P6 = p; p += ((int)cnt[384] + 255) >> 8; P7 = p; p += ((int)cnt[448] + 255) >> 8;
        so.nM = p; so.nN = nNl_; so.nwg = p * nNl_; so.G = G; so.c = c; nNl = nNl_; a_sparse = a_sparse_;
    }
    __device__ __forceinline__ bool next(int i, Unit& u) const {
        if (!so.next(i, u)) return false;
        int e = 0, pe = 0;
        if (u.pm >= P1) { e = 1; pe = P1; } if (u.pm >= P2) { e = 2; pe = P2; } if (u.pm >= P3) { e = 3; pe = P3; } if (u.pm >= P4) { e = 4; pe = P4; }
        if (u.pm >= P5) { e = 5; pe = P5; } if (u.pm >= P6) { e = 6; pe = P6; } if (u.pm >= P7) { e = 7; pe = P7; }
        u.pa = a_sparse ? e * 128 + (u.pm - pe) : u.pm; u.pn = e * nNl + u.pn; return true;
    }
    __device__ __forceinline__ void unit_of(int wgid, Unit& u) const {
        const int nig = WGM * so.nN, gid = wgid / nig, fm = gid * WGM, gsz = (so.nM - fm) < WGM ? (so.nM - fm) : WGM;
        u.pm = fm + ((wgid % nig) % gsz); u.pn = (wgid % nig) / gsz;
        int e = 0, pe = 0;
        if (u.pm >= P1) { e = 1; pe = P1; } if (u.pm >= P2) { e = 2; pe = P2; } if (u.pm >= P3) { e = 3; pe = P3; } if (u.pm >= P4) { e = 4; pe = P4; }
        if (u.pm >= P5) { e = 5; pe = P5; } if (u.pm >= P6) { e = 6; pe = P6; } if (u.pm >= P7) { e = 7; pe = P7; }
        u.pa = a_sparse ? e * 128 + (u.pm - pe) : u.pm; u.pn = e * nNl + u.pn;
    }
    __device__ __forceinline__ void a_ready(const Unit&) const {}
    __device__ __forceinline__ void done(const Unit&) const {}
};
template <class Epi, class Sched, bool ALIGN_EPI = false, bool SP2 = false, bool FP8 = false>
__device__ __forceinline__ void gemm_phase(PG8_LAS unsigned char* lds, const Gemm g, const Sched& S, const Epi& E, int tid_) {
    asm volatile("" : "+v"(tid_));
    const int tid = tid_, wid = __builtin_amdgcn_readfirstlane(tid >> 6), lane = tid & 63, wr = wid >> 2, wc = wid & 3, fr = lane & 15, fq = lane >> 4;
    int K_ = g.K; asm volatile("" : "+s"(K_));
    const int K = K_, nt = FP8 ? K / 128 : K / BK; const int RB = g.ldk ? g.ldk : (FP8 ? K : 2 * K);
    unsigned voffA[2], voffB[2];
#pragma unroll
    for (int i = 0; i < 2; ++i) { int R, C; stage_rc(tid * 16 + i * 8192, R, C); const int Rb = Epi::PERM ? ((R & ~31) + perm32(R & 31)) : R;
        voffA[i] = (unsigned)(R * RB + C * 2); voffB[i] = (unsigned)(Rb * RB + C * 2); }
    const size_t kstep = (size_t)(BK * 2);
    const size_t hstep = (size_t)HALF * RB;
    const size_t tstep = 2 * hstep;
    const unsigned ldsw = (unsigned)wid * 1024u;
    const int aoff = lds_byte(wr * 64 + fr, fq * 8), boff = lds_byte(wc * 32 + fr, fq * 8);
#define PG8_SA(b, h) (((b) * 2 + (h)) * HTB)
#define PG8_SB(b, h) ((4 + (b) * 2 + (h)) * HTB)
#define PG8_STAGE(bufoff, gbase, voff) do { _Pragma("unroll") for (int _i = 0; _i < 2; ++_i) \
        __builtin_amdgcn_global_load_lds((const unsigned*)((const char*)(gbase) + (voff)[_i]), (PG8_LAS unsigned*)(lds + (bufoff) + ldsw + _i * 8192), 16, 0, 0); } while (0)
#define PG8_LDA(dst, b, h) do { if constexpr (FP8) { _Pragma("unroll") for (int m = 0; m < 4; ++m) { dst##8[m].lo = *(const PG8_LAS v4i_t*)(lds + PG8_SA(b, h) + aoff + m * 2048); dst##8[m].hi = *(const PG8_LAS v4i_t*)(lds + PG8_SA(b, h) + aoff + m * 2048 + 1024); } } \
        else { _Pragma("unroll") for (int m = 0; m < 4; ++m) _Pragma("unroll") for (int k = 0; k < 2; ++k) dst[m][k] = *(const PG8_LAS bf16x8*)(lds + PG8_SA(b, h) + aoff + m * 2048 + k * 1024); } } while (0)
#define PG8_LDB(dst, b, h) do { if constexpr (FP8) { _Pragma("unroll") for (int n = 0; n < 2; ++n) { dst##8[n].lo = *(const PG8_LAS v4i_t*)(lds + PG8_SB(b, h) + boff + n * 2048); dst##8[n].hi = *(const PG8_LAS v4i_t*)(lds + PG8_SB(b, h) + boff + n * 2048 + 1024); } } \
        else { _Pragma("unroll") for (int n = 0; n < 2; ++n) _Pragma("unroll") for (int k = 0; k < 2; ++k) dst[n][k] = *(const PG8_LAS bf16x8*)(lds + PG8_SB(b, h) + boff + n * 2048 + k * 1024); } } while (0)
#define PG8_MMA(ai, bj, At, Bt) do { __builtin_amdgcn_s_setprio(1); \
        if constexpr (FP8) { _Pragma("unroll") for (int m = 0; m < 4; ++m) _Pragma("unroll") for (int n = 0; n < 2; ++n) \
            asm volatile("v_mfma_scale_f32_16x16x128_f8f6f4 %0, %1, %2, %0, %3, %3 op_sel_hi:[0,0,0]" : "+v"(acc[ai][bj][m][n]) : "v"(Bt##8[n]), "v"(At##8[m]), "v"(scl8)); } \
        else { _Pragma("unroll") for (int m = 0; m < 4; ++m) _Pragma("unroll") for (int n = 0; n < 2; ++n) _Pragma("unroll") for (int k = 0; k < 2; ++k) \
            acc[ai][bj][m][n] = __builtin_amdgcn_mfma_f32_16x16x32_bf16(Bt[n][k], At[m][k], acc[ai][bj][m][n], 0, 0, 0); } __builtin_amdgcn_s_setprio(0); } while (0)
#define PG8_WAIT_V(n) asm volatile("s_waitcnt vmcnt(" #n ")" ::: "memory")
#define PG8_WAIT_L(n) asm volatile("s_waitcnt lgkmcnt(" #n ")" ::: "memory")
#define PG8_BAR __builtin_amdgcn_s_barrier()
#define PG8_SCHED __builtin_amdgcn_sched_barrier(0)
    Unit cur, nxt; int ui = 0;
    if (!S.next(0, cur)) return;
    f32x4 acc[2][2][4][2];
#pragma unroll
    for (int a = 0; a < 2; ++a)
#pragma unroll
        for (int b = 0; b < 2; ++b)
#pragma unroll
            for (int m = 0; m < 4; ++m)
#pragma unroll
                for (int n = 0; n < 2; ++n) acc[a][b][m][n] = (f32x4){0.f, 0.f, 0.f, 0.f};
    typedef int v4i_t __attribute__((ext_vector_type(4))); typedef int v8i_t __attribute__((ext_vector_type(8)));
    int scl8 = 0x7F7F7F7F; asm volatile("" : "+v"(scl8));
    bf16x8 At[4][2], B0[2][2], B1[2][2]; v8i_t At8[4], B08[2], B18[2];
    const char* cA = (const char*)g.A + (size_t)cur.pa * tstep; const char* cB = (const char*)g.Bt + (size_t)cur.pn * tstep;
    S.a_ready(cur);
    if constexpr (SP2) {
        PG8_STAGE(PG8_SB(0, 0), cB, voffB); PG8_STAGE(PG8_SB(0, 1), cB + hstep, voffB); PG8_STAGE(PG8_SA(0, 0), cA, voffA); PG8_STAGE(PG8_SA(0, 1), cA + hstep, voffA);
        if (wr == 1) PG8_BAR;
        PG8_WAIT_V(2); PG8_BAR;
        PG8_STAGE(PG8_SB(1, 0), cB + kstep, voffB); PG8_STAGE(PG8_SA(1, 0), cA + kstep, voffA); PG8_STAGE(PG8_SB(1, 1), cB + hstep + kstep, voffB);
        PG8_WAIT_V(6); PG8_BAR;
    } else {
        PG8_STAGE(PG8_SB(0, 0), cB, voffB); PG8_STAGE(PG8_SA(0, 0), cA, voffA); PG8_STAGE(PG8_SB(0, 1), cB + hstep, voffB); PG8_STAGE(PG8_SA(0, 1), cA + hstep, voffA);
        if (wr == 1) PG8_BAR;
        PG8_WAIT_V(4); PG8_BAR;
        PG8_STAGE(PG8_SB(1, 0), cB + kstep, voffB); PG8_STAGE(PG8_SA(1, 0), cA + kstep, voffA); PG8_STAGE(PG8_SB(1, 1), cB + hstep + kstep, voffB);
        PG8_WAIT_V(6); PG8_BAR;
    }
    for (;;) {
        const bool has_next = S.next(ui + 1, nxt);
        const char* nA = has_next ? (const char*)g.A + (size_t)nxt.pa * tstep : cA; const char* nB = has_next ? (const char*)g.Bt + (size_t)nxt.pn * tstep : cB;
#pragma unroll 1
        for (int t = 0; t < nt; t += 2) {
            const bool last = (t == nt - 2);
            const char* a1 = cA + (size_t)(t + 1) * kstep;
            const char* a2 = last ? nA : cA + (size_t)(t + 2) * kstep; const char* b2 = last ? nB : cB + (size_t)(t + 2) * kstep;
            const char* a3 = a2 + kstep; const char* b3 = b2 + kstep;
            if (last && has_next) S.a_ready(nxt);
            if constexpr (SP2) {
            PG8_LDB(B0, 0, 0); PG8_LDB(B1, 0, 1); PG8_SCHED; PG8_LDA(At, 0, 0); PG8_STAGE(PG8_SA(1, 1), a1 + hstep, voffA);
            PG8_WAIT_V(8); PG8_WAIT_L(0); PG8_BAR; PG8_MMA(0, 0, At, B0); PG8_MMA(0, 1, At, B1); PG8_BAR; PG8_SCHED;
            PG8_LDA(At, 0, 1); PG8_STAGE(PG8_SB(0, 0), b2, voffB); PG8_STAGE(PG8_SB(0, 1), b2 + hstep, voffB); PG8_STAGE(PG8_SA(0, 0), a2, voffA);
            PG8_WAIT_V(8); PG8_WAIT_L(0); PG8_BAR; PG8_MMA(1, 0, At, B0); PG8_MMA(1, 1, At, B1); PG8_BAR; PG8_SCHED;
            PG8_LDB(B0, 1, 0); PG8_LDB(B1, 1, 1); PG8_SCHED; PG8_LDA(At, 1, 0); PG8_STAGE(PG8_SA(0, 1), a2 + hstep, voffA);
            PG8_WAIT_V(8); PG8_WAIT_L(0); PG8_BAR; PG8_MMA(0, 0, At, B0); PG8_MMA(0, 1, At, B1); PG8_BAR; PG8_SCHED;
            PG8_LDA(At, 1, 1); PG8_STAGE(PG8_SB(1, 0), b3, voffB); PG8_STAGE(PG8_SB(1, 1), b3 + hstep, voffB); PG8_STAGE(PG8_SA(1, 0), a3, voffA);
            PG8_WAIT_V(8); PG8_WAIT_L(0); PG8_BAR; PG8_MMA(1, 0, At, B0); PG8_MMA(1, 1, At, B1); PG8_BAR; PG8_SCHED;
            } else {
            PG8_LDB(B0, 0, 0); PG8_SCHED; PG8_LDA(At, 0, 0); PG8_STAGE(PG8_SA(1, 1), a1 + hstep, voffA);
            PG8_WAIT_L(8); PG8_BAR; PG8_WAIT_L(0); PG8_MMA(0, 0, At, B0); PG8_BAR; PG8_SCHED;
            PG8_LDB(B1, 0, 1); PG8_STAGE(PG8_SB(0, 0), b2, voffB);
            PG8_BAR; PG8_WAIT_L(0); PG8_MMA(0, 1, At, B1); PG8_BAR;
            PG8_LDA(At, 0, 1); PG8_STAGE(PG8_SA(0, 0), a2, voffA);
            PG8_BAR; PG8_WAIT_L(0); PG8_MMA(1, 0, At, B0); PG8_BAR; PG8_SCHED;
            PG8_STAGE(PG8_SB(0, 1), b2 + hstep, voffB);
            PG8_WAIT_V(6); PG8_BAR; PG8_MMA(1, 1, At, B1); PG8_BAR;
            PG8_LDB(B0, 1, 0); PG8_SCHED; PG8_LDA(At, 1, 0); PG8_STAGE(PG8_SA(0, 1), a2 + hstep, voffA);
            PG8_WAIT_L(8); PG8_BAR; PG8_WAIT_L(0); PG8_MMA(0, 0, At, B0); PG8_BAR; PG8_SCHED;
            PG8_LDB(B1, 1, 1); PG8_STAGE(PG8_SB(1, 0), b3, voffB);
            PG8_BAR; PG8_WAIT_L(0); PG8_MMA(0, 1, At, B1); PG8_BAR;
            PG8_LDA(At, 1, 1); PG8_STAGE(PG8_SA(1, 0), a3, voffA);
            PG8_BAR; PG8_WAIT_L(0); PG8_MMA(1, 0, At, B0); PG8_BAR; PG8_SCHED;
            PG8_STAGE(PG8_SB(1, 1), b3 + hstep, voffB);
            PG8_WAIT_V(6); PG8_BAR; PG8_MMA(1, 1, At, B1); PG8_BAR;
            }
        }
        if constexpr (ALIGN_EPI) { if (wr == 0) PG8_BAR; }
        if constexpr (FP8) asm volatile("s_nop 15\n\ts_nop 15" ::: "memory");
        if constexpr (!Epi::AFTER_DRAIN) { int fr_ = fr, fq_ = fq; asm volatile("" : "+v"(fr_), "+v"(fq_));
            E(acc, cur, wr, wc, fr_, fq_); S.done(cur); }
        if (!has_next) break;
#pragma unroll
        for (int a = 0; a < 2; ++a)
#pragma unroll
            for (int b = 0; b < 2; ++b)
#pragma unroll
                for (int m = 0; m < 4; ++m)
#pragma unroll
                    for (int n = 0; n < 2; ++n) acc[a][b][m][n] = (f32x4){0.f, 0.f, 0.f, 0.f};
        cur = nxt; cA = nA; cB = nB; ++ui;
        if constexpr (ALIGN_EPI) { if (wr == 1) PG8_BAR; }
    }
    PG8_WAIT_V(0);
    if constexpr (!ALIGN_EPI) { if (wr == 0) PG8_BAR; }
    PG8_BAR;
    if constexpr (Epi::AFTER_DRAIN) { E.fused(acc, cur, wr, wc, fr, fq, lds, wid, lane); S.done(cur); }
#undef PG8_SA
#undef PG8_SB
#undef PG8_STAGE
#undef PG8_LDA
#undef PG8_LDB
#undef PG8_MMA
#undef PG8_WAIT_V
#undef PG8_WAIT_L
#undef PG8_BAR
#undef PG8_SCHED
}
}
#define GAS __attribute__((address_space(1)))
#define LAS __attribute__((address_space(3)))
typedef unsigned short bf16;
typedef unsigned v4u __attribute__((ext_vector_type(4)));
typedef float f32x4 __attribute__((ext_vector_type(4)));
typedef short bf16x8 __attribute__((ext_vector_type(8)));
typedef GAS unsigned gu32;
typedef GAS unsigned long long gu64;
#define RLX_AGENT __ATOMIC_RELAXED, __HIP_MEMORY_SCOPE_AGENT
#define LDS_WAIT() asm volatile("s_waitcnt lgkmcnt(0)" ::: "memory")
#define VM_WAIT() asm volatile("s_waitcnt vmcnt(0)" ::: "memory")
__device__ __forceinline__ unsigned long long rt() { return __builtin_amdgcn_s_memrealtime(); }
__device__ __forceinline__ unsigned f2bf(float f) { unsigned u = __builtin_bit_cast(unsigned, f); return (u + 0x7fffu + ((u >> 16) & 1u)) >> 16; }
__device__ __forceinline__ unsigned pk2(float lo, float hi) { return f2bf(lo) | (f2bf(hi) << 16); }

#define XB_TMO      128
#define XB_XCNT(j)  (256  + 64 * (j))
#define XB_XSUB(j)  (1280 + 64 * (j))
#define XB_XGEN(j)  (2304 + 64 * (j))
#define XB_TOP      3328
#define XB_TOPGEN   3392
#define XCD_BAR_WORDS 3456
#define XB_SPIN_CAP (1u << 18)

__device__ __forceinline__ unsigned xb_ld(unsigned* p)              { return __hip_atomic_load(p, __ATOMIC_RELAXED, __HIP_MEMORY_SCOPE_AGENT); }
__device__ __forceinline__ unsigned xb_add(unsigned* p, unsigned v) { return __hip_atomic_fetch_add(p, v, __ATOMIC_RELAXED, __HIP_MEMORY_SCOPE_AGENT); }
__device__ __forceinline__ unsigned xb_xcc_id() { return (unsigned)__builtin_amdgcn_s_getreg((3 << 11) | 20) & 0xFu; }
#define XB_SPIN(cond, bar) do { unsigned _sp = 0; while (cond) { __builtin_amdgcn_s_sleep(1); \
    if ((++_sp & 255u) == 0u) { if (xb_ld(&(bar)[XB_TMO])) break; if (_sp > XB_SPIN_CAP) { atomicAdd(&(bar)[XB_TMO], 1u); break; } } } } while (0)

struct XcdBarrier {
    unsigned* bar; unsigned x;
    volatile LAS unsigned* st;
    int w0;
};
__device__ __forceinline__ bool xb_is_t0(const XcdBarrier& b) { return b.w0 == 0 && __builtin_amdgcn_mbcnt_hi(~0u, __builtin_amdgcn_mbcnt_lo(~0u, 0u)) == 0u; }

__device__ __forceinline__ XcdBarrier xcd_barrier_post(unsigned* bar, volatile LAS unsigned* st) {
    XcdBarrier b; b.bar = bar; b.x = xb_xcc_id(); b.st = st;
    if (threadIdx.x == 0) (void)xb_add(&bar[XB_XCNT(b.x)], 1u);
    return b;
}
__device__ __forceinline__ void xcd_barrier_complete(unsigned* bar, unsigned x, unsigned& nloc, unsigned& nx) {
    const unsigned G = gridDim.x * gridDim.y * gridDim.z;
    unsigned sum, cnt, mine, sp = 0u;
    for (;;) {
        sum = 0u; cnt = 0u; mine = 0u;
#pragma unroll
        for (unsigned j = 0; j < 16; ++j) { const unsigned c = xb_ld(&bar[XB_XCNT(j)]); sum += c; cnt += (c > 0u) ? 1u : 0u; mine = (j == x) ? c : mine; }
        if (sum == G) break;
        __builtin_amdgcn_s_sleep(1);
        if ((++sp & 255u) == 0u) { if (xb_ld(&bar[XB_TMO])) break; if (sp > XB_SPIN_CAP) { atomicAdd(&bar[XB_TMO], 1u); break; } }
    }
    nloc = mine > 0u ? mine : 1u; nx = cnt > 0u ? cnt : 1u;
}

__device__ __forceinline__ void xcd_barrier(const XcdBarrier& b) {
    asm volatile("s_waitcnt vmcnt(0)" ::: "memory");
    __syncthreads();
    if (xb_is_t0(b)) {
        unsigned* bar = b.bar;
        __builtin_amdgcn_s_waitcnt(0);
        unsigned nloc = b.st[0], nx = b.st[1];
        if (nloc == 0u) { xcd_barrier_complete(bar, b.x, nloc, nx); b.st[0] = nloc; b.st[1] = nx; }
        const unsigned old = xb_add(&bar[XB_XSUB(b.x)], 1u);
        const unsigned gen = old / nloc;
        if (old + 1u == (gen + 1u) * nloc) {
            __builtin_amdgcn_fence(__ATOMIC_RELEASE, "agent");
            asm volatile("s_waitcnt vmcnt(0)" ::: "memory");
            const unsigned og = xb_add(&bar[XB_TOP], 1u);
            const unsigned tg = og / nx;
            if (og + 1u == (tg + 1u) * nx) xb_add(&bar[XB_TOPGEN], 1u);
            else XB_SPIN(xb_ld(&bar[XB_TOPGEN]) == tg, bar);
            __builtin_amdgcn_fence(__ATOMIC_ACQUIRE, "agent");
            xb_add(&bar[XB_XGEN(b.x)], 1u);
            asm volatile("s_waitcnt vmcnt(0)" ::: "memory");
        } else {
            XB_SPIN(xb_ld(&bar[XB_XGEN(b.x)]) == gen, bar);
            __builtin_amdgcn_fence(__ATOMIC_ACQUIRE, "agent");
            asm volatile("s_waitcnt vmcnt(0)" ::: "memory");
        }
    }
    __syncthreads();
}

#ifndef DENSE_FP8
#define DENSE_FP8 2
#endif
#ifndef DENSE_UP8_LAYERS
#define DENSE_UP8_LAYERS 0x4
#endif
#ifndef INPROJ_FP8
#define INPROJ_FP8 1
#endif
constexpr int NWAVES = 8;
constexpr int BATCH = 16, T = 2048, D = 1024, M = BATCH * T, DEPTH = 4;
constexpr int NU = 2560;
constexpr int UQ = 0, UKC = 512, UVC = 640, UKS = 768, UVS = 896, UKW = 1024, UVW = 1152, UCA = 1280, UCG = 1792, UGL = 2304;
constexpr int D_IN = 2328;
constexpr int FF = 2816, FFE = 3584, NEXP = 8;
constexpr int NCMP = 127, NCP = 128;
constexpr float LN_EPS = 1e-5f;
constexpr float ALPHA = 1.6817928305074290f;
constexpr float LOG2E = 1.4426950408889634f;
constexpr float C2 = 0.125f * 1.4426950408889634f;
constexpr int ECAP = 32768;

constexpr size_t MiB = 1u << 20;
constexpr size_t WS_CTL = 0, CTL_ZERO_BYTES = 1 * MiB;
constexpr size_t WS_MOD = 1 * MiB;
constexpr size_t WS_TBL = 3 * MiB;
constexpr size_t WS_KCMP = 4 * MiB;
constexpr size_t WS_VCMP = 4 * MiB + 512 * 1024;
constexpr size_t WS_ROUTE = 5 * MiB;
constexpr size_t WS_WCMP = 6 * MiB;
constexpr size_t WS_WIN = 8 * MiB;
constexpr size_t WS_WO = 13 * MiB;
constexpr size_t WS_W1 = 16 * MiB;
constexpr size_t WS_W2 = 128 * MiB;
constexpr size_t WS_H = 184 * MiB;
constexpr size_t WS_CAT = 248 * MiB;
constexpr size_t WS_Y = 312 * MiB;
constexpr size_t WS_U = 440 * MiB;
constexpr size_t WS_Y2 = 312 * MiB;
constexpr size_t WS_HG = 600 * MiB;
constexpr size_t WS_HID = 1112 * MiB;
constexpr size_t WS_XB = 1574 * MiB;
constexpr size_t WS_END = 1638 * MiB;
static_assert(WS_Y2 + (size_t)(2 * M + 2048) * D * 4 <= WS_HG && WS_HID + (size_t)(2 * M + 2048) * FFE * 2 <= WS_END, "d_ws map");
constexpr int CW_TMO = 0, CW_CODE = 1;
constexpr int CW_BAR = 4096;
constexpr int CW_CNT = 16384;
constexpr int RING_OFF = 0, RING_BYTES = 131072;
constexpr int LDSCTL_OFF = RING_BYTES, MISC_OFF = LDSCTL_OFF + 320;
constexpr int LDS_BYTES = 147456;
constexpr bool dense_up8(int l) { return DENSE_FP8 == 1 || (DENSE_FP8 == 2 && ((DENSE_UP8_LAYERS >> l) & 1) != 0); }
struct Args { const float* in[21]; float* out; unsigned char* ws; int ph_lo, ph_hi; };

struct Frame {
    LAS unsigned char* lds;
    volatile LAS unsigned* MISC;
    gu32* ctl;
    int tid, lane, wave, G, wave0;

    float* X;
    unsigned char* ws;
};
enum { I_X = 0, I_C, I_WIN, I_CPOS, I_CW1, I_CW2, I_CVW, I_CVB, I_CVG, I_CVBE, I_WOUT, I_RB, I_ADAW, I_ADAB, I_LNG, I_LNB, I_FW1, I_FW2, I_RW, I_MW1, I_MW2 };

__device__ __forceinline__ float dpp_f(float v, const int ctrl_sel) {
    const int x = (int)__float_as_uint(v);
    return __uint_as_float((unsigned)(ctrl_sel == 0 ? __builtin_amdgcn_update_dpp(0, x, 0xB1, 0xF, 0xF, true) : ctrl_sel == 1 ? __builtin_amdgcn_update_dpp(0, x, 0x4E, 0xF, 0xF, true)
                                      : ctrl_sel == 2 ? __builtin_amdgcn_update_dpp(0, x, 0x141, 0xF, 0xF, true) : __builtin_amdgcn_update_dpp(0, x, 0x140, 0xF, 0xF, true)));
}
__device__ __forceinline__ float wave_sum(float v) {
    v += dpp_f(v, 0); v += dpp_f(v, 1); v += dpp_f(v, 2); v += dpp_f(v, 3);
    const int x = (int)__float_as_uint(v);
    const float a = __uint_as_float((unsigned)__builtin_amdgcn_readlane(x, 0)), b = __uint_as_float((unsigned)__builtin_amdgcn_readlane(x, 16));
    const float c = __uint_as_float((unsigned)__builtin_amdgcn_readlane(x, 32)), d = __uint_as_float((unsigned)__builtin_amdgcn_readlane(x, 48));
    return (a + b) + (c + d);
}
__device__ __forceinline__ float bf2f(unsigned short v) { return __uint_as_float((unsigned)v << 16); }
__device__ __forceinline__ float bflo(unsigned w) { return __uint_as_float(w << 16); }
__device__ __forceinline__ float bfhi(unsigned w) { return __uint_as_float(w & 0xffff0000u); }
__device__ __forceinline__ float sigmoid_f(float x) { return __builtin_amdgcn_rcpf(1.f + __builtin_amdgcn_exp2f(-1.4426950408889634f * x)); }

__device__ __forceinline__ void ph_ada(const Args& A, Frame& F) {
    LAS float* sc = (LAS float*)(F.lds);
    LAS float* red = (LAS float*)(F.lds + 65536);
    float* MOD = (float*)(F.ws + WS_MOD);
    for (int i = F.tid; i < BATCH * D; i += 512) { const float v = A.in[I_C][i]; sc[i] = v / (1.f + expf(-v)); }
    __syncthreads();
    const int c = F.tid & 63, ks = F.tid >> 6;
    for (int item = blockIdx.x; item < DEPTH * 96; item += gridDim.x) {
        const int l = item / 96, cb = item % 96, col = cb * 64 + c;
        const float* W = A.in[I_ADAW] + (size_t)l * D * 6 * D + col;
        float acc[16];
#pragma unroll
        for (int b = 0; b < 16; ++b) acc[b] = 0.f;
        for (int k0 = ks * 128; k0 < ks * 128 + 128; k0 += 32) { float wv[32];
#pragma unroll
            for (int kk = 0; kk < 32; ++kk) wv[kk] = __builtin_nontemporal_load(W + (size_t)(k0 + kk) * 6 * D);
            asm volatile("" ::: "memory");
#pragma unroll
            for (int b = 0; b < 16; ++b) { f32x4 s4[8];
#pragma unroll
                for (int q = 0; q < 8; ++q) s4[q] = *(const LAS f32x4*)(sc + b * D + k0 + 4 * q);
#pragma unroll
                for (int q = 0; q < 8; ++q) acc[b] += (s4[q].x * wv[4 * q] + s4[q].y * wv[4 * q + 1]) + (s4[q].z * wv[4 * q + 2] + s4[q].w * wv[4 * q + 3]); } }
#pragma unroll
        for (int b = 0; b < 16; ++b) red[(ks * 16 + b) * 64 + c] = acc[b];
        __syncthreads();
        for (int o = F.tid; o < 1024; o += 512) { const int b = o >> 6, cc = o & 63; float s = 0.f;
#pragma unroll
            for (int k2 = 0; k2 < 8; ++k2) s += red[(k2 * 16 + b) * 64 + cc];
            MOD[(size_t)(l * BATCH + b) * 6 * D + cb * 64 + cc] = s + A.in[I_ADAB][l * 6 * D + cb * 64 + cc]; }
        __syncthreads();
    }
}
__device__ __forceinline__ int rel_bucket_dev(int d) {
    if (d < 16) return d;
    int b = 16;
    b += (d >= 19); b += (d >= 21); b += (d >= 24); b += (d >= 27); b += (d >= 31); b += (d >= 35); b += (d >= 40); b += (d >= 46);
    b += (d >= 52); b += (d >= 59); b += (d >= 67); b += (d >= 77); b += (d >= 87); b += (d >= 99); b += (d >= 113);
    return b;
}
__device__ __forceinline__ void ph_tbl(const Args& A, Frame& F) {
    if (blockIdx.x != 0) return;
    float* TBL = (float*)(F.ws + WS_TBL);
    for (int i = F.tid; i < 2048; i += 512) { const int h = i >> 8, d = 191 - (i & 255); TBL[i] = d < 0 ? 0.f : A.in[I_RB][rel_bucket_dev(d) * 8 + h] * LOG2E; }
}
__device__ __forceinline__ int cvt_dest(int kind, int Fh, int n) {
    if (kind == 0) return n;
    if (kind == 1) return n < 1280 ? n : (n < 1304 ? n + 1024 : n - 24);
    return n < Fh ? ((n >> 7) << 8) + (n & 127) : (((n - Fh) >> 7) << 8) + 128 + ((n - Fh) & 127);
}
struct CvtItem { const float* W; bf16* WT; int K, N, kind, Fh, item; };
__device__ __forceinline__ void cvt_load(const CvtItem& c, float (&t)[32], int lane) {
    if (c.kind < 0 || c.kind == 3) return;
    const int nblk = (c.N + 31) >> 5, kb = c.item / nblk, nb = c.item % nblk, k0 = 64 * kb, n0 = 32 * nb;
    const int nn = n0 + (lane & 31);
    const float* wp = c.W + (size_t)(k0 + (lane >> 5)) * c.N + (nn < c.N ? nn : 0);
#pragma unroll
    for (int i = 0; i < 32; ++i) t[i] = __builtin_nontemporal_load(wp + (size_t)(2 * i) * c.N);
}
__device__ __forceinline__ void cvt_store(const CvtItem& c, const float (&t)[32], LAS float* scr, int lane) {
    if (c.kind < 0) return;
    if (c.kind == 3) { unsigned zz = 0u; asm volatile("" : "+v"(zz)); v4u z = {zz, zz, zz, zz}; *(GAS v4u*)(c.WT + ((size_t)c.item * 64 + lane) * 8) = z; return; }
    const int nblk = (c.N + 31) >> 5, kb = c.item / nblk, nb = c.item % nblk, k0 = 64 * kb, n0 = 32 * nb;
    const int nn = n0 + (lane & 31);
#pragma unroll
    for (int i = 0; i < 32; ++i) scr[(2 * i + (lane >> 5)) * 33 + (lane & 31)] = (nn < c.N) ? t[i] : 0.f;
    LDS_WAIT(); asm volatile("" ::: "memory");
    if (INPROJ_FP8 && c.kind == 1) {
        const int c4 = lane & 3;
#pragma unroll
        for (int j = 0; j < 2; ++j) { const int nl = (lane >> 2) + 16 * j; const int n = n0 + nl; const LAS float* s = scr + (16 * c4) * 33 + nl;
            int p0 = __builtin_amdgcn_cvt_pk_fp8_f32(s[0 * 33] * 32.f, s[1 * 33] * 32.f, 0, false); p0 = __builtin_amdgcn_cvt_pk_fp8_f32(s[2 * 33] * 32.f, s[3 * 33] * 32.f, p0, true);
            int p1 = __builtin_amdgcn_cvt_pk_fp8_f32(s[4 * 33] * 32.f, s[5 * 33] * 32.f, 0, false); p1 = __builtin_amdgcn_cvt_pk_fp8_f32(s[6 * 33] * 32.f, s[7 * 33] * 32.f, p1, true);
            int p2 = __builtin_amdgcn_cvt_pk_fp8_f32(s[8 * 33] * 32.f, s[9 * 33] * 32.f, 0, false); p2 = __builtin_amdgcn_cvt_pk_fp8_f32(s[10 * 33] * 32.f, s[11 * 33] * 32.f, p2, true);
            int p3 = __builtin_amdgcn_cvt_pk_fp8_f32(s[12 * 33] * 32.f, s[13 * 33] * 32.f, 0, false); p3 = __builtin_amdgcn_cvt_pk_fp8_f32(s[14 * 33] * 32.f, s[15 * 33] * 32.f, p3, true);
            v4u o; o.x = (unsigned)p0; o.y = (unsigned)p1; o.z = (unsigned)p2; o.w = (unsigned)p3;
            if (n < c.N) *(GAS v4u*)((unsigned char*)c.WT + (size_t)cvt_dest(c.kind, c.Fh, n) * c.K + k0 + 16 * c4) = o; }
        LDS_WAIT(); asm volatile("" ::: "memory");
        return;
    }
    const int cc = lane & 7;
#pragma unroll
    for (int j = 0; j < 4; ++j) { const int nl = (lane >> 3) + 8 * j; const int n = n0 + nl; const LAS float* s = scr + (8 * cc) * 33 + nl;
        v4u o; o.x = pk2(s[0 * 33], s[1 * 33]); o.y = pk2(s[2 * 33], s[3 * 33]); o.z = pk2(s[4 * 33], s[5 * 33]); o.w = pk2(s[6 * 33], s[7 * 33]);
        if (n < c.N) *(GAS v4u*)(c.WT + (size_t)cvt_dest(c.kind, c.Fh, n) * c.K + k0 + 8 * cc) = o; }
    LDS_WAIT(); asm volatile("" ::: "memory");
}
__device__ __forceinline__ CvtItem cvt_decode(const Args& A, Frame& F, int l, int it, int NIT) {
    bf16* WIN = (bf16*)(F.ws + WS_WIN);
    const int I_A = 16 * 73, I_C = 2 * 64;
    CvtItem c; c.W = nullptr; c.WT = nullptr; c.K = 0; c.N = 0; c.kind = -1; c.Fh = 0; c.item = 0;
    if (it >= NIT) return c;
    int r = it;
    if (r < I_A) { c.W = A.in[I_WIN] + (size_t)l * D * D_IN; c.K = D; c.N = D_IN; c.WT = WIN; c.kind = 1; c.item = r; return c; } r -= I_A;
    if (r < I_C) { const int kv = r >> 6; c.W = A.in[I_CW1] + (size_t)(l * 2 + kv) * 2048 * 64; c.K = 2048; c.N = 64; c.WT = (bf16*)(F.ws + WS_WCMP) + (size_t)kv * 64 * 2048; c.kind = 0; c.item = r & 63; return c; } r -= I_C;
    c.kind = 3; c.WT = INPROJ_FP8 ? (bf16*)((unsigned char*)WIN + (size_t)D_IN * D) : WIN + (size_t)D_IN * D; c.item = r; return c;
}
struct CvtBig { const float* W; bf16* WT; int K, N, kind, Fh, kt, nt; float q8; };
__device__ __forceinline__ CvtBig cvtbig_decode(const Args& A, Frame& F, int l, int it, int NIT) {
    bf16* WO = (bf16*)(F.ws + WS_WO); bf16* W1 = (bf16*)(F.ws + WS_W1); bf16* W2 = (bf16*)(F.ws + WS_W2);
    const bool moe = (l & 1) != 0; const int l2 = l >> 1;
    CvtBig c; c.W = nullptr; c.WT = nullptr; c.K = 0; c.N = 0; c.kind = -1; c.Fh = 0; c.kt = 0; c.nt = 0; c.q8 = 0.f;
    if (it >= NIT) return c;
    int r = it;
    if (moe) {
        if (r < 8 * 8 * 28) { const int e = r / (8 * 28), q = r % (8 * 28); c.W = A.in[I_MW1] + (size_t)(l2 * 8 + e) * D * 2 * FFE; c.K = D; c.N = 2 * FFE; c.WT = (bf16*)((unsigned char*)W1 + (size_t)e * 2 * FFE * D); c.kind = 2; c.Fh = FFE; c.kt = q / 28; c.nt = q % 28; c.q8 = 32.f; return c; } r -= 8 * 8 * 28;
        if (r < 8 * 28 * 4) { const int e = r / (28 * 4), q = r % (28 * 4); c.W = A.in[I_MW2] + (size_t)(l2 * 8 + e) * FFE * D; c.K = FFE; c.N = D; c.WT = (bf16*)((unsigned char*)W2 + (size_t)e * D * FFE); c.kind = 0; c.kt = q / 4; c.nt = q % 4; c.q8 = 128.f; return c; } r -= 8 * 28 * 4;
    } else {
        if (r < 8 * 22) { c.W = A.in[I_FW1] + (size_t)l2 * D * 2 * FF; c.K = D; c.N = 2 * FF; c.WT = W1; c.kind = 2; c.Fh = FF; c.kt = r / 22; c.nt = r % 22; c.q8 = dense_up8(l) ? 32.f : 0.f; return c; } r -= 8 * 22;
        if (r < 22 * 4) { c.W = A.in[I_FW2] + (size_t)l2 * FF * D; c.K = FF; c.N = D; c.WT = W2; c.kind = 0; c.kt = r / 4; c.nt = r % 4; c.q8 = DENSE_FP8 ? 128.f : 0.f; return c; } r -= 22 * 4;
    }
    c.W = A.in[I_WOUT] + (size_t)l * D * D; c.K = D; c.N = D; c.WT = WO; c.kind = 0; c.kt = r / 4; c.nt = r % 4; return c;
}
__device__ __forceinline__ void cvtbig_load(const CvtBig& c, float (&t)[64], int wave, int lane) {
    if (c.kind < 0) return;
    const float* wp = c.W + (size_t)(128 * c.kt + 16 * wave) * c.N + 256 * c.nt + lane;
#pragma unroll
    for (int i = 0; i < 16; ++i)
#pragma unroll
        for (int g = 0; g < 4; ++g) t[4 * i + g] = __builtin_nontemporal_load(wp + (size_t)i * c.N + 64 * g);
}
__device__ __forceinline__ void cvtbig_store(const CvtBig& c, const float (&t)[64], LAS unsigned* T, int wave, int lane) {
    if (c.kind >= 0 && c.q8 == 0.f) {
#pragma unroll
        for (int i = 0; i < 8; ++i)
#pragma unroll
            for (int g = 0; g < 4; ++g) T[(64 * g + lane) * 65 + 8 * wave + i] = pk2(t[4 * (2 * i) + g], t[4 * (2 * i + 1) + g]);
    }
    if (c.kind >= 0 && c.q8 != 0.f) {
#pragma unroll
        for (int i = 0; i < 4; ++i)
#pragma unroll
            for (int g = 0; g < 4; ++g) { int pq = __builtin_amdgcn_cvt_pk_fp8_f32(t[4 * (4 * i) + g] * c.q8, t[4 * (4 * i + 1) + g] * c.q8, 0, false); pq = __builtin_amdgcn_cvt_pk_fp8_f32(t[4 * (4 * i + 2) + g] * c.q8, t[4 * (4 * i + 3) + g] * c.q8, pq, true);
                T[(64 * g + lane) * 33 + 4 * wave + i] = (unsigned)pq; }
    }
    __syncthreads();
    if (c.kind >= 0 && c.q8 == 0.f) {
        const int cc = lane & 15;
#pragma unroll
        for (int j = 0; j < 8; ++j) { const int nl = 32 * wave + 4 * j + (lane >> 4); const LAS unsigned* sp = T + nl * 65 + 4 * cc;
            v4u o; o.x = sp[0]; o.y = sp[1]; o.z = sp[2]; o.w = sp[3];
            *(GAS v4u*)(c.WT + (size_t)cvt_dest(c.kind, c.Fh, 256 * c.nt + nl) * c.K + 128 * c.kt + 8 * cc) = o; }
    }
    if (c.kind >= 0 && c.q8 != 0.f) {
        const int cc = lane & 7;
#pragma unroll
        for (int j = 0; j < 4; ++j) { const int nl = 32 * wave + 8 * j + (lane >> 3); const LAS unsigned* sp = T + nl * 33 + 4 * cc;
            v4u o; o.x = sp[0]; o.y = sp[1]; o.z = sp[2]; o.w = sp[3];
            *(GAS v4u*)((unsigned char*)c.WT + (size_t)cvt_dest(c.kind, c.Fh, 256 * c.nt + nl) * c.K + 128 * c.kt + 16 * cc) = o; }
    }
    __syncthreads();
}
__device__ __forceinline__ void ph_cvt(const Args& A, Frame& F, int l) {
    const bool moe = (l & 1) != 0;
    {
      LAS unsigned* T = (LAS unsigned*)F.lds;
      const int NB = (moe ? 8 * 8 * 28 + 8 * 28 * 4 : 8 * 22 + 22 * 4) + 8 * 4;
      const int G = gridDim.x;
      float ta[64], tb[64];
      CvtBig ca = cvtbig_decode(A, F, l, blockIdx.x, NB), cb;
      cvtbig_load(ca, ta, F.wave, F.lane);
      for (int it = blockIdx.x; it < NB; it += 2 * G) {
          cb = cvtbig_decode(A, F, l, it + G, NB); cvtbig_load(cb, tb, F.wave, F.lane);
          asm volatile("" ::: "memory");
          cvtbig_store(ca, ta, T, F.wave, F.lane);
          ca = cvtbig_decode(A, F, l, it + 2 * G, NB); cvtbig_load(ca, ta, F.wave, F.lane);
          asm volatile("" ::: "memory");
          cvtbig_store(cb, tb, T, F.wave, F.lane);
      }
      __syncthreads(); }
    LAS float* scr = (LAS float*)(F.lds + F.wave * 16384);
    const int gw = blockIdx.x * NWAVES + F.wave, NGW = gridDim.x * NWAVES;
    const int NIT = 16 * 73 + 2 * 64 + 464;
    { float ta[32], tb[32];
      CvtItem ca = cvt_decode(A, F, l, gw, NIT), cb;
      cvt_load(ca, ta, F.lane);
      for (int it = gw; it < NIT; it += 2 * NGW) {
          cb = cvt_decode(A, F, l, it + NGW, NIT); cvt_load(cb, tb, F.lane);
          asm volatile("" ::: "memory");
          cvt_store(ca, ta, scr, F.lane);
          ca = cvt_decode(A, F, l, it + 2 * NGW, NIT); cvt_load(ca, ta, F.lane);
          asm volatile("" ::: "memory");
          cvt_store(cb, tb, scr, F.lane);
      } }
    if ((int)blockIdx.x >= (int)gridDim.x - 16) {
        __syncthreads();
        const int part16 = (int)gridDim.x - 1 - (int)blockIdx.x;
        LAS float* red = (LAS float*)F.lds;
        const int kv = F.tid >> 8, j = F.tid & 63, part = (F.tid >> 6) & 3;
        const float* w1 = A.in[I_CW1] + (size_t)(l * 2 + kv) * 2048 * 64 + (size_t)(128 * part16 + 32 * part) * 64 + j; const float* pos = A.in[I_CPOS] + (size_t)(l * 2 + kv) * 2048 + 128 * part16 + 32 * part;
        float wv[32], pv[32];
#pragma unroll
        for (int kk = 0; kk < 32; ++kk) { wv[kk] = w1[(size_t)kk * 64]; pv[kk] = pos[kk]; }
        asm volatile("" ::: "memory");
        float sacc = 0.f;
#pragma unroll
        for (int kk = 0; kk < 32; ++kk) sacc += pv[kk] * wv[kk];
        red[part * 128 + kv * 64 + j] = sacc;
        __syncthreads();
        if (F.tid < 128) ((float*)(F.ws + WS_WCMP + 512 * 1024))[part16 * 128 + F.tid] = (red[F.tid] + red[128 + F.tid]) + (red[256 + F.tid] + red[384 + F.tid]);
        __syncthreads();
    }
}
__device__ __forceinline__ void ph_mod0(const Args& A, Frame& F) {
    const int gw = blockIdx.x * NWAVES + F.wave, NGW = gridDim.x * NWAVES;
    const float* MOD = (const float*)(F.ws + WS_MOD); bf16* H = (bf16*)(F.ws + WS_H);
    for (int grp = gw; grp < M / 16; grp += NGW) { const int b = grp >> 7; const float* mod = MOD + (size_t)b * 6 * D;
        f32x4 shq[4], sclq[4];
#pragma unroll
        for (int j = 0; j < 4; ++j) { shq[j] = *((const f32x4*)mod + F.lane + 64 * j); sclq[j] = *((const f32x4*)(mod + D) + F.lane + 64 * j); }
#pragma unroll 1
        for (int m0 = grp * 16; m0 < grp * 16 + 16; m0 += 4) { f32x4 xv[4][4];
#pragma unroll
            for (int u = 0; u < 4; ++u)
#pragma unroll
                for (int j = 0; j < 4; ++j) xv[u][j] = __builtin_nontemporal_load((const f32x4*)(A.in[I_X] + (size_t)(m0 + u) * D) + F.lane + 64 * j);
            asm volatile("" ::: "memory");
#pragma unroll
            for (int u = 0; u < 4; ++u) { const int m = m0 + u;
#pragma unroll
                for (int j = 0; j < 4; ++j) { const f32x4 h = xv[u][j] * (1.f + sclq[j]) + shq[j];
                    if (INPROJ_FP8) { int pq = __builtin_amdgcn_cvt_pk_fp8_f32(h.x, h.y, 0, false); pq = __builtin_amdgcn_cvt_pk_fp8_f32(h.z, h.w, pq, true); *((unsigned*)((unsigned char*)H + (size_t)m * D) + F.lane + 64 * j) = (unsigned)pq; }
                    else *((unsigned long long*)(H + (size_t)m * D) + F.lane + 64 * j) = (unsigned long long)pk2(h.x, h.y) | ((unsigned long long)pk2(h.z, h.w) << 32); } } }
    }
}
__device__ __forceinline__ f32x4 bf4(unsigned long long w) { f32x4 r; r.x = bflo((unsigned)w); r.y = bfhi((unsigned)w); r.z = bflo((unsigned)(w >> 32)); r.w = bfhi((unsigned)(w >> 32)); return r; }
typedef _Float16 h4v_t __attribute__((ext_vector_type(4)));
__device__ __forceinline__ unsigned long long pack_h4(const f32x4 v) { h4v_t h; h[0] = (_Float16)v.x; h[1] = (_Float16)v.y; h[2] = (_Float16)v.z; h[3] = (_Float16)v.w; return __builtin_bit_cast(unsigned long long, h); }
__device__ __forceinline__ f32x4 h4f(unsigned long long w) { const h4v_t h = __builtin_bit_cast(h4v_t, w); f32x4 r; r.x = (float)h[0]; r.y = (float)h[1]; r.z = (float)h[2]; r.w = (float)h[3]; return r; }
__device__ __forceinline__ void ph_ln1(const Args& A, Frame& F, int l) {
    const int gw = blockIdx.x * NWAVES + F.wave, NGW = gridDim.x * NWAVES;
    const float* MODL = (const float*)(F.ws + WS_MOD) + (size_t)l * BATCH * 6 * D; bf16* H = (bf16*)(F.ws + WS_H); bf16* HG = (bf16*)(F.ws + WS_HG);
    const bf16* Y = (const bf16*)(F.ws + WS_Y); const float* xin = A.in[I_X]; bf16* XB = (bf16*)(F.ws + WS_XB);
    const float* lg = A.in[I_LNG] + (size_t)(l * 2 + 0) * D; const float* lb = A.in[I_LNB] + (size_t)(l * 2 + 0) * D;
    const bool moe = (l & 1) != 0; const float* RW = A.in[I_RW] + (size_t)(l >> 1) * D * 8;
    unsigned* ROUTE = (unsigned*)(F.ws + WS_ROUTE); unsigned* cnt = (unsigned*)(F.ctl + CW_CNT) + (l >> 1) * 8 * 64;
    LAS unsigned* cntL = (LAS unsigned*)F.lds;
    LAS float* RWL = (LAS float*)(F.lds + 256);
    if (F.tid < 16) cntL[F.tid] = 0u;
    if (moe) { f32x4 t[4];
#pragma unroll
        for (int i = 0; i < 4; ++i) t[i] = ((const f32x4*)RW)[F.tid + 512 * i];
        asm volatile("" ::: "memory");
#pragma unroll
        for (int i = 0; i < 4; ++i) ((LAS f32x4*)RWL)[F.tid + 512 * i] = t[i]; }
    f32x4 lgv[4], lbv[4];
#pragma unroll
    for (int j = 0; j < 4; ++j) { lgv[j] = *((const f32x4*)lg + F.lane + 64 * j); lbv[j] = *((const f32x4*)lb + F.lane + 64 * j); }
    __syncthreads();
    int bcur = -1; f32x4 g1v[4], shq[4], sclq[4];
    for (int grp = gw; grp < M / 16; grp += NGW) {
      { const int b = grp >> 7;
        if (b != bcur) { bcur = b; const float* mod = MODL + (size_t)b * 6 * D;
#pragma unroll
            for (int j = 0; j < 4; ++j) { const int q4 = F.lane + 64 * j; g1v[j] = *((const f32x4*)(mod + 2 * D) + q4); shq[j] = *((const f32x4*)(mod + 3 * D) + q4); sclq[j] = *((const f32x4*)(mod + 4 * D) + q4); } } }
      f32x4 xv[2][4]; unsigned long long xw[2][4], yw[2][4];
#define LN1_LOAD(M0) do { _Pragma("unroll") for (int u = 0; u < 2; ++u) { const int m_ = (M0) + u; _Pragma("unroll") for (int j = 0; j < 4; ++j) { const int q4 = F.lane + 64 * j; \
          if (l == 0) xv[u][j] = __builtin_nontemporal_load((const f32x4*)(xin + (size_t)m_ * D) + q4); else xw[u][j] = __builtin_nontemporal_load((const unsigned long long*)(XB + (size_t)m_ * D) + q4); \
          yw[u][j] = __builtin_nontemporal_load((const unsigned long long*)(Y + (size_t)m_ * D) + q4); } } } while (0)
      LN1_LOAD(grp * 16);
#pragma unroll 1
      for (int m0 = grp * 16; m0 < grp * 16 + 16; m0 += 2) {
        f32x4 v[2][4]; float s[2] = {0.f, 0.f};
        asm volatile("" ::: "memory");
#pragma unroll
        for (int u = 0; u < 2; ++u)
#pragma unroll
            for (int j = 0; j < 4; ++j) { const f32x4 xval = (l == 0) ? xv[u][j] : h4f(xw[u][j]); v[u][j] = ALPHA * xval + (1.f + g1v[j]) * bf4(yw[u][j]); s[u] += (v[u][j].x + v[u][j].y) + (v[u][j].z + v[u][j].w); }
        if (m0 + 2 < grp * 16 + 16) LN1_LOAD(m0 + 2);
        asm volatile("" ::: "memory");
        float mean[2], s2[2] = {0.f, 0.f}, rstd[2];
#pragma unroll
        for (int u = 0; u < 2; ++u) mean[u] = wave_sum(s[u]) * (1.f / D);
#pragma unroll
        for (int u = 0; u < 2; ++u)
#pragma unroll
            for (int j = 0; j < 4; ++j) { v[u][j] = v[u][j] - mean[u]; s2[u] += (v[u][j].x * v[u][j].x + v[u][j].y * v[u][j].y) + (v[u][j].z * v[u][j].z + v[u][j].w * v[u][j].w); }
#pragma unroll
        for (int u = 0; u < 2; ++u) rstd[u] = 1.f / sqrtf(wave_sum(s2[u]) * (1.f / D) + LN_EPS);
#pragma unroll
        for (int u = 0; u < 2; ++u) { const int m = m0 + u;
            float lgt[8];
#pragma unroll
            for (int e = 0; e < 8; ++e) lgt[e] = 0.f;
#pragma unroll
            for (int j = 0; j < 4; ++j) { const int q4 = F.lane + 64 * j;
                const f32x4 xn = v[u][j] * rstd[u] * lgv[j] + lbv[j]; *((unsigned long long*)(XB + (size_t)m * D) + q4) = pack_h4(xn);
                const f32x4 h = xn * (1.f + sclq[j]) + shq[j];
                if (!moe && !dense_up8(l)) *((unsigned long long*)(H + (size_t)m * D) + q4) = (unsigned long long)pk2(h.x, h.y) | ((unsigned long long)pk2(h.z, h.w) << 32);
                else { int pq = __builtin_amdgcn_cvt_pk_fp8_f32(h.x, h.y, 0, false); pq = __builtin_amdgcn_cvt_pk_fp8_f32(h.z, h.w, pq, true); *((unsigned*)((unsigned char*)H + (size_t)m * D) + q4) = (unsigned)pq; }
                if (moe) {
#pragma unroll
                    for (int k = 0; k < 4; ++k) { const f32x4 r0 = *(const LAS f32x4*)(RWL + (4 * q4 + k) * 8), r1 = *(const LAS f32x4*)(RWL + (4 * q4 + k) * 8 + 4); const float hv = h[k];
                        lgt[0] += hv * r0.x; lgt[1] += hv * r0.y; lgt[2] += hv * r0.z; lgt[3] += hv * r0.w; lgt[4] += hv * r1.x; lgt[5] += hv * r1.y; lgt[6] += hv * r1.z; lgt[7] += hv * r1.w; } }
            }
            if (moe) {
#pragma unroll
                for (int e = 0; e < 8; ++e) lgt[e] = wave_sum(lgt[e]);
                int e1 = 0; float v1 = lgt[0];
#pragma unroll
                for (int e = 1; e < 8; ++e) if (lgt[e] > v1) { v1 = lgt[e]; e1 = e; }
                int e2 = -1; float v2 = 0.f;
#pragma unroll
                for (int e = 0; e < 8; ++e) if (e != e1 && (e2 < 0 || lgt[e] > v2)) { v2 = lgt[e]; e2 = e; }
                const float w2 = 1.f / (1.f + expf(v1 - v2)), w1 = 1.f - w2;
                if (F.lane == 0) { const unsigned p1 = atomicAdd((unsigned*)(cntL + e1), 1u), p2 = atomicAdd((unsigned*)(cntL + e2), 1u);
                    v4u r; r.x = (unsigned)e1; r.y = p1; r.z = (unsigned)e2; r.w = p2; *(v4u*)(ROUTE + (size_t)m * 8) = r; ROUTE[(size_t)m * 8 + 4] = __float_as_uint(w1); ROUTE[(size_t)m * 8 + 5] = __float_as_uint(w2); }
            }
        }
      }
#undef LN1_LOAD
    }
    if (moe) {
        asm volatile("s_waitcnt vmcnt(0) lgkmcnt(0)" ::: "memory"); __syncthreads();
        if (F.tid < 8) cntL[8 + F.tid] = atomicAdd(cnt + F.tid * 64, cntL[F.tid]);
        __syncthreads();
        for (int grp = gw; grp < M / 16; grp += NGW)
#pragma unroll 1
        for (int m0 = grp * 16; m0 < grp * 16 + 16; m0 += 2) {
            v4u r[2]; unsigned hv[2][4];
#pragma unroll
            for (int u = 0; u < 2; ++u) { const int m = m0 + u; r[u] = *(const v4u*)(ROUTE + (size_t)m * 8);
#pragma unroll
                for (int j = 0; j < 4; ++j) hv[u][j] = *((const unsigned*)((const unsigned char*)H + (size_t)m * D) + F.lane + 64 * j); }
#pragma unroll
            for (int u = 0; u < 2; ++u) { const int m = m0 + u;
                r[u].y += cntL[8 + r[u].x]; r[u].w += cntL[8 + r[u].z];
                if (F.lane == 0) { ROUTE[(size_t)m * 8 + 1] = r[u].y; ROUTE[(size_t)m * 8 + 3] = r[u].w; }
                unsigned char* d1 = (unsigned char*)HG + ((size_t)r[u].x * ECAP + r[u].y) * D; unsigned char* d2 = (unsigned char*)HG + ((size_t)r[u].z * ECAP + r[u].w) * D;
#pragma unroll
                for (int j = 0; j < 4; ++j) { *((unsigned*)d1 + F.lane + 64 * j) = hv[u][j]; *((unsigned*)d2 + F.lane + 64 * j) = hv[u][j]; } }
        }
    }
}
__device__ __forceinline__ void ph_ln2(const Args& A, Frame& F, int l) {
    const int gw = blockIdx.x * NWAVES + F.wave, NGW = gridDim.x * NWAVES;
    const float* MODL = (const float*)(F.ws + WS_MOD) + (size_t)l * BATCH * 6 * D; bf16* H = (bf16*)(F.ws + WS_H);
    const bf16* Y = (const bf16*)(F.ws + WS_Y); const bf16* Y2 = (const bf16*)(F.ws + WS_Y2); bf16* XB = (bf16*)(F.ws + WS_XB);
    const float* lg = A.in[I_LNG] + (size_t)(l * 2 + 1) * D; const float* lb = A.in[I_LNB] + (size_t)(l * 2 + 1) * D;
    const bool moe = (l & 1) != 0;
    const unsigned* ROUTE = (const unsigned*)(F.ws + WS_ROUTE); const unsigned* cnt = (const unsigned*)(F.ctl + CW_CNT) + (l >> 1) * 8 * 64;
    int P[8];
    { int p = 0;
#pragma unroll
      for (int e = 0; e < 8; ++e) { P[e] = p; p += moe ? ((__builtin_amdgcn_readfirstlane((int)cnt[e * 64]) + 255) >> 8) : 0; } }
    f32x4 lgv[4], lbv[4];
#pragma unroll
    for (int j = 0; j < 4; ++j) { lgv[j] = *((const f32x4*)lg + F.lane + 64 * j); lbv[j] = *((const f32x4*)lb + F.lane + 64 * j); }
    int bcur = -1; f32x4 g2v[4], shq[4], sclq[4];
    for (int grp = gw; grp < M / 16; grp += NGW) {
      { const int b = grp >> 7;
        if (b != bcur) { bcur = b; const float* mod = MODL + (size_t)b * 6 * D;
#pragma unroll
            for (int j = 0; j < 4; ++j) { const int q4 = F.lane + 64 * j; g2v[j] = *((const f32x4*)(mod + 5 * D) + q4);
                if (l + 1 < DEPTH) { shq[j] = *((const f32x4*)(mod + (size_t)BATCH * 6 * D) + q4); sclq[j] = *((const f32x4*)(mod + (size_t)BATCH * 6 * D + D) + q4); } } } }
#pragma unroll 1
      for (int m0 = grp * 16; m0 < grp * 16 + 16; m0 += 2) {
        f32x4 v[2][4]; float s[2] = {0.f, 0.f};
        const bf16* f1[2]; const bf16* f2[2]; float w1[2], w2[2];
#pragma unroll
        for (int u = 0; u < 2; ++u) { const int m = m0 + u; f1[u] = Y + (size_t)m * D; f2[u] = f1[u]; w1[u] = 1.f; w2[u] = 0.f;
            if (moe) { const v4u r = *(const v4u*)(ROUTE + (size_t)m * 8); w1[u] = __uint_as_float(ROUTE[(size_t)m * 8 + 4]); w2[u] = __uint_as_float(ROUTE[(size_t)m * 8 + 5]);
                int b1 = 0, b2 = 0;
#pragma unroll
                for (int e = 0; e < 8; ++e) { if ((int)r.x == e) b1 = P[e]; if ((int)r.z == e) b2 = P[e]; }
                f1[u] = Y2 + ((size_t)b1 * 256 + r.y) * D; f2[u] = Y2 + ((size_t)b2 * 256 + r.w) * D; } }
        { unsigned long long xw[2][4], ya[2][4], yb[2][4];
#pragma unroll
          for (int u = 0; u < 2; ++u) { const int m = m0 + u;
#pragma unroll
              for (int j = 0; j < 4; ++j) { const int q4 = F.lane + 64 * j; xw[u][j] = __builtin_nontemporal_load((const unsigned long long*)(XB + (size_t)m * D) + q4);
                  ya[u][j] = __builtin_nontemporal_load((const unsigned long long*)f1[u] + q4); yb[u][j] = moe ? __builtin_nontemporal_load((const unsigned long long*)f2[u] + q4) : 0ull; } }
          asm volatile("" ::: "memory");
#pragma unroll
          for (int u = 0; u < 2; ++u)
#pragma unroll
              for (int j = 0; j < 4; ++j) { f32x4 fv = bf4(ya[u][j]); if (moe) fv = w1[u] * fv + w2[u] * bf4(yb[u][j]);
                  v[u][j] = ALPHA * h4f(xw[u][j]) + (1.f + g2v[j]) * fv; s[u] += (v[u][j].x + v[u][j].y) + (v[u][j].z + v[u][j].w); } }
        float mean[2], s2[2] = {0.f, 0.f}, rstd[2];
#pragma unroll
        for (int u = 0; u < 2; ++u) mean[u] = wave_sum(s[u]) * (1.f / D);
#pragma unroll
        for (int u = 0; u < 2; ++u)
#pragma unroll
            for (int j = 0; j < 4; ++j) { v[u][j] = v[u][j] - mean[u]; s2[u] += (v[u][j].x * v[u][j].x + v[u][j].y * v[u][j].y) + (v[u][j].z * v[u][j].z + v[u][j].w * v[u][j].w); }
#pragma unroll
        for (int u = 0; u < 2; ++u) rstd[u] = 1.f / sqrtf(wave_sum(s2[u]) * (1.f / D) + LN_EPS);
#pragma unroll
        for (int u = 0; u < 2; ++u) { const int m = m0 + u;
#pragma unroll
            for (int j = 0; j < 4; ++j) { const int q4 = F.lane + 64 * j;
                const f32x4 xn = v[u][j] * rstd[u] * lgv[j] + lbv[j];
                if (l + 1 < DEPTH) *((unsigned long long*)(XB + (size_t)m * D) + q4) = pack_h4(xn); else *((f32x4*)(F.X + (size_t)m * D) + q4) = xn;
                if (l + 1 < DEPTH) { const f32x4 h = xn * (1.f + sclq[j]) + shq[j];
                    if (INPROJ_FP8) { int pq = __builtin_amdgcn_cvt_pk_fp8_f32(h.x, h.y, 0, false); pq = __builtin_amdgcn_cvt_pk_fp8_f32(h.z, h.w, pq, true); *((unsigned*)((unsigned char*)H + (size_t)m * D) + q4) = (unsigned)pq; }
                    else *((unsigned long long*)(H + (size_t)m * D) + q4) = (unsigned long long)pk2(h.x, h.y) | ((unsigned long long)pk2(h.z, h.w) << 32); } } }
      }
    }
}

__device__ __forceinline__ float gelu_tanh_f(float x) { return 0.5f * x * (1.f + tanhf(0.7978845608028654f * (x + 0.044715f * x * x * x))); }
__device__ __forceinline__ void ph_compress_naive(const Args& A, Frame& F, int l) {
    const int gw = blockIdx.x * NWAVES + F.wave, NGW = gridDim.x * NWAVES;
    const bf16* U = (const bf16*)(F.ws + WS_U);
    for (int it = gw; it < 2 * BATCH * NCP * 2; it += NGW) {
        const int g = it & 1, n = (it >> 1) & 127, b = (it >> 8) & 15, kv = it >> 12;
        bf16* OUT = (bf16*)(F.ws + (kv ? WS_VCMP : WS_KCMP)) + ((size_t)(b * NCP + n) * 2 + g) * 64;
        float out = 0.f;
        if (n < NCMP) {
            const float* w1 = A.in[I_CW1] + (size_t)(l * 2 + kv) * 2048 * 64; const float* pos = A.in[I_CPOS] + (size_t)(l * 2 + kv) * 2048;
            const float* w2 = A.in[I_CW2] + (size_t)(l * 2 + kv) * 64 * 64;
            const bf16* ub = U + ((size_t)b * T + 16 * n) * NU + (kv ? UVC : UKC) + g * 64;
            float pre = 0.f;
            for (int kk = 0; kk < 2048; ++kk) { const float a = bf2f(ub[(size_t)(kk >> 6) * NU + (kk & 63)]) + pos[kk]; pre += a * w1[(size_t)kk * 64 + F.lane]; }
            const float ge = gelu_tanh_f(pre);
            for (int j = 0; j < 64; ++j) out += __shfl(ge, j) * w2[j * 64 + F.lane];
        }
        OUT[F.lane] = (bf16)f2bf(out);
    }
}
__device__ __forceinline__ void ph_conv_naive(const Args& A, Frame& F, int l) {
    LAS float* glu = (LAS float*)F.lds;
    LAS float* red = (LAS float*)(F.lds + 46 * 512 * 4);
    const bf16* U = (const bf16*)(F.ws + WS_U); bf16* CAT = (bf16*)(F.ws + WS_CAT);
    const int c = F.tid;
    float w[31];
#pragma unroll
    for (int k = 0; k < 31; ++k) w[k] = A.in[I_CVW][(size_t)(l * 31 + k) * 512 + c];
    const float cb = A.in[I_CVB][l * 512 + c], lg = A.in[I_CVG][l * 512 + c], lb = A.in[I_CVBE][l * 512 + c];
    for (int it = blockIdx.x; it < M / 16; it += gridDim.x) {
        const int b = it >> 7, t0 = (it & 127) * 16;
        for (int rr = 0; rr < 46; ++rr) { const int tt = t0 - 30 + rr; float v = 0.f;
            if (tt >= 0) { const bf16* ur = U + ((size_t)b * T + tt) * NU; v = bf2f(ur[UCA + c]) * sigmoid_f(bf2f(ur[UCG + c])); }
            glu[rr * 512 + c] = v; }
        LDS_WAIT();
        float y[16];
#pragma unroll
        for (int i = 0; i < 16; ++i) { float a = cb;
#pragma unroll
            for (int k = 0; k < 31; ++k) a += w[k] * glu[(i + k) * 512 + c];
            y[i] = a; }
#pragma unroll
        for (int i = 0; i < 16; ++i) { const float s = wave_sum(y[i]); if (F.lane == 0) red[i * 8 + F.wave] = s; }
        __syncthreads();
        float mean[16];
#pragma unroll
        for (int i = 0; i < 16; ++i) { float s = 0.f;
#pragma unroll
            for (int k = 0; k < 8; ++k) s += red[i * 8 + k];
            mean[i] = s * (1.f / 512.f); }
        __syncthreads();
#pragma unroll
        for (int i = 0; i < 16; ++i) { y[i] -= mean[i]; const float s = wave_sum(y[i] * y[i]); if (F.lane == 0) red[i * 8 + F.wave] = s; }
        __syncthreads();
#pragma unroll
        for (int i = 0; i < 16; ++i) { float s = 0.f;
#pragma unroll
            for (int k = 0; k < 8; ++k) s += red[i * 8 + k];
            const float rstd = 1.f / sqrtf(s * (1.f / 512.f) + LN_EPS); const float z = y[i] * rstd * lg + lb;
            CAT[((size_t)b * T + t0 + i) * D + 512 + c] = (bf16)f2bf(z * sigmoid_f(z)); }
        __syncthreads();
    }
}
__device__ __forceinline__ float dot64(const v4u (&qp)[8], const bf16* kp) {
    float s = 0.f;
#pragma unroll
    for (int c = 0; c < 8; ++c) { const v4u kv = *(const v4u*)(kp + 8 * c);
        s += bflo(qp[c].x) * bflo(kv.x) + bfhi(qp[c].x) * bfhi(kv.x); s += bflo(qp[c].y) * bflo(kv.y) + bfhi(qp[c].y) * bfhi(kv.y);
        s += bflo(qp[c].z) * bflo(kv.z) + bfhi(qp[c].z) * bfhi(kv.z); s += bflo(qp[c].w) * bflo(kv.w) + bfhi(qp[c].w) * bfhi(kv.w); }
    return s;
}
__device__ __forceinline__ void axpy64(float (&O)[64], float e, const bf16* vp) {
#pragma unroll
    for (int c = 0; c < 8; ++c) { const v4u vv = *(const v4u*)(vp + 8 * c);
        O[8 * c + 0] += e * bflo(vv.x); O[8 * c + 1] += e * bfhi(vv.x); O[8 * c + 2] += e * bflo(vv.y); O[8 * c + 3] += e * bfhi(vv.y);
        O[8 * c + 4] += e * bflo(vv.z); O[8 * c + 5] += e * bfhi(vv.z); O[8 * c + 6] += e * bflo(vv.w); O[8 * c + 7] += e * bfhi(vv.w); }
}
__device__ __forceinline__ void ph_attn_naive(const Args& A, Frame& F, int l) {
    (void)l;
    LAS float* impH = (LAS float*)F.lds;
    LAS unsigned* selm = (LAS unsigned*)(F.lds + 32768);
    LAS float* WOUT = (LAS float*)(F.lds + 32768 + 256);
    const bf16* U = (const bf16*)(F.ws + WS_U); bf16* CAT = (bf16*)(F.ws + WS_CAT);
    const bf16* KC = (const bf16*)(F.ws + WS_KCMP); const bf16* VC = (const bf16*)(F.ws + WS_VCMP);
    const float* TBL = (const float*)(F.ws + WS_TBL);
    const float NEG = -INFINITY;
    for (int it = blockIdx.x; it < BATCH * 2 * 32; it += gridDim.x) {
        const int tb = it & 31, g = (it >> 5) & 1, b = it >> 6;
        const int t0 = tb * 64, i = F.tid & 63, r = F.wave & 3, t = t0 + i, h = g * 4 + r;
        const size_t m = (size_t)b * T + t;
        const bf16* urow = U + m * NU;
        v4u qp[8];
#pragma unroll
        for (int c = 0; c < 8; ++c) qp[c] = *(const v4u*)(urow + UQ + h * 64 + 8 * c);
        const float* tb_h = TBL + h * 128;
        const float gl0 = sigmoid_f(bf2f(urow[UGL + g * 12 + r * 3 + 0])), gl1 = sigmoid_f(bf2f(urow[UGL + g * 12 + r * 3 + 1])), gl2 = sigmoid_f(bf2f(urow[UGL + g * 12 + r * 3 + 2]));
        LAS float* acc = WOUT + (r * 64 + i) * 64;
        float O[64]; float wsc = 0.f;
        if (F.wave < 4) {
            float mx = NEG;
            for (int n = 0; n < NCMP; ++n) { const int dist = t - (16 * n + 31);
                if (dist >= 0) { const float s = dot64(qp, KC + ((size_t)(b * NCP + n) * 2 + g) * 64) + tb_h[dist < 127 ? dist : 127]; mx = fmaxf(mx, s); } }
            float ls = 0.f;
#pragma unroll
            for (int d = 0; d < 64; ++d) O[d] = 0.f;
            LAS float* imp = impH + (r * 64 + i) * 32;
            for (int j = 0; j < 32; ++j) imp[j] = 0.f;
            for (int n = 0; n < NCMP; ++n) { const int dist = t - (16 * n + 31);
                if (dist >= 0) { const float s = dot64(qp, KC + ((size_t)(b * NCP + n) * 2 + g) * 64) + tb_h[dist < 127 ? dist : 127];
                    const float e = exp2f(s - mx); ls += e; axpy64(O, e, VC + ((size_t)(b * NCP + n) * 2 + g) * 64);
                    imp[n >> 2] += e; if ((n & 3) == 3) imp[(n + 1) >> 2] += e; } }
            const float invl = ls > 0.f ? 1.f / ls : 0.f;
            for (int j = 0; j < 32; ++j) imp[j] *= invl;
#pragma unroll
            for (int d = 0; d < 64; ++d) acc[d] = gl0 * invl * O[d];
        } else {
            float mx = NEG, ls = 0.f;
#pragma unroll
            for (int d = 0; d < 64; ++d) O[d] = 0.f;
            const int p0 = t0 - 511 > 0 ? t0 - 511 : 0;
            for (int pos = p0; pos < t0 + 64; ++pos) { const int dist = t - pos;
                if (dist >= 0 && dist < 512) { const bf16* kr = U + ((size_t)b * T + pos) * NU;
                    const float s = dot64(qp, kr + UKW + g * 64) + tb_h[dist < 127 ? dist : 127];
                    if (s > mx) { const float sc = exp2f(mx - s); ls *= sc;
#pragma unroll
                        for (int d = 0; d < 64; ++d) O[d] *= sc;
                        mx = s; }
                    const float e = exp2f(s - mx); ls += e; axpy64(O, e, kr + UVW + g * 64); } }
            wsc = gl2 / ls;
        }
        __syncthreads();
        if (F.wave >= 4) {
#pragma unroll
            for (int d = 0; d < 64; ++d) acc[d] += wsc * O[d];
        }
        if (F.wave == 0) {
            LAS float* sc = impH + i * 32;
            for (int j = 0; j < 32; ++j) { float s = impH[(0 * 64 + i) * 32 + j] + impH[(1 * 64 + i) * 32 + j] + impH[(2 * 64 + i) * 32 + j] + impH[(3 * 64 + i) * 32 + j];
                if (j > tb) s = NEG; else if (j == 0 || j == tb || j == tb - 1) s = INFINITY;
                sc[j] = s; }
            unsigned mask = 0u;
            for (int k = 0; k < 8; ++k) { int best = -1; float bv = 0.f;
                for (int j = 0; j < 32; ++j) if (!((mask >> j) & 1u)) { const float v = sc[j]; if (best < 0 || v > bv) { best = j; bv = v; } }
                mask |= 1u << best; }
            mask &= (tb == 31) ? 0xffffffffu : ((1u << (tb + 1)) - 1u);
            selm[i] = mask;
        }
        __syncthreads();
        if (F.wave < 4) {
            const unsigned mask = selm[i];
            float mx = NEG, ls = 0.f;
#pragma unroll
            for (int d = 0; d < 64; ++d) O[d] = 0.f;
            for (int j = 0; j <= tb; ++j) { const bool sel = (mask >> j) & 1u;
                if (!__any(sel)) continue;
                for (int kk = 0; kk < 64; ++kk) { const int pos = 64 * j + kk, dist = t - pos;
                    if (sel && dist >= 0) { const bf16* kr = U + ((size_t)b * T + pos) * NU;
                        const float s = dot64(qp, kr + UKS + g * 64) + tb_h[dist < 127 ? dist : 127];
                        if (s > mx) { const float sc = exp2f(mx - s); ls *= sc;
#pragma unroll
                            for (int d = 0; d < 64; ++d) O[d] *= sc;
                            mx = s; }
                        const float e = exp2f(s - mx); ls += e; axpy64(O, e, kr + UVS + g * 64); } } }
            const float sc = gl1 / ls;
            bf16* orow = CAT + m * D + h * 64;
#pragma unroll
            for (int c = 0; c < 8; ++c) { float o[8];
#pragma unroll
                for (int k = 0; k < 8; ++k) o[k] = acc[8 * c + k] + sc * O[8 * c + k];
                v4u w; w.x = pk2(o[0], o[1]); w.y = pk2(o[2], o[3]); w.z = pk2(o[4], o[5]); w.w = pk2(o[6], o[7]); *(v4u*)(orow + 8 * c) = w; }
        }
        __syncthreads();
    }
}

namespace att {
using f32x16 = __attribute__((ext_vector_type(16))) float;
using s16x4 = __attribute__((ext_vector_type(4))) short;
typedef short v4i16_t __attribute__((ext_vector_type(4)));
constexpr int SLOTB = 8192;
constexpr int NSLOT = 3;
constexpr int L_K = 0, L_V = NSLOT * SLOTB, L_WSF = 2 * NSLOT * SLOTB, L_OST = L_WSF + 8 * 256, L_TB = L_OST + 8 * 8192, L_IMP = L_TB + 4096, L_MSK = L_IMP + 8 * 1024, L_END = L_MSK + 256;
__device__ __forceinline__ int crow(int r, int hi) { return (r & 3) + 8 * (r >> 2) + 4 * hi; }
__device__ __forceinline__ void glds16(const void* gsrc, unsigned lds_dst) { unsigned keep;
    asm volatile("s_mov_b32 %0, m0\n\ts_mov_b32 m0, %2\n\ts_nop 0\n\tglobal_load_lds_dwordx4 %1, off\n\ts_mov_b32 m0, %0" : "=&s"(keep) : "v"(gsrc), "s"(lds_dst) : "memory"); }
__device__ __forceinline__ unsigned cvtpk(float lo, float hi) { unsigned r; asm volatile("v_cvt_pk_bf16_f32 %0, %1, %2" : "=v"(r) : "v"(lo), "v"(hi)); return r; }
__device__ __forceinline__ void qkt(f32x16& p0, f32x16& p1, const LAS char* Kslot, const bf16x8 (&qr)[4], int r32, int hi, float cinit) {
    const LAS char* kb = Kslot + hi * 1024 + r32 * 16;
    f32x16 z;
#pragma unroll
    for (int r = 0; r < 16; ++r) z[r] = cinit;
    bf16x8 b0[4], b1[4];
#pragma unroll
    for (int d0 = 0; d0 < 4; ++d0) { b0[d0] = *(const LAS bf16x8*)(kb + d0 * 2048); b1[d0] = *(const LAS bf16x8*)(kb + d0 * 2048 + 512); }
    asm volatile("" ::: "memory");
    p0 = __builtin_amdgcn_mfma_f32_32x32x16_bf16(b0[0], qr[0], z, 0, 0, 0); p1 = __builtin_amdgcn_mfma_f32_32x32x16_bf16(b1[0], qr[0], z, 0, 0, 0);
#pragma unroll
    for (int d0 = 1; d0 < 4; ++d0) { p0 = __builtin_amdgcn_mfma_f32_32x32x16_bf16(b0[d0], qr[d0], p0, 0, 0, 0); p1 = __builtin_amdgcn_mfma_f32_32x32x16_bf16(b1[d0], qr[d0], p1, 0, 0, 0); }
}
__device__ __forceinline__ void pv(f32x16 (&o)[2], int vb, bf16x8 pa0, bf16x8 pa1, bf16x8 pa2, bf16x8 pa3) {
    s16x4 lo[2][4], hi[2][4];
#pragma unroll
    for (int d0 = 0; d0 < 2; ++d0)
#pragma unroll
        for (int ks = 0; ks < 4; ++ks) {
            asm volatile("ds_read_b64_tr_b16 %0,%1 offset:%c2" : "=&v"(lo[d0][ks]) : "v"(vb), "i"(d0 * 4096 + ks * 1024) : "memory");
            asm volatile("ds_read_b64_tr_b16 %0,%1 offset:%c2" : "=&v"(hi[d0][ks]) : "v"(vb), "i"(d0 * 4096 + ks * 1024 + 512) : "memory"); }
#define PK(d, k) (bf16x8){lo[d][k][0], lo[d][k][1], lo[d][k][2], lo[d][k][3], hi[d][k][0], hi[d][k][1], hi[d][k][2], hi[d][k][3]}
    asm volatile("s_waitcnt lgkmcnt(8)" : "+v"(lo[0][0]), "+v"(lo[0][1]), "+v"(lo[0][2]), "+v"(lo[0][3]), "+v"(hi[0][0]), "+v"(hi[0][1]), "+v"(hi[0][2]), "+v"(hi[0][3]) :: "memory"); __builtin_amdgcn_sched_barrier(0);
    o[0] = __builtin_amdgcn_mfma_f32_32x32x16_bf16(pa0, PK(0, 0), o[0], 0, 0, 0);
    o[0] = __builtin_amdgcn_mfma_f32_32x32x16_bf16(pa1, PK(0, 1), o[0], 0, 0, 0);
    o[0] = __builtin_amdgcn_mfma_f32_32x32x16_bf16(pa2, PK(0, 2), o[0], 0, 0, 0);
    o[0] = __builtin_amdgcn_mfma_f32_32x32x16_bf16(pa3, PK(0, 3), o[0], 0, 0, 0);
    asm volatile("s_waitcnt lgkmcnt(0)" : "+v"(lo[1][0]), "+v"(lo[1][1]), "+v"(lo[1][2]), "+v"(lo[1][3]), "+v"(hi[1][0]), "+v"(hi[1][1]), "+v"(hi[1][2]), "+v"(hi[1][3]) :: "memory"); __builtin_amdgcn_sched_barrier(0);
    o[1] = __builtin_amdgcn_mfma_f32_32x32x16_bf16(pa0, PK(1, 0), o[1], 0, 0, 0);
    o[1] = __builtin_amdgcn_mfma_f32_32x32x16_bf16(pa1, PK(1, 1), o[1], 0, 0, 0);
    o[1] = __builtin_amdgcn_mfma_f32_32x32x16_bf16(pa2, PK(1, 2), o[1], 0, 0, 0);
    o[1] = __builtin_amdgcn_mfma_f32_32x32x16_bf16(pa3, PK(1, 3), o[1], 0, 0, 0);
#undef PK
}
__device__ __forceinline__ float xhalf_max(float m) { auto rr = __builtin_amdgcn_permlane32_swap(__float_as_uint(m), __float_as_uint(m), false, false); return fmaxf(__uint_as_float(rr[0]), __uint_as_float(rr[1])); }
__device__ __forceinline__ float xhalf_sum(float m) { auto rr = __builtin_amdgcn_permlane32_swap(__float_as_uint(m), __float_as_uint(m), false, false); return __uint_as_float(rr[0]) + __uint_as_float(rr[1]); }
__device__ __forceinline__ float xhalf_other(float m, int hi) { auto rr = __builtin_amdgcn_permlane32_swap(__float_as_uint(m), __float_as_uint(m), false, false); const float a = __uint_as_float(rr[0]), b = __uint_as_float(rr[1]); return hi ? a : b; }
__device__ __forceinline__ float dpp_xor1(float v) { return __uint_as_float((unsigned)__builtin_amdgcn_update_dpp(0, (int)__float_as_uint(v), 0xB1, 0xF, 0xF, true)); }
__device__ __forceinline__ float dpp_xor2(float v) { return __uint_as_float((unsigned)__builtin_amdgcn_update_dpp(0, (int)__float_as_uint(v), 0x4E, 0xF, 0xF, true)); }
__device__ __forceinline__ float dpp_hmir(float v) { return __uint_as_float((unsigned)__builtin_amdgcn_update_dpp(0, (int)__float_as_uint(v), 0x141, 0xF, 0xF, true)); }
__device__ __forceinline__ int dpp_xor1i(int v) { return __builtin_amdgcn_update_dpp(0, v, 0xB1, 0xF, 0xF, true); }
__device__ __forceinline__ int dpp_xor2i(int v) { return __builtin_amdgcn_update_dpp(0, v, 0x4E, 0xF, 0xF, true); }
__device__ __forceinline__ int dpp_hmiri(int v) { return __builtin_amdgcn_update_dpp(0, v, 0x141, 0xF, 0xF, true); }
}

__device__ __forceinline__ void ph_attn(const Args& A, Frame& F, int l) {
    using namespace att; (void)l; (void)A;
    const int lane = F.lane, w = F.wave, r32 = lane & 31, hi = lane >> 5;
    const bf16* U = (const bf16*)(F.ws + WS_U); bf16* CAT = (bf16*)(F.ws + WS_CAT);
    const bf16* KC = (const bf16*)(F.ws + WS_KCMP); const bf16* VC = (const bf16*)(F.ws + WS_VCMP);
    const float* TBL = (const float*)(F.ws + WS_TBL);
    const LAS char* ldsb = (const LAS char*)F.lds;
    const unsigned lds0 = (unsigned)(size_t)F.lds;
    LAS float* wsf = (LAS float*)(F.lds + L_WSF) + w * 64;
    LAS float* tb4 = (LAS float*)(F.lds + L_TB);
    LAS float* impw = (LAS float*)(F.lds + L_IMP) + w * 256;
    LAS unsigned* mskw = (LAS unsigned*)(F.lds + L_MSK) + w * 8;
    const float NEG = -INFINITY;
    const int vbl = ((lane >> 4) & 1) * 32 + (lane & 3) * 8 + (4 * hi + ((lane & 15) >> 2)) * 64;
#ifdef ATT_ECHO
    unsigned long long ec_wait = 0, ec_s1 = 0, ec_pv = 0, ec_t = 0;
#define EC_MARK() (ec_t = __builtin_amdgcn_s_memtime())
#define EC_ADD(x) do { const unsigned long long n_ = __builtin_amdgcn_s_memtime(); x += n_ - ec_t; ec_t = n_; } while (0)
#else
#define EC_MARK() do {} while (0)
#define EC_ADD(x) do {} while (0)
#endif
    const int tok = 8 * w + (r32 >> 2), hr = r32 & 3;
    bf16x8 qn[4]; bf16 gq0 = 0, gq1 = 0, gq2 = 0; int gtab = -1;
#pragma unroll
    for (int d0 = 0; d0 < 4; ++d0) qn[d0] = (bf16x8){0, 0, 0, 0, 0, 0, 0, 0};
#define UNIT_PRE(P) do { const int p_ = (P); const int ui_ = p_ >> 8, w_ = p_ & 255, v_ = ((w_ & 7) << 5) | (w_ >> 3), bg_ = v_ >> 3, s8_ = v_ & 7; \
        const int tb_ = (ui_ == 0) ? s8_ : (ui_ == 1) ? 15 - s8_ : (ui_ == 2) ? 16 + s8_ : 31 - s8_; const int b_ = bg_ >> 1, g_ = bg_ & 1; \
        const bool ld_ = g_ != gtab; float t0_ = 0.f, t1_ = 0.f; if (ld_) { t0_ = TBL[(size_t)(4 * g_) * 256 + F.tid]; t1_ = TBL[(size_t)(4 * g_) * 256 + F.tid + 512]; } \
        const bf16* ur_ = U + ((size_t)b_ * T + tb_ * 64 + tok) * NU; \
        _Pragma("unroll") for (int d0 = 0; d0 < 4; ++d0) qn[d0] = *(const bf16x8*)(ur_ + UQ + (4 * g_ + hr) * 64 + d0 * 16 + hi * 8); \
        gq0 = ur_[UGL + g_ * 12 + hr * 3 + 0]; gq1 = ur_[UGL + g_ * 12 + hr * 3 + 1]; gq2 = ur_[UGL + g_ * 12 + hr * 3 + 2]; \
        asm volatile("" ::: "memory"); \
        const size_t rkc_ = ((size_t)(b_ * NCP) * 2 + g_) * 64; const bf16* kc_ = KC + rkc_ + (size_t)lane * 128 + w * 8; const bf16* vc_ = VC + rkc_ + (size_t)(16 * (w & 3) + (lane >> 2)) * 128 + (w >> 2) * 32 + (lane & 3) * 8; \
        glds16(kc_, (unsigned)__builtin_amdgcn_readfirstlane(lds0 + L_K + w * 1024)); glds16(vc_, (unsigned)__builtin_amdgcn_readfirstlane(lds0 + L_V + w * 1024)); \
        glds16(kc_ + 64 * 128, (unsigned)__builtin_amdgcn_readfirstlane(lds0 + L_K + SLOTB + w * 1024)); glds16(vc_ + 64 * 128, (unsigned)__builtin_amdgcn_readfirstlane(lds0 + L_V + SLOTB + w * 1024)); \
        if (ld_) { tb4[F.tid] = t0_; tb4[F.tid + 512] = t1_; gtab = g_; }     \
        asm volatile("" ::: "memory"); } while (0)
    if ((int)blockIdx.x < BATCH * 2 * 32) UNIT_PRE((int)blockIdx.x);
    for (int p = blockIdx.x; p < BATCH * 2 * 32; p += gridDim.x) {
        const int ui = p >> 8, w8 = p & 255, v = ((w8 & 7) << 5) | (w8 >> 3), bg = v >> 3, s8 = v & 7;
        const int tb = (ui == 0) ? s8 : (ui == 1) ? 15 - s8 : (ui == 2) ? 16 + s8 : 31 - s8;
        const int b = bg >> 1, g = bg & 1, t0 = tb * 64;
        const int t = t0 + tok;
        const int nwin = tb + 1 < 9 ? tb + 1 : 9, nsel = tb + 1, ntile = 2 + nwin + nsel;
        const bf16* ubg = U + (size_t)b * T * NU + g * 64;
        const bf16* kbU = ubg + (size_t)lane * NU + w * 8; const bf16* vbU = ubg + (size_t)(16 * (w & 3) + (lane >> 2)) * NU + (w >> 2) * 32 + (lane & 3) * 8;
#define TILE_DMA(i) do { const int i_ = (i); const bf16* kp_; const bf16* vp_; \
            { const bool win_ = i_ < 2 + nwin; const int kt_ = win_ ? tb - (i_ - 2) : i_ - 2 - nwin; const size_t o_ = (size_t)kt_ * (64 * NU) + (win_ ? UKW : UKS); kp_ = kbU + o_; vp_ = vbU + o_ + (UVW - UKW); } \
            const unsigned so_ = (unsigned)(i_ % NSLOT) * SLOTB; \
            glds16(kp_, (unsigned)__builtin_amdgcn_readfirstlane(lds0 + L_K + so_ + w * 1024)); glds16(vp_, (unsigned)__builtin_amdgcn_readfirstlane(lds0 + L_V + so_ + w * 1024)); } while (0)
        bf16x8 qr[4];
#pragma unroll
        for (int d0 = 0; d0 < 4; ++d0) qr[d0] = qn[d0];
        const float gl0 = sigmoid_f(bf2f(gq0)), gl1 = sigmoid_f(bf2f(gq1)), gl2 = sigmoid_f(bf2f(gq2));
        const LAS float* tbh = tb4 + hr * 256;
        const bool pre_unit = p != (int)blockIdx.x;
        f32x16 o[2];
#pragma unroll
        for (int r = 0; r < 16; ++r) { o[0][r] = 0.f; o[1][r] = 0.f; }
        LAS float* accw = (LAS float*)(F.lds + L_OST) + w * 2048 + lane;
        float cg[8], cl[8];
#pragma unroll
        for (int k = 0; k < 8; ++k) { cg[k] = 0.f; cl[k] = 0.f; }
        float mref = 0.f, lrun = 0.f; unsigned selmask = 0u;
#define FOLD(cf_, MODE) do { if (hi == 0) wsf[r32] = (cf_); asm volatile("s_waitcnt lgkmcnt(0)" ::: "memory"); \
            float f_[16]; _Pragma("unroll") for (int r = 0; r < 16; ++r) f_[r] = wsf[crow(r, hi)]; \
            if ((MODE) == 0) { _Pragma("unroll") for (int r = 0; r < 16; ++r) { accw[(2 * r) * 64] = f_[r] * o[0][r]; accw[(2 * r + 1) * 64] = f_[r] * o[1][r]; o[0][r] = 0.f; o[1][r] = 0.f; } } \
            else { float a0_[16], a1_[16]; _Pragma("unroll") for (int r = 0; r < 16; ++r) { a0_[r] = accw[(2 * r) * 64]; a1_[r] = accw[(2 * r + 1) * 64]; } \
                if ((MODE) == 1) { _Pragma("unroll") for (int r = 0; r < 16; ++r) { accw[(2 * r) * 64] = a0_[r] + f_[r] * o[0][r]; accw[(2 * r + 1) * 64] = a1_[r] + f_[r] * o[1][r]; o[0][r] = 0.f; o[1][r] = 0.f; } } \
                else { _Pragma("unroll") for (int r = 0; r < 16; ++r) { o[0][r] = a0_[r] + f_[r] * o[0][r]; o[1][r] = a1_[r] + f_[r] * o[1][r]; } } } \
            asm volatile("s_waitcnt lgkmcnt(0)" ::: "memory"); mref = 0.f; lrun = 0.f; } while (0)
        for (int i = 0; i < ntile; ++i) {
            EC_MARK();
            if (i == 0 && pre_unit) asm volatile("s_waitcnt vmcnt(6)" ::: "memory");
            else if (i + 1 < ntile) asm volatile("s_waitcnt vmcnt(2)" ::: "memory"); else asm volatile("s_waitcnt vmcnt(0)" ::: "memory");
            asm volatile("s_waitcnt lgkmcnt(0)" ::: "memory"); __builtin_amdgcn_s_barrier(); asm volatile("" ::: "memory");
            EC_ADD(ec_wait);
            if (i + 2 < ntile) TILE_DMA(i + 2);
            const unsigned so = (unsigned)(i % NSLOT) * SLOTB;
            const LAS char* Ks = ldsb + L_K + so; const int vb = (int)(lds0 + L_V + so) + vbl;
            const int kind = i < 2 ? 0 : (i < 2 + nwin ? 1 : 2);
            const int kt = kind == 0 ? i : (kind == 1 ? tb - (i - 2) : i - 2 - nwin);
            if (i == 2 + nwin) { const float lt = xhalf_sum(lrun); FOLD(gl2 / lt, 1); }
            const bool rowok = kind == 2 ? ((selmask >> kt) & 1u) != 0u : true;
            if (__any(rowok)) {
                const bool cfar = kind == 0 && kt == 0 && t0 >= 1152;
                const bool near = (kind == 0 && !cfar) || (kind != 0 && kt + 2 >= tb); const float b31 = tbh[191 - 127];
                const bool first = (i == 0) || (i == 2) || (i == 2 + nwin);
                const bool diag = kind != 0 && kt == tb, wedge = kind == 1 && (kt == tb - 8);
                f32x16 p0, p1; qkt(p0, p1, Ks, qr, r32, hi, (near ? 0.f : b31) - mref);
                if (kind == 0 && !cfar) {
                    const int dbase = t - 31 - 1024 * kt - 64 * hi;
#pragma unroll
                    for (int r = 0; r < 16; ++r) { const int cc = (r & 3) + 8 * (r >> 2); const int d0 = dbase - 16 * cc, d1 = d0 - 512;
                        p0[r] += tbh[191 - (int)min((unsigned)d0, 127u)]; p1[r] += tbh[191 - (int)min((unsigned)d1, 127u)]; }
                    asm volatile("" ::: "memory");
#pragma unroll
                    for (int r = 0; r < 16; ++r) { const int cc = (r & 3) + 8 * (r >> 2); const int d0 = dbase - 16 * cc, d1 = d0 - 512;
                        p0[r] = d0 >= 0 ? p0[r] : NEG; p1[r] = d1 >= 0 ? p1[r] : NEG; }
                } else if (near && kind != 0) {
                    const int dbase = t - 64 * kt - 4 * hi;
                    const LAS float* bp = tbh + (191 - dbase);
#pragma unroll
                    for (int r = 0; r < 16; ++r) { const int cc = (r & 3) + 8 * (r >> 2); p0[r] += bp[cc]; p1[r] += bp[cc + 32]; }
                    if (diag) {
                        asm volatile("" ::: "memory");
#pragma unroll
                        for (int r = 0; r < 16; ++r) { const int cc = (r & 3) + 8 * (r >> 2); const int d0 = dbase - cc, d1 = d0 - 32;
                            p0[r] = d0 >= 0 ? p0[r] : NEG; p1[r] = d1 >= 0 ? p1[r] : NEG; }
                    }
                } else if (wedge) {
                    const int dbase = t - 64 * kt - 4 * hi;
#pragma unroll
                    for (int r = 0; r < 16; ++r) { const int cc = (r & 3) + 8 * (r >> 2); const int d0 = dbase - cc, d1 = d0 - 32;
                        if (d0 >= 512) p0[r] = NEG; if (d1 >= 512) p1[r] = NEG; }
                }
                float alpha = 1.f;
                if (first) {
                    float mx;
                    { float m0 = fmaxf(fmaxf(p0[0], p0[1]), p0[2]), m1 = fmaxf(fmaxf(p1[0], p1[1]), p1[2]);
#pragma unroll
                      for (int r = 3; r < 15; r += 2) { m0 = fmaxf(fmaxf(m0, p0[r]), p0[r + 1]); m1 = fmaxf(fmaxf(m1, p1[r]), p1[r + 1]); }
                      mx = fmaxf(fmaxf(m0, m1), fmaxf(p0[15], p1[15])); }
                    mx = xhalf_max(mx);
                    const float dl = (mx == NEG) ? 0.f : mx;
                    mref += dl;
#pragma unroll
                    for (int r = 0; r < 16; ++r) { p0[r] -= dl; p1[r] -= dl; }
                }
#pragma unroll
                for (int r = 0; r < 16; ++r) { p0[r] = __builtin_amdgcn_exp2f(p0[r]); p1[r] = __builtin_amdgcn_exp2f(p1[r]); }
                float ls;
                { const f32x16 sv = p0 + p1; ls = ((sv[0] + sv[1]) + (sv[2] + sv[3])) + ((sv[4] + sv[5]) + (sv[6] + sv[7])) + (((sv[8] + sv[9]) + (sv[10] + sv[11])) + ((sv[12] + sv[13]) + (sv[14] + sv[15]))); }
                if (!rowok) ls = 0.f;
                const float lsr = first ? 0.f : xhalf_sum(ls);
                if (!first && __any(lsr > 1048576.f)) {
                    const float dl = lsr > 1048576.f ? __builtin_amdgcn_logf(lsr) : 0.f;
                    mref += dl; alpha = __builtin_amdgcn_exp2f(-dl);
#pragma unroll
                    for (int r = 0; r < 16; ++r) { p0[r] *= alpha; p1[r] *= alpha; }
                    ls *= alpha; lrun *= alpha;
                    if (hi == 0) wsf[r32] = alpha; asm volatile("s_waitcnt lgkmcnt(0)" ::: "memory");
#pragma unroll
                    for (int r = 0; r < 16; ++r) { const float f = wsf[crow(r, hi)]; o[0][r] *= f; o[1][r] *= f; }
                    asm volatile("s_waitcnt lgkmcnt(0)" ::: "memory");
                }
                lrun += ls;
                v4u pw0, pw1, pw2, pw3;
                pw0.x = cvtpk(p0[0], p0[1]); pw0.y = cvtpk(p0[2], p0[3]); pw0.z = cvtpk(p0[4], p0[5]); pw0.w = cvtpk(p0[6], p0[7]);
                pw1.x = cvtpk(p0[8], p0[9]); pw1.y = cvtpk(p0[10], p0[11]); pw1.z = cvtpk(p0[12], p0[13]); pw1.w = cvtpk(p0[14], p0[15]);
                pw2.x = cvtpk(p1[0], p1[1]); pw2.y = cvtpk(p1[2], p1[3]); pw2.z = cvtpk(p1[4], p1[5]); pw2.w = cvtpk(p1[6], p1[7]);
                pw3.x = cvtpk(p1[8], p1[9]); pw3.y = cvtpk(p1[10], p1[11]); pw3.z = cvtpk(p1[12], p1[13]); pw3.w = cvtpk(p1[14], p1[15]);
                if (kind == 2 && !__all(rowok)) { const unsigned km = rowok ? 0xffffffffu : 0u;
                    pw0.x &= km; pw0.y &= km; pw0.z &= km; pw0.w &= km; pw1.x &= km; pw1.y &= km; pw1.z &= km; pw1.w &= km;
                    pw2.x &= km; pw2.y &= km; pw2.z &= km; pw2.w &= km; pw3.x &= km; pw3.y &= km; pw3.z &= km; pw3.w &= km; }
                asm volatile("" ::: "memory"); EC_ADD(ec_s1);
                pv(o, vb, __builtin_bit_cast(bf16x8, pw0), __builtin_bit_cast(bf16x8, pw1), __builtin_bit_cast(bf16x8, pw2), __builtin_bit_cast(bf16x8, pw3));
                asm volatile("s_nop 0" ::: "memory"); EC_ADD(ec_pv);
                if (i == 0) {
#pragma unroll
                    for (int a = 0; a < 4; ++a) { cg[a] = (p0[4 * a] + p0[4 * a + 1]) + (p0[4 * a + 2] + p0[4 * a + 3]); cl[a] = p0[4 * a + 3]; cg[4 + a] = (p1[4 * a] + p1[4 * a + 1]) + (p1[4 * a + 2] + p1[4 * a + 3]); cl[4 + a] = p1[4 * a + 3]; } }
                if (i == 1) {
                    const float lt = xhalf_sum(lrun); const float inv = lt > 0.f ? 1.f / lt : 0.f;
                    const float ia = inv * alpha;
                    { float prev = 0.f;
#pragma unroll
                      for (int k = 0; k < 16; ++k) { float gsum, lst;
                          if (k < 8) { gsum = cg[k] * ia; lst = cl[k] * ia; }
                          else if (k < 12) { const int a = k - 8; gsum = ((p0[4 * a] + p0[4 * a + 1]) + (p0[4 * a + 2] + p0[4 * a + 3])) * inv; lst = p0[4 * a + 3] * inv; }
                          else { const int a = k - 12; gsum = ((p1[4 * a] + p1[4 * a + 1]) + (p1[4 * a + 2] + p1[4 * a + 3])) * inv; lst = p1[4 * a + 3] * inv; }
                          const float ot = xhalf_other(lst, hi); gsum += hi ? ot : prev; prev = ot;
                          gsum += dpp_xor1(gsum); gsum += dpp_xor2(gsum);
                          if (hr == 0) impw[(r32 >> 2) * 32 + 2 * k + hi] = gsum; } }
                    asm volatile("s_waitcnt lgkmcnt(0)" ::: "memory");
                    {
                      const int tk = lane >> 3, sub = lane & 7;
                      const f32x4 sv = *(const LAS f32x4*)(impw + tk * 32 + sub * 4);
                      float sc4[4];
#pragma unroll
                      for (int q = 0; q < 4; ++q) { const int j = sub * 4 + q; sc4[q] = j > tb ? -1.f : ((j == 0 || j == tb || j == tb - 1) ? INFINITY : sv[q]); }
                      unsigned mask = 0u;
#pragma unroll 1
                      for (int k = 0; k < 8; ++k) {
                          float bv = sc4[0]; int gj = sub * 4;
#pragma unroll
                          for (int q = 1; q < 4; ++q) if (sc4[q] > bv) { bv = sc4[q]; gj = sub * 4 + q; }
                          { float ov = dpp_xor1(bv); int oj = dpp_xor1i(gj); if (ov > bv || (ov == bv && oj < gj)) { bv = ov; gj = oj; }
                            ov = dpp_xor2(bv); oj = dpp_xor2i(gj); if (ov > bv || (ov == bv && oj < gj)) { bv = ov; gj = oj; }
                            ov = dpp_hmir(bv); oj = dpp_hmiri(gj); if (ov > bv || (ov == bv && oj < gj)) { bv = ov; gj = oj; } }
                          mask |= 1u << gj;
#pragma unroll
                          for (int q = 0; q < 4; ++q) if (gj == sub * 4 + q) sc4[q] = NEG;
                      }
                      mask &= (tb == 31) ? 0xffffffffu : ((1u << (tb + 1)) - 1u);
                      selmask = (unsigned)__shfl((int)mask, (r32 >> 2) * 8); }
                    FOLD(gl0 * inv, 0);
                }
            }
        }
        asm volatile("s_waitcnt lgkmcnt(0)" ::: "memory"); __builtin_amdgcn_s_barrier(); asm volatile("" ::: "memory");
        if (p + (int)gridDim.x < BATCH * 2 * 32) UNIT_PRE(p + (int)gridDim.x);
        { const float lt = xhalf_sum(lrun); FOLD(gl1 / lt, 2); }
        { LAS bf16* stg = (LAS bf16*)(F.lds + L_OST + w * 8192);
#pragma unroll
          for (int r = 0; r < 16; ++r) { const int orow = crow(r, hi);
#pragma unroll
              for (int d0 = 0; d0 < 2; ++d0) stg[orow * 64 + d0 * 32 + r32] = (bf16)f2bf(o[d0][r]); }
          asm volatile("s_waitcnt lgkmcnt(0)" ::: "memory");
#pragma unroll
          for (int i2 = 0; i2 < 4; ++i2) { const int row = i2 * 8 + (lane >> 3), ch = lane & 7; const v4u vv = *(const LAS v4u*)(stg + row * 64 + ch * 8);
              *(v4u*)(CAT + ((size_t)b * T + t0 + 8 * w + (row >> 2)) * D + (4 * g + (row & 3)) * 64 + ch * 8) = vv; }
          asm volatile("s_waitcnt lgkmcnt(0)" ::: "memory"); }
#undef FOLD
#undef TILE_DMA
    }
#undef UNIT_PRE
#ifdef ATT_ECHO
    { const unsigned long long dur = (ATT_ECHO == 1) ? ec_wait : (ATT_ECHO == 2) ? ec_s1 : ec_pv;
      if (w == 0) { const unsigned long long t0_ = __builtin_amdgcn_s_memtime(); while (__builtin_amdgcn_s_memtime() - t0_ < dur) __builtin_amdgcn_s_sleep(4); }
      __syncthreads(); }
#endif
}

__device__ __forceinline__ void ph_compress(const Args& A, Frame& F, int l) {
    LAS float* P = (LAS float*)F.lds;
    LAS float* G = (LAS float*)(F.lds + 17408);
    LAS float* W2 = (LAS float*)(F.lds + 25600);
    const bf16* U = (const bf16*)(F.ws + WS_U);
    const int lane = F.lane, w = F.wave, rt = w & 1, hf = (w >> 1) & 1, ch = w >> 2;
    for (int it = blockIdx.x; it < 256; it += gridDim.x) {
        const int q = it & 3, g = (it >> 2) & 1, b = (it >> 3) & 15, kv = it >> 7;
        const bf16* WT = (const bf16*)(F.ws + WS_WCMP) + (size_t)kv * 64 * 2048;
        const float* w2 = A.in[I_CW2] + (size_t)(l * 2 + kv) * 64 * 64;
        float posb = 0.f;
        { const float* pp = (const float*)(F.ws + WS_WCMP + 512 * 1024) + kv * 64 + (F.tid & 63); float pt[16];
#pragma unroll
          for (int i = 0; i < 16; ++i) pt[i] = pp[i * 128];
#pragma unroll
          for (int i = 0; i < 16; ++i) posb += pt[i]; }
        { f32x4 t[2];
#pragma unroll
          for (int i = 0; i < 2; ++i) t[i] = ((const f32x4*)w2)[F.tid + 512 * i];
          asm volatile("" ::: "memory");
#pragma unroll
          for (int i = 0; i < 2; ++i) ((LAS f32x4*)W2)[F.tid + 512 * i] = t[i]; }
        f32x4 acc[2] = {(f32x4){0.f, 0.f, 0.f, 0.f}, (f32x4){0.f, 0.f, 0.f, 0.f}};
        const int kq = lane >> 4, rc = lane & 15;
        int chunk = 32 * q + 16 * rt + rc + hf; chunk = chunk < 128 ? chunk : 127;
        const bf16* ap = U + ((size_t)b * T + 16 * chunk) * NU + (kv ? UVC : UKC) + g * 64 + 8 * kq;
        const bf16* bp = WT + (size_t)(32 * ch + rc) * 2048 + 1024 * hf + 8 * kq;
        for (int ks0 = 0; ks0 < 32; ks0 += 8) {
            bf16x8 a[8], bb[8][2];
#pragma unroll
            for (int u = 0; u < 8; ++u) { const int ks = ks0 + u; a[u] = *(const bf16x8*)(ap + (size_t)(ks >> 1) * NU + (ks & 1) * 32);
                bb[u][0] = *(const bf16x8*)(bp + 32 * ks); bb[u][1] = *(const bf16x8*)(bp + (size_t)16 * 2048 + 32 * ks); }
            asm volatile("" ::: "memory");
#pragma unroll
            for (int u = 0; u < 8; ++u) { acc[0] = __builtin_amdgcn_mfma_f32_16x16x32_bf16(a[u], bb[u][0], acc[0], 0, 0, 0); acc[1] = __builtin_amdgcn_mfma_f32_16x16x32_bf16(a[u], bb[u][1], acc[1], 0, 0, 0); } }
#pragma unroll
        for (int ct = 0; ct < 2; ++ct)
#pragma unroll
            for (int r = 0; r < 4; ++r) P[(hf * 32 + 16 * rt + kq * 4 + r) * 68 + 32 * ch + 16 * ct + rc] = acc[ct][r];
        __syncthreads();
#pragma unroll
        for (int i = 0; i < 4; ++i) { const int idx = F.tid + 512 * i, n = idx >> 6, j = idx & 63; G[idx] = gelu_tanh_f(P[n * 68 + j] + P[(32 + n) * 68 + j] + posb); }
        __syncthreads();
        { const int j2 = F.tid & 63, ng = F.tid >> 6;
          bf16* OUT = (bf16*)(F.ws + (kv ? WS_VCMP : WS_KCMP));
          float sacc[4] = {0.f, 0.f, 0.f, 0.f};
#pragma unroll 1
          for (int jc = 0; jc < 4; ++jc) { float wv[16]; f32x4 gv[4][4];
#pragma unroll
              for (int i = 0; i < 16; ++i) wv[i] = W2[(16 * jc + i) * 64 + j2];
#pragma unroll
              for (int i = 0; i < 4; ++i)
#pragma unroll
                  for (int q4 = 0; q4 < 4; ++q4) gv[i][q4] = *(const LAS f32x4*)(G + (ng + 8 * i) * 64 + 16 * jc + 4 * q4);
              asm volatile("" ::: "memory");
#pragma unroll
              for (int i = 0; i < 4; ++i)
#pragma unroll
                  for (int q4 = 0; q4 < 4; ++q4) sacc[i] += gv[i][q4].x * wv[4 * q4] + gv[i][q4].y * wv[4 * q4 + 1] + gv[i][q4].z * wv[4 * q4 + 2] + gv[i][q4].w * wv[4 * q4 + 3]; }
#pragma unroll
          for (int i = 0; i < 4; ++i) { const int nl = ng + 8 * i, n = 32 * q + nl; OUT[((size_t)(b * NCP + n) * 2 + g) * 64 + j2] = (bf16)f2bf(n < NCMP ? sacc[i] : 0.f); } }
        __syncthreads();
    }
}

__device__ __forceinline__ void ph_conv(const Args& A, Frame& F, int l) {
    typedef _Float16 h8 __attribute__((ext_vector_type(8)));
    typedef _Float16 h4 __attribute__((ext_vector_type(4)));
    LAS _Float16* taps = (LAS _Float16*)F.lds;
    LAS _Float16* glu = (LAS _Float16*)(F.lds + 31 * 512 * 2);
    const bf16* U = (const bf16*)(F.ws + WS_U); bf16* CAT = (bf16*)(F.ws + WS_CAT);
    const int lane = F.lane, w = F.wave, c0 = 8 * lane;
    { const f32x4* src = (const f32x4*)(A.in[I_CVW] + (size_t)l * 31 * 512); f32x4 t[8];
#pragma unroll
      for (int i = 0; i < 8; ++i) { const int q = F.tid + 512 * i; t[i] = q < 31 * 128 ? src[q] : (f32x4){0.f, 0.f, 0.f, 0.f}; }
      asm volatile("" ::: "memory");
#pragma unroll
      for (int i = 0; i < 8; ++i) { const int q = F.tid + 512 * i; if (q < 31 * 128) { h4 o; o[0] = (_Float16)t[i].x; o[1] = (_Float16)t[i].y; o[2] = (_Float16)t[i].z; o[3] = (_Float16)t[i].w; ((LAS h4*)taps)[q] = o; } } }
    f32x4 cb[2], lg[2], lb[2];
#pragma unroll
    for (int h = 0; h < 2; ++h) { cb[h] = *(const f32x4*)(A.in[I_CVB] + l * 512 + c0 + 4 * h); lg[h] = *(const f32x4*)(A.in[I_CVG] + l * 512 + c0 + 4 * h); lb[h] = *(const f32x4*)(A.in[I_CVBE] + l * 512 + c0 + 4 * h); }
    __syncthreads();
    for (int it = blockIdx.x; it < M / 32; it += gridDim.x) {
        const int b = it >> 6, t0 = (it & 63) * 32;
        { v4u av[8], gv[8];
#pragma unroll
          for (int i = 0; i < 8; ++i) { const int q = F.tid + 512 * i; const int rr = q >> 6, ch = (q & 63) * 8; const int tt = t0 - 30 + rr; const bool ok = q < 62 * 64 && tt >= 0;
              const bf16* ur = U + ((size_t)b * T + (ok ? tt : 0)) * NU; av[i] = *(const v4u*)(ur + UCA + ch); gv[i] = *(const v4u*)(ur + UCG + ch); }
          asm volatile("" ::: "memory");
#pragma unroll
          for (int i = 0; i < 8; ++i) { const int q = F.tid + 512 * i; const int rr = q >> 6, ch = (q & 63) * 8; const int tt = t0 - 30 + rr;
              if (q < 62 * 64) { h8 o;
                  if (tt >= 0) { o[0] = (_Float16)(bflo(av[i].x) * sigmoid_f(bflo(gv[i].x))); o[1] = (_Float16)(bfhi(av[i].x) * sigmoid_f(bfhi(gv[i].x))); o[2] = (_Float16)(bflo(av[i].y) * sigmoid_f(bflo(gv[i].y))); o[3] = (_Float16)(bfhi(av[i].y) * sigmoid_f(bfhi(gv[i].y)));
                      o[4] = (_Float16)(bflo(av[i].z) * sigmoid_f(bflo(gv[i].z))); o[5] = (_Float16)(bfhi(av[i].z) * sigmoid_f(bfhi(gv[i].z))); o[6] = (_Float16)(bflo(av[i].w) * sigmoid_f(bflo(gv[i].w))); o[7] = (_Float16)(bfhi(av[i].w) * sigmoid_f(bfhi(gv[i].w))); }
                  else {
#pragma unroll
                      for (int k = 0; k < 8; ++k) o[k] = (_Float16)0.f; }
                  *(LAS h8*)(glu + rr * 512 + ch) = o; } } }
        __syncthreads();
        h8 y16[4];
        { h8 cb16; cb16[0] = (_Float16)cb[0].x; cb16[1] = (_Float16)cb[0].y; cb16[2] = (_Float16)cb[0].z; cb16[3] = (_Float16)cb[0].w; cb16[4] = (_Float16)cb[1].x; cb16[5] = (_Float16)cb[1].y; cb16[6] = (_Float16)cb[1].z; cb16[7] = (_Float16)cb[1].w;
#pragma unroll
          for (int i = 0; i < 4; ++i) y16[i] = cb16; }
        h8 wk[11];
#pragma unroll
        for (int c8 = 0; c8 < 34; c8 += 8) {
            h8 gh[8];
#pragma unroll
            for (int i = 0; i < 8; ++i) { const int rho = c8 + i;
                if (rho < 34) gh[i] = *(const LAS h8*)(glu + (4 * w + rho) * 512 + c0);
                if (rho < 31) wk[3 + i] = *(const LAS h8*)(taps + rho * 512 + c0); }
            asm volatile("" ::: "memory");
#pragma unroll
            for (int i = 0; i < 8; ++i) { const int rho = c8 + i;
                if (rho < 34) {
#pragma unroll
                    for (int t = 0; t < 4; ++t) { const int k = rho - t; if (k >= 0 && k < 31) y16[t] += wk[3 + i - t] * gh[i]; } } }
#pragma unroll
            for (int t = 0; t < 3; ++t) wk[t] = wk[8 + t];
        }
        f32x4 y[4][2];
#pragma unroll
        for (int i = 0; i < 4; ++i) { y[i][0] = (f32x4){(float)y16[i][0], (float)y16[i][1], (float)y16[i][2], (float)y16[i][3]}; y[i][1] = (f32x4){(float)y16[i][4], (float)y16[i][5], (float)y16[i][6], (float)y16[i][7]}; }
#pragma unroll
        for (int i = 0; i < 4; ++i) {
            float s = (y[i][0].x + y[i][0].y) + (y[i][0].z + y[i][0].w) + (y[i][1].x + y[i][1].y) + (y[i][1].z + y[i][1].w);
            const float mean = wave_sum(s) * (1.f / 512.f);
            const f32x4 d0 = y[i][0] - mean, d1 = y[i][1] - mean;
            float q = (d0.x * d0.x + d0.y * d0.y) + (d0.z * d0.z + d0.w * d0.w) + (d1.x * d1.x + d1.y * d1.y) + (d1.z * d1.z + d1.w * d1.w);
            const float rstd = 1.f / sqrtf(wave_sum(q) * (1.f / 512.f) + LN_EPS);
            const f32x4 z0 = d0 * rstd * lg[0] + lb[0], z1 = d1 * rstd * lg[1] + lb[1];
            v4u o; o.x = pk2(z0.x * sigmoid_f(z0.x), z0.y * sigmoid_f(z0.y)); o.y = pk2(z0.z * sigmoid_f(z0.z), z0.w * sigmoid_f(z0.w));
            o.z = pk2(z1.x * sigmoid_f(z1.x), z1.y * sigmoid_f(z1.y)); o.w = pk2(z1.z * sigmoid_f(z1.z), z1.w * sigmoid_f(z1.w));
            *(v4u*)(CAT + ((size_t)b * T + t0 + 4 * w + i) * D + 512 + c0) = o; }
        __syncthreads();
    }
}

constexpr int NSTEP_PRO = 2, NSTEP_LAYER = 8, NSTEPS = NSTEP_PRO + DEPTH * NSTEP_LAYER;
#define IN(k) (lo <= (k) && (k) < hi)
#define SEAM(k) do { if (IN(k) && IN((k) + 1)) xcd_barrier(bar); } while (0)
#define FRESH() do { int t_ = (int)__builtin_amdgcn_mbcnt_hi(~0u, __builtin_amdgcn_mbcnt_lo(~0u, 0u)) + 64 * F.wave0; asm volatile("" : "+v"(t_)); F.tid = t_; F.lane = t_ & 63; F.wave = __builtin_amdgcn_readfirstlane(t_ >> 6); \
        size_t z_ = 0; asm volatile("" : "+s"(z_)); F.ws = args.ws + z_; F.ctl = (gu32*)(F.ws + WS_CTL); F.X = args.out + z_; } while (0)

template <int L> __device__ __forceinline__ void layer_steps(const Args& args, Frame& F, const XcdBarrier& bar, const int lo, const int hi) {
    constexpr int l = L;
        constexpr int base = NSTEP_PRO + l * NSTEP_LAYER; constexpr bool moe = (l & 1) != 0;
        if (IN(base + 0)) { FRESH();
            pg8::Gemm g{(const pg8::bf16_t*)(F.ws + WS_H), (const pg8::bf16_t*)(F.ws + WS_WIN), M, NU, D}; pg8::StaticOrder S; S.init(M, NU, F.G, (int)blockIdx.x);
            pg8::EpiU E{(pg8::bf16_t*)(F.ws + WS_U), NU, 2, INPROJ_FP8 ? C2 / 32.f : C2, INPROJ_FP8 ? 1.f / 32.f : 1.f};
            pg8::gemm_phase<pg8::EpiU, pg8::StaticOrder, true, true, INPROJ_FP8 != 0>(F.lds + RING_OFF, g, S, E, F.tid);
        }
        SEAM(base + 0);
        if (IN(base + 1)) { FRESH(); ph_compress(args, F, l); FRESH(); ph_conv(args, F, l); }
        SEAM(base + 1);
        if (IN(base + 2)) { FRESH();
#ifdef USE_NAIVE_ATTN
            ph_attn_naive(args, F, l);
#else
            ph_attn(args, F, l);
#endif
        }
        SEAM(base + 2);
        if (IN(base + 3)) { FRESH();
            pg8::Gemm g{(const pg8::bf16_t*)(F.ws + WS_CAT), (const pg8::bf16_t*)(F.ws + WS_WO), M, D, D}; pg8::StaticOrder S; S.init(M, D, F.G, (int)blockIdx.x);
            pg8::EpiBf E{(pg8::bf16_t*)(F.ws + WS_Y), D, 4, 1.f};
            pg8::gemm_phase<pg8::EpiBf, pg8::StaticOrder, true, true>(F.lds + RING_OFF, g, S, E, F.tid);
        }
        SEAM(base + 3);
        if (IN(base + 4)) { FRESH(); ph_ln1(args, F, l); }
        SEAM(base + 4);
        if (IN(base + 5)) { FRESH();
            pg8::MoeOrder S;
            if constexpr (moe) S.init_moe((unsigned*)(F.ctl + CW_CNT) + (l >> 1) * 8 * 64, 2 * FFE / 256, F.G, (int)blockIdx.x, 1); else S.init_dense(M / 256, 2 * FF / 256, F.G, (int)blockIdx.x);
            pg8::Gemm g{(const pg8::bf16_t*)(F.ws + (moe ? WS_HG : WS_H)), (const pg8::bf16_t*)(F.ws + WS_W1), M, 0, D};
            if constexpr (moe || dense_up8(l)) { pg8::EpiSwiGLU8 E{(unsigned char*)(F.ws + WS_HID), moe ? FFE : FF, moe ? 2 * FFE / 256 : 2 * FF / 256, 1.f / 32.f};
                pg8::gemm_phase<pg8::EpiSwiGLU8, pg8::MoeOrder, true, true, true>(F.lds + RING_OFF, g, S, E, F.tid); }
            else if constexpr (DENSE_FP8 == 2) { pg8::EpiSwiGLU8 E{(unsigned char*)(F.ws + WS_HID), FF, 2 * FF / 256, 1.f};
                pg8::gemm_phase<pg8::EpiSwiGLU8, pg8::MoeOrder, true, true>(F.lds + RING_OFF, g, S, E, F.tid); }
            else { pg8::EpiSwiGLU E{(pg8::bf16_t*)(F.ws + WS_HID), FF, 2 * FF / 256};
                pg8::gemm_phase<pg8::EpiSwiGLU, pg8::MoeOrder, true, true>(F.lds + RING_OFF, g, S, E, F.tid); }
        }
        SEAM(base + 5);
        if (IN(base + 6)) { FRESH();
            pg8::MoeOrder S;
            if constexpr (moe) S.init_moe((unsigned*)(F.ctl + CW_CNT) + (l >> 1) * 8 * 64, 4, F.G, (int)blockIdx.x, 0); else S.init_dense(M / 256, 4, F.G, (int)blockIdx.x);
            pg8::Gemm g{(const pg8::bf16_t*)(F.ws + WS_HID), (const pg8::bf16_t*)(F.ws + WS_W2), M, D, moe ? FFE : FF};
            if constexpr (moe) {
                const int n_units = S.so.nwg, n_full = (n_units / F.G) * F.G, tail = n_units - n_full;
                const int chunks = tail == 0 ? 1 : (tail * 7 <= F.G ? 7 : (tail * 2 <= F.G ? 2 : 1));
                if (chunks > 1) S.so.nwg = n_full;
                { pg8::EpiBf E{(pg8::bf16_t*)(F.ws + WS_Y2), D, 4, 1.f / 128.f};
                  pg8::gemm_phase<pg8::EpiBf, pg8::MoeOrder, true, true, true>(F.lds + RING_OFF, g, S, E, F.tid); }
                if (chunks > 1) {
                    asm volatile("s_waitcnt vmcnt(0) lgkmcnt(0)" ::: "memory"); __syncthreads();
                    FRESH();
                    const int kb = FFE / chunks;
                    pg8::OneUnit S1; S1.have = 0; S1.u.pm = 0; S1.u.pn = 0; S1.u.pa = 0; int cch = 0;
                    if ((int)blockIdx.x < tail * chunks) { const int tu = (int)blockIdx.x / chunks; cch = (int)blockIdx.x % chunks; pg8::Unit t; S.unit_of(n_full + tu, t);
                        S1.have = 1; S1.u.pm = tu * chunks + cch; S1.u.pn = t.pn; S1.u.pa = t.pa; }
                    pg8::Gemm g1{(const pg8::bf16_t*)(F.ws + WS_HID + (size_t)cch * kb), (const pg8::bf16_t*)(F.ws + WS_W2 + (size_t)cch * kb), M, D, kb, FFE};
                    pg8::EpiF32P E1{(float*)(F.ws + WS_H), 256};
                    pg8::gemm_phase<pg8::EpiF32P, pg8::OneUnit, true, true, true>(F.lds + RING_OFF, g1, S1, E1, F.tid);
                    xcd_barrier(bar);
                    FRESH();
                    { const float* Pp = (const float*)(F.ws + WS_H); bf16* Y2o = (bf16*)(F.ws + WS_Y2);
                      const int gw = (int)blockIdx.x * NWAVES + F.wave, NGW = F.G * NWAVES;
                      for (int rr = gw; rr < tail * 256; rr += NGW) { const int tu = rr >> 8, r = rr & 255; pg8::Unit t; S.unit_of(n_full + tu, t);
                          f32x4 a = {0.f, 0.f, 0.f, 0.f};
                          for (int c2 = 0; c2 < chunks; ++c2) a += *((const f32x4*)(Pp + ((size_t)(tu * chunks + c2) * 256 + r) * 256) + F.lane);
                          a = a * (1.f / 128.f);
                          *((unsigned long long*)(Y2o + ((size_t)t.pm * 256 + r) * D + (t.pn & 3) * 256) + F.lane) = (unsigned long long)pk2(a.x, a.y) | ((unsigned long long)pk2(a.z, a.w) << 32); } }
                }
            } else if constexpr (DENSE_FP8 != 0) { pg8::EpiBf E{(pg8::bf16_t*)(F.ws + WS_Y), D, 4, 1.f / 128.f};
                pg8::gemm_phase<pg8::EpiBf, pg8::MoeOrder, true, true, true>(F.lds + RING_OFF, g, S, E, F.tid); }
            else { pg8::EpiBf E{(pg8::bf16_t*)(F.ws + WS_Y), D, 4, 1.f};
                pg8::gemm_phase<pg8::EpiBf, pg8::MoeOrder, true, true>(F.lds + RING_OFF, g, S, E, F.tid); }
        }
        SEAM(base + 6);
        if (IN(base + 7)) { FRESH(); ph_ln2(args, F, l); FRESH(); if (l + 1 < DEPTH) ph_cvt(args, F, l + 1); }
        SEAM(base + 7);
}
__global__ void __launch_bounds__(NWAVES * 64, 2) fwd(Args args) {
    extern __shared__ __attribute__((aligned(16))) unsigned char lds[];
    Frame F;
    F.lds = (LAS unsigned char*)lds;
    F.MISC = (volatile LAS unsigned*)(F.lds + MISC_OFF);
    F.tid = threadIdx.x; F.lane = F.tid & 63; F.wave = __builtin_amdgcn_readfirstlane(F.tid >> 6); F.wave0 = F.wave;
    F.G = gridDim.x;
    F.ws = args.ws; F.ctl = (gu32*)(args.ws + WS_CTL); F.X = args.out;
    for (int u = F.tid; u < (LDS_BYTES - LDSCTL_OFF) / 4; u += NWAVES * 64) ((LAS unsigned*)(F.lds + LDSCTL_OFF))[u] = 0u;
    __syncthreads();
    const int lo = args.ph_lo, hi = args.ph_hi;
    XcdBarrier bar; bar.bar = (unsigned*)(F.ctl + CW_BAR); bar.x = 0; bar.st = nullptr; bar.w0 = F.wave0;
    if (hi - lo > 1) { bar = xcd_barrier_post((unsigned*)(F.ctl + CW_BAR), F.MISC + 8); bar.w0 = F.wave0; }
    if (IN(0)) { ph_ada(args, F); ph_tbl(args, F); ph_cvt(args, F, 0); }
    SEAM(0);
    if (IN(1)) { ph_mod0(args, F); }
    SEAM(1);
    layer_steps<0>(args, F, bar, lo, hi); layer_steps<1>(args, F, bar, lo, hi); layer_steps<2>(args, F, bar, lo, hi); layer_steps<3>(args, F, bar, lo, hi);
#undef IN
#undef SEAM
}

extern "C" void kernel_launch(void* const* d_in, const int* in_sizes, int n_in, void* d_out, int out_size, void* d_ws, size_t ws_size, hipStream_t stream) {
    static int grid = 0;
    if (grid == 0) {
        if (n_in != 21 || out_size != M * D || ws_size < WS_END) { fprintf(stderr, "kernel_launch: unexpected shapes (n_in %d out %d ws %zu)\n", n_in, out_size, ws_size); grid = -1; return; }
        int dev = 0, cus = 0, per_cu = 0;
        if (hipGetDevice(&dev) != hipSuccess || hipDeviceGetAttribute(&cus, hipDeviceAttributeMultiprocessorCount, dev) != hipSuccess) { grid = -1; return; }
        if (hipFuncSetAttribute((const void*)fwd, hipFuncAttributeMaxDynamicSharedMemorySize, LDS_BYTES) != hipSuccess) { fprintf(stderr, "kernel_launch: hipFuncSetAttribute failed\n"); grid = -1; return; }
        if (hipOccupancyMaxActiveBlocksPerMultiprocessor(&per_cu, (const void*)fwd, NWAVES * 64, LDS_BYTES) != hipSuccess || per_cu < 1) fprintf(stderr, "kernel_launch: occupancy query reports %d\n", per_cu);
        (void)hipGetLastError();
        grid = cus;
    }
    if (grid < 0) return;
    (void)in_sizes;
    if (hipMemsetAsync((char*)d_ws + WS_CTL, 0, CTL_ZERO_BYTES, stream) != hipSuccess) return;
    Args a{};
    for (int i = 0; i < 21; ++i) a.in[i] = (const float*)d_in[i];
    a.out = (float*)d_out; a.ws = (unsigned char*)d_ws;
#ifndef MK_ONE_LAUNCH
    for (int s = 0; s < NSTEPS; ++s) { a.ph_lo = s; a.ph_hi = s + 1; hipLaunchKernelGGL(fwd, dim3(grid), dim3(NWAVES * 64), LDS_BYTES, stream, a); }
#else
    a.ph_lo = 0; a.ph_hi = NSTEPS; hipLaunchKernelGGL(fwd, dim3(grid), dim3(NWAVES * 64), LDS_BYTES, stream, a);
#endif
}
```

```cpp
#define MK_ONE_LAUNCH 1
#include <hip/hip_runtime.h>
#include <cstdio>
#include <cstdint>
#include <cmath>
namespace pg8 {
#define PG8_LAS __attribute__((address_space(3)))
typedef unsigned short bf16_t;
typedef short bf16x8 __attribute__((ext_vector_type(8)));
typedef float f32x4 __attribute__((ext_vector_type(4)));
typedef unsigned u32x4 __attribute__((ext_vector_type(4)));
constexpr int BM = 256, BK = 64, HALF = 128, HTB = HALF * BK * 2  , STAGE_BYTES = 8 * HTB, NXCD = 8, WGM = 8;

__host__ __device__ __forceinline__ int lds_byte(int r, int c) { const int st = (r >> 4) * 2 + (c >> 5), rr = r & 15, cc = c & 31, ob = rr * 64 + cc * 2; return st * 1024 + (ob ^ (((ob >> 9) & 1) << 5)); }
__host__ __device__ __forceinline__ void stage_rc(int b, int& R, int& C) { const int st = b / 1024, sb = b % 1024, swz = sb ^ (((sb >> 9) & 1) << 5); R = (st >> 1) * 16 + swz / 64; C = (st & 1) * 32 + (swz % 64) / 2; }
__host__ __device__ __forceinline__ int perm32(int rho) { const int n = rho >> 4, i = rho & 15; return 8 * (i >> 2) + 4 * n + (i & 3); }

struct Unit { int pm, pn, pa; };
struct Gemm { const bf16_t* A; const bf16_t* Bt; int M, N, K; int ldk; };

struct StaticOrder {
    int nM, nN, nwg, G, c;
    __host__ __device__ void init(int M, int N, int G_, int c_) { nM = M / BM; nN = N / BM; nwg = nM * nN; G = G_; c = c_; }
    __host__ __device__ bool next(int i, Unit& u) const {
        const long L = (long)i * G + c; if (L >= nwg) return false;
        int wgid = (int)L; { const int q = nwg / NXCD, r = nwg % NXCD, xcd = wgid % NXCD, off = wgid / NXCD; wgid = (xcd < r ? xcd * (q + 1) : r * (q + 1) + (xcd - r) * q) + off; }
        const int nig = WGM * nN, gid = wgid / nig, fm = gid * WGM, gsz = (nM - fm) < WGM ? (nM - fm) : WGM;
        u.pm = fm + ((wgid % nig) % gsz); u.pn = (wgid % nig) / gsz; u.pa = u.pm; return true;
    }
    __device__ __forceinline__ void a_ready(const Unit&) const {}
    __device__ __forceinline__ void done(const Unit&) const {}
};


__device__ __forceinline__ unsigned cvt_pk_bf16(float lo, float hi) { unsigned r; asm volatile("v_cvt_pk_bf16_f32 %0, %1, %2" : "=v"(r) : "v"(lo), "v"(hi)); return r; }

struct EpiU {
    static constexpr bool PERM = true, AFTER_DRAIN = false;
    bf16_t* O; int ldc; int nscale; float scale0, scale1;
    __device__ __forceinline__ void operator()(const f32x4 (&acc)[2][2][4][2], const Unit& u, int wr, int wc, int fr, int fq) const {
        const int row0 = u.pm * BM + wr * 64 + fr; const int col0 = u.pn * BM + wc * 32 + 8 * fq;
        const float sc = (u.pn < nscale) ? scale0 : scale1;
#pragma unroll
        for (int ai = 0; ai < 2; ++ai)
#pragma unroll
            for (int m = 0; m < 4; ++m) { bf16_t* rowp = O + (size_t)(row0 + ai * HALF + m * 16) * ldc + col0;
#pragma unroll
                for (int bj = 0; bj < 2; ++bj) { f32x4 v0 = acc[ai][bj][m][0] * sc, v1 = acc[ai][bj][m][1] * sc;
                    u32x4 w; w.x = cvt_pk_bf16(v0[0], v0[1]); w.y = cvt_pk_bf16(v0[2], v0[3]); w.z = cvt_pk_bf16(v1[0], v1[1]); w.w = cvt_pk_bf16(v1[2], v1[3]);
                    *(u32x4*)(rowp + bj * HALF) = w; } }
    }
};
__device__ __forceinline__ float silu_f(float x) { return x * __builtin_amdgcn_rcpf(1.f + __builtin_amdgcn_exp2f(-1.4426950408889634f * x)); }
struct EpiSwiGLU {
    static constexpr bool PERM = true, AFTER_DRAIN = false;
    bf16_t* O; int ldo; int nNl;
    __device__ __forceinline__ void operator()(const f32x4 (&acc)[2][2][4][2], const Unit& u, int wr, int wc, int fr, int fq) const {
        const int row0 = u.pm * BM + wr * 64 + fr; const int hc0 = (u.pn % nNl) * HALF + wc * 32 + 8 * fq;
#pragma unroll
        for (int ai = 0; ai < 2; ++ai)
#pragma unroll
            for (int m = 0; m < 4; ++m) { bf16_t* rowp = O + (size_t)(row0 + ai * HALF + m * 16) * ldo + hc0;
                const f32x4 g0 = acc[ai][0][m][0], g1 = acc[ai][0][m][1], u0 = acc[ai][1][m][0], u1 = acc[ai][1][m][1];
                u32x4 w; w.x = cvt_pk_bf16(silu_f(g0[0]) * u0[0], silu_f(g0[1]) * u0[1]); w.y = cvt_pk_bf16(silu_f(g0[2]) * u0[2], silu_f(g0[3]) * u0[3]);
                w.z = cvt_pk_bf16(silu_f(g1[0]) * u1[0], silu_f(g1[1]) * u1[1]); w.w = cvt_pk_bf16(silu_f(g1[2]) * u1[2], silu_f(g1[3]) * u1[3]);
                *(u32x4*)rowp = w; }
    }
};
__device__ __forceinline__ f32x4 swiglu4(const f32x4 g, const f32x4 u, const float s) {
    const f32x4 t = g * (-1.4426950408889634f * s);
    f32x4 e; e[0] = __builtin_amdgcn_exp2f(t[0]); e[1] = __builtin_amdgcn_exp2f(t[1]); e[2] = __builtin_amdgcn_exp2f(t[2]); e[3] = __builtin_amdgcn_exp2f(t[3]);
    const f32x4 d = e + 1.f;
    f32x4 r; r[0] = __builtin_amdgcn_rcpf(d[0]); r[1] = __builtin_amdgcn_rcpf(d[1]); r[2] = __builtin_amdgcn_rcpf(d[2]); r[3] = __builtin_amdgcn_rcpf(d[3]);
    return (g * u) * (r * (s * s));
}
struct EpiSwiGLU8 {
    static constexpr bool PERM = true, AFTER_DRAIN = false;
    unsigned char* O; int ldo; int nNl; float s;
    __device__ __forceinline__ void operator()(const f32x4 (&acc)[2][2][4][2], const Unit& u, int wr, int wc, int fr, int fq) const {
        const int row0 = u.pm * BM + wr * 64 + fr; const int hc0 = (u.pn % nNl) * HALF + wc * 32 + 8 * fq;
        typedef unsigned u32x2 __attribute__((ext_vector_type(2)));
#pragma unroll
        for (int ai = 0; ai < 2; ++ai)
#pragma unroll
            for (int m = 0; m < 4; ++m) { unsigned char* rowp = O + (size_t)(row0 + ai * HALF + m * 16) * ldo + hc0;
                const f32x4 h0 = swiglu4(acc[ai][0][m][0], acc[ai][1][m][0], s), h1 = swiglu4(acc[ai][0][m][1], acc[ai][1][m][1], s);
                int p0 = __builtin_amdgcn_cvt_pk_fp8_f32(h0[0], h0[1], 0, false); p0 = __builtin_amdgcn_cvt_pk_fp8_f32(h0[2], h0[3], p0, true);
                int p1 = __builtin_amdgcn_cvt_pk_fp8_f32(h1[0], h1[1], 0, false); p1 = __builtin_amdgcn_cvt_pk_fp8_f32(h1[2], h1[3], p1, true);
                u32x2 w; w.x = (unsigned)p0; w.y = (unsigned)p1; *(u32x2*)rowp = w; __builtin_amdgcn_sched_barrier(0); }
    }
};
struct EpiBf {
    static constexpr bool PERM = true, AFTER_DRAIN = false;
    bf16_t* O; int ldc; int nNl; float s;
    __device__ __forceinline__ void operator()(const f32x4 (&acc)[2][2][4][2], const Unit& u, int wr, int wc, int fr, int fq) const {
        const int row0 = u.pm * BM + wr * 64 + fr; const int col0 = (u.pn % nNl) * BM + wc * 32 + 8 * fq;
#pragma unroll
        for (int ai = 0; ai < 2; ++ai)
#pragma unroll
            for (int m = 0; m < 4; ++m) { bf16_t* rowp = O + (size_t)(row0 + ai * HALF + m * 16) * ldc + col0;
#pragma unroll
                for (int bj = 0; bj < 2; ++bj) { const f32x4 v0 = acc[ai][bj][m][0] * s, v1 = acc[ai][bj][m][1] * s;
                    u32x4 w; w.x = cvt_pk_bf16(v0[0], v0[1]); w.y = cvt_pk_bf16(v0[2], v0[3]); w.z = cvt_pk_bf16(v1[0], v1[1]); w.w = cvt_pk_bf16(v1[2], v1[3]);
                    *(u32x4*)(rowp + bj * HALF) = w; } }
    }
};
struct EpiF32 {
    static constexpr bool PERM = false, AFTER_DRAIN = false;
    float* O; int ldc; int nNl;
    __device__ __forceinline__ void operator()(const f32x4 (&acc)[2][2][4][2], const Unit& u, int wr, int wc, int fr, int fq) const {
        const int row0 = u.pm * BM + wr * 64 + fr; const int col0 = (u.pn % nNl) * BM + wc * 32 + 4 * fq;
#pragma unroll
        for (int ai = 0; ai < 2; ++ai)
#pragma unroll
            for (int m = 0; m < 4; ++m) { float* rowp = O + (size_t)(row0 + ai * HALF + m * 16) * ldc + col0;
#pragma unroll
                for (int bj = 0; bj < 2; ++bj)
#pragma unroll
                    for (int n = 0; n < 2; ++n) *(f32x4*)(rowp + bj * HALF + n * 16) = acc[ai][bj][m][n]; }
    }
};
struct EpiF32P {
    static constexpr bool PERM = true, AFTER_DRAIN = false;
    float* O; int ldc;
    __device__ __forceinline__ void operator()(const f32x4 (&acc)[2][2][4][2], const Unit& u, int wr, int wc, int fr, int fq) const {
        const int row0 = u.pm * BM + wr * 64 + fr; const int col0 = wc * 32 + 8 * fq;
#pragma unroll
        for (int ai = 0; ai < 2; ++ai)
#pragma unroll
            for (int m = 0; m < 4; ++m) { float* rowp = O + (size_t)(row0 + ai * HALF + m * 16) * ldc + col0;
#pragma unroll
                for (int bj = 0; bj < 2; ++bj) { *(f32x4*)(rowp + bj * HALF) = acc[ai][bj][m][0]; *(f32x4*)(rowp + bj * HALF + 4) = acc[ai][bj][m][1]; } }
    }
};
struct OneUnit {
    Unit u; int have;
    __device__ __forceinline__ bool next(int i, Unit& o) const { if (i != 0 || !have) return false; o = u; return true; }
    __device__ __forceinline__ void a_ready(const Unit&) const {}
    __device__ __forceinline__ void done(const Unit&) const {}
};
struct MoeOrder {
    StaticOrder so; int P1, P2, P3, P4, P5, P6, P7; int nNl, a_sparse;
    __device__ __forceinline__ void init_dense(int nM, int nNl_, int G, int c) { so.nM = nM; so.nN = nNl_; so.nwg = nM * nNl_; so.G = G; so.c = c; nNl = nNl_; a_sparse = 0; P1 = P2 = P3 = P4 = P5 = P6 = P7 = nM; }
    __device__ __forceinline__ void init_moe(const unsigned* cnt  , int nNl_, int G, int c, int a_sparse_) {
        int p = 0; p += ((int)cnt[0] + 255) >> 8; P1 = p; p += ((int)cnt[64] + 255) >> 8; P2 = p; p += ((int)cnt[128] + 255) >> 8; P3 = p; p += ((int)cnt[192] + 255) >> 8; P4 = p;
        p += ((int)cnt[256] + 255) >> 8; P5 = p; p += ((int)cnt[320] + 255) >> 8; P6 = p; p += ((int)cnt[384] + 255) >> 8; P7 = p; p += ((int)cnt[448] + 255) >> 8;
        so.nM = p; so.nN = nNl_; so.nwg = p * nNl_; so.G = G; so.c = c; nNl = nNl_; a_sparse = a_sparse_;
    }
    __device__ __forceinline__ bool next(int i, Unit& u) const {
        if (!so.next(i, u)) return false;
        int e = 0, pe = 0;
        if (u.pm >= P1) { e = 1; pe = P1; } if (u.pm >= P2) { e = 2; pe = P2; } if (u.pm >= P3) { e = 3; pe = P3; } if (u.pm >= P4) { e = 4; pe = P4; }
        if (u.pm >= P5) { e = 5; pe = P5; } if (u.pm >= P6) { e = 6; pe = P6; } if (u.pm >= P7) { e = 7; pe = P7; }
        u.pa = a_sparse ? e * 128 + (u.pm - pe) : u.pm; u.pn = e * nNl + u.pn; return true;
    }
    __device__ __forceinline__ void unit_of(int wgid, Unit& u) const {
        const int nig = WGM * so.nN, gid = wgid / nig, fm = gid * WGM, gsz = (so.nM - fm) < WGM ? (so.nM - fm) : WGM;
        u.pm = fm + ((wgid % nig) % gsz); u.pn = (wgid % nig) / gsz;
        int e = 0, pe = 0;
        if (u.pm >= P1) { e = 1; pe = P1; } if (u.pm >= P2) { e = 2; pe = P2; } if (u.pm >= P3) { e = 3; pe = P3; } if (u.pm >= P4) { e = 4; pe = P4; }
        if (u.pm >= P5) { e = 5; pe = P5; } if (u.pm >= P6) { e = 6; pe = P6; } if (u.pm >= P7) { e = 7; pe = P7; }
        u.pa = a_sparse ? e * 128 + (u.pm - pe) : u.pm; u.pn = e * nNl + u.pn;
    }
    __device__ __forceinline__ void a_ready(const Unit&) const {}
    __device__ __forceinline__ void done(const Unit&) const {}
};
template <class Epi, class Sched, bool ALIGN_EPI = false, bool SP2 = false, bool FP8 = false>
__device__ __forceinline__ void gemm_phase(PG8_LAS unsigned char* lds, const Gemm g, const Sched& S, const Epi& E, int tid_) {
    asm volatile("" : "+v"(tid_));
    const int tid = tid_, wid = __builtin_amdgcn_readfirstlane(tid >> 6), lane = tid & 63, wr = wid >> 2, wc = wid & 3, fr = lane & 15, fq = lane >> 4;
    int K_ = g.K; asm volatile("" : "+s"(K_));
    const int K = K_, nt = FP8 ? K / 128 : K / BK; const int RB = g.ldk ? g.ldk : (FP8 ? K : 2 * K);
    unsigned voffA[2], voffB[2];
#pragma unroll
    for (int i = 0; i < 2; ++i) { int R, C; stage_rc(tid * 16 + i * 8192, R, C); const int Rb = Epi::PERM ? ((R & ~31) + perm32(R & 31)) : R;
        voffA[i] = (unsigned)(R * RB + C * 2); voffB[i] = (unsigned)(Rb * RB + C * 2); }
    const size_t kstep = (size_t)(BK * 2);
    const size_t hstep = (size_t)HALF * RB;
    const size_t tstep = 2 * hstep;
    const unsigned ldsw = (unsigned)wid * 1024u;
    const int aoff = lds_byte(wr * 64 + fr, fq * 8), boff = lds_byte(wc * 32 + fr, fq * 8);
#define PG8_SA(b, h) (((b) * 2 + (h)) * HTB)
#define PG8_SB(b, h) ((4 + (b) * 2 + (h)) * HTB)
#define PG8_STAGE(bufoff, gbase, voff) do { _Pragma("unroll") for (int _i = 0; _i < 2; ++_i) \
        __builtin_amdgcn_global_load_lds((const unsigned*)((const char*)(gbase) + (voff)[_i]), (PG8_LAS unsigned*)(lds + (bufoff) + ldsw + _i * 8192), 16, 0, 0); } while (0)
#define PG8_LDA(dst, b, h) do { if constexpr (FP8) { _Pragma("unroll") for (int m = 0; m < 4; ++m) { dst##8[m].lo = *(const PG8_LAS v4i_t*)(lds + PG8_SA(b, h) + aoff + m * 2048); dst##8[m].hi = *(const PG8_LAS v4i_t*)(lds + PG8_SA(b, h) + aoff + m * 2048 + 1024); } } \
        else { _Pragma("unroll") for (int m = 0; m < 4; ++m) _Pragma("unroll") for (int k = 0; k < 2; ++k) dst[m][k] = *(const PG8_LAS bf16x8*)(lds + PG8_SA(b, h) + aoff + m * 2048 + k * 1024); } } while (0)
#define PG8_LDB(dst, b, h) do { if constexpr (FP8) { _Pragma("unroll") for (int n = 0; n < 2; ++n) { dst##8[n].lo = *(const PG8_LAS v4i_t*)(lds + PG8_SB(b, h) + boff + n * 2048); dst##8[n].hi = *(const PG8_LAS v4i_t*)(lds + PG8_SB(b, h) + boff + n * 2048 + 1024); } } \
        else { _Pragma("unroll") for (int n = 0; n < 2; ++n) _Pragma("unroll") for (int k = 0; k < 2; ++k) dst[n][k] = *(const PG8_LAS bf16x8*)(lds + PG8_SB(b, h) + boff + n * 2048 + k * 1024); } } while (0)
#define PG8_MMA(ai, bj, At, Bt) do { __builtin_amdgcn_s_setprio(1); \
        if constexpr (FP8) { _Pragma("unroll") for (int m = 0; m < 4; ++m) _Pragma("unroll") for (int n = 0; n < 2; ++n) \
            asm volatile("v_mfma_scale_f32_16x16x128_f8f6f4 %0, %1, %2, %0, %3, %3 op_sel_hi:[0,0,0]" : "+v"(acc[ai][bj][m][n]) : "v"(Bt##8[n]), "v"(At##8[m]), "v"(scl8)); } \
        else { _Pragma("unroll") for (int m = 0; m < 4; ++m) _Pragma("unroll") for (int n = 0; n < 2; ++n) _Pragma("unroll") for (int k = 0; k < 2; ++k) \
            acc[ai][bj][m][n] = __builtin_amdgcn_mfma_f32_16x16x32_bf16(Bt[n][k], At[m][k], acc[ai][bj][m][n], 0, 0, 0); } __builtin_amdgcn_s_setprio(0); } while (0)
#define PG8_WAIT_V(n) asm volatile("s_waitcnt vmcnt(" #n ")" ::: "memory")
#define PG8_WAIT_L(n) asm volatile("s_waitcnt lgkmcnt(" #n ")" ::: "memory")
#define PG8_BAR __builtin_amdgcn_s_barrier()
#define PG8_SCHED __builtin_amdgcn_sched_barrier(0)
    Unit cur, nxt; int ui = 0;
    if (!S.next(0, cur)) return;
    f32x4 acc[2][2][4][2];
#pragma unroll
    for (int a = 0; a < 2; ++a)
#pragma unroll
        for (int b = 0; b < 2; ++b)
#pragma unroll
            for (int m = 0; m < 4; ++m)
#pragma unroll
                for (int n = 0; n < 2; ++n) acc[a][b][m][n] = (f32x4){0.f, 0.f, 0.f, 0.f};
    typedef int v4i_t __attribute__((ext_vector_type(4))); typedef int v8i_t __attribute__((ext_vector_type(8)));
    int scl8 = 0x7F7F7F7F; asm volatile("" : "+v"(scl8));
    bf16x8 At[4][2], B0[2][2], B1[2][2]; v8i_t At8[4], B08[2], B18[2];
    const char* cA = (const char*)g.A + (size_t)cur.pa * tstep; const char* cB = (const char*)g.Bt + (size_t)cur.pn * tstep;
    S.a_ready(cur);
    if constexpr (SP2) {
        PG8_STAGE(PG8_SB(0, 0), cB, voffB); PG8_STAGE(PG8_SB(0, 1), cB + hstep, voffB); PG8_STAGE(PG8_SA(0, 0), cA, voffA); PG8_STAGE(PG8_SA(0, 1), cA + hstep, voffA);
        if (wr == 1) PG8_BAR;
        PG8_WAIT_V(2); PG8_BAR;
        PG8_STAGE(PG8_SB(1, 0), cB + kstep, voffB); PG8_STAGE(PG8_SA(1, 0), cA + kstep, voffA); PG8_STAGE(PG8_SB(1, 1), cB + hstep + kstep, voffB);
        PG8_WAIT_V(6); PG8_BAR;
    } else {
        PG8_STAGE(PG8_SB(0, 0), cB, voffB); PG8_STAGE(PG8_SA(0, 0), cA, voffA); PG8_STAGE(PG8_SB(0, 1), cB + hstep, voffB); PG8_STAGE(PG8_SA(0, 1), cA + hstep, voffA);
        if (wr == 1) PG8_BAR;
        PG8_WAIT_V(4); PG8_BAR;
        PG8_STAGE(PG8_SB(1, 0), cB + kstep, voffB); PG8_STAGE(PG8_SA(1, 0), cA + kstep, voffA); PG8_STAGE(PG8_SB(1, 1), cB + hstep + kstep, voffB);
        PG8_WAIT_V(6); PG8_BAR;
    }
    for (;;) {
        const bool has_next = S.next(ui + 1, nxt);
        const char* nA = has_next ? (const char*)g.A + (size_t)nxt.pa * tstep : cA; const char* nB = has_next ? (const char*)g.Bt + (size_t)nxt.pn * tstep : cB;
#pragma unroll 1
        for (int t = 0; t < nt; t += 2) {
            const bool last = (t == nt - 2);
            const char* a1 = cA + (size_t)(t + 1) * kstep;
            const char* a2 = last ? nA : cA + (size_t)(t + 2) * kstep; const char* b2 = last ? nB : cB + (size_t)(t + 2) * kstep;
            const char* a3 = a2 + kstep; const char* b3 = b2 + kstep;
            if (last && has_next) S.a_ready(nxt);
            if constexpr (SP2) {
            PG8_LDB(B0, 0, 0); PG8_LDB(B1, 0, 1); PG8_SCHED; PG8_LDA(At, 0, 0); PG8_STAGE(PG8_SA(1, 1), a1 + hstep, voffA);
            PG8_WAIT_V(8); PG8_WAIT_L(0); PG8_BAR; PG8_MMA(0, 0, At, B0); PG8_MMA(0, 1, At, B1); PG8_BAR; PG8_SCHED;
            PG8_LDA(At, 0, 1); PG8_STAGE(PG8_SB(0, 0), b2, voffB); PG8_STAGE(PG8_SB(0, 1), b2 + hstep, voffB); PG8_STAGE(PG8_SA(0, 0), a2, voffA);
            PG8_WAIT_V(8); PG8_WAIT_L(0); PG8_BAR; PG8_MMA(1, 0, At, B0); PG8_MMA(1, 1, At, B1); PG8_BAR; PG8_SCHED;
            PG8_LDB(B0, 1, 0); PG8_LDB(B1, 1, 1); PG8_SCHED; PG8_LDA(At, 1, 0); PG8_STAGE(PG8_SA(0, 1), a2 + hstep, voffA);
            PG8_WAIT_V(8); PG8_WAIT_L(0); PG8_BAR; PG8_MMA(0, 0, At, B0); PG8_MMA(0, 1, At, B1); PG8_BAR; PG8_SCHED;
            PG8_LDA(At, 1, 1); PG8_STAGE(PG8_SB(1, 0), b3, voffB); PG8_STAGE(PG8_SB(1, 1), b3 + hstep, voffB); PG8_STAGE(PG8_SA(1, 0), a3, voffA);
            PG8_WAIT_V(8); PG8_WAIT_L(0); PG8_BAR; PG8_MMA(1, 0, At, B0); PG8_MMA(1, 1, At, B1); PG8_BAR; PG8_SCHED;
            } else {
            PG8_LDB(B0, 0, 0); PG8_SCHED; PG8_LDA(At, 0, 0); PG8_STAGE(PG8_SA(1, 1), a1 + hstep, voffA);
            PG8_WAIT_L(8); PG8_BAR; PG8_WAIT_L(0); PG8_MMA(0, 0, At, B0); PG8_BAR; PG8_SCHED;
            PG8_LDB(B1, 0, 1); PG8_STAGE(PG8_SB(0, 0), b2, voffB);
            PG8_BAR; PG8_WAIT_L(0); PG8_MMA(0, 1, At, B1); PG8_BAR;
            PG8_LDA(At, 0, 1); PG8_STAGE(PG8_SA(0, 0), a2, voffA);
            PG8_BAR; PG8_WAIT_L(0); PG8_MMA(1, 0, At, B0); PG8_BAR; PG8_SCHED;
            PG8_STAGE(PG8_SB(0, 1), b2 + hstep, voffB);
            PG8_WAIT_V(6); PG8_BAR; PG8_MMA(1, 1, At, B1); PG8_BAR;
            PG8_LDB(B0, 1, 0); PG8_SCHED; PG8_LDA(At, 1, 0); PG8_STAGE(PG8_SA(0, 1), a2 + hstep, voffA);
            PG8_WAIT_L(8); PG8_BAR; PG8_WAIT_L(0); PG8_MMA(0, 0, At, B0); PG8_BAR; PG8_SCHED;
            PG8_LDB(B1, 1, 1); PG8_STAGE(PG8_SB(1, 0), b3, voffB);
            PG8_BAR; PG8_WAIT_L(0); PG8_MMA(0, 1, At, B1); PG8_BAR;
            PG8_LDA(At, 1, 1); PG8_STAGE(PG8_SA(1, 0), a3, voffA);
            PG8_BAR; PG8_WAIT_L(0); PG8_MMA(1, 0, At, B0); PG8_BAR; PG8_SCHED;
            PG8_STAGE(PG8_SB(1, 1), b3 + hstep, voffB);
            PG8_WAIT_V(6); PG8_BAR; PG8_MMA(1, 1, At, B1); PG8_BAR;
            }
        }
        if constexpr (ALIGN_EPI) { if (wr == 0) PG8_BAR; }
        if constexpr (FP8) asm volatile("s_nop 15\n\ts_nop 15" ::: "memory");
        if constexpr (!Epi::AFTER_DRAIN) { int fr_ = fr, fq_ = fq; asm volatile("" : "+v"(fr_), "+v"(fq_));
            E(acc, cur, wr, wc, fr_, fq_); S.done(cur); }
        if (!has_next) break;
#pragma unroll
        for (int a = 0; a < 2; ++a)
#pragma unroll
            for (int b = 0; b < 2; ++b)
#pragma unroll
                for (int m = 0; m < 4; ++m)
#pragma unroll
                    for (int n = 0; n < 2; ++n) acc[a][b][m][n] = (f32x4){0.f, 0.f, 0.f, 0.f};
        cur = nxt; cA = nA; cB = nB; ++ui;
        if constexpr (ALIGN_EPI) { if (wr == 1) PG8_BAR; }
    }
    PG8_WAIT_V(0);
    if constexpr (!ALIGN_EPI) { if (wr == 0) PG8_BAR; }
    PG8_BAR;
    if constexpr (Epi::AFTER_DRAIN) { E.fused(acc, cur, wr, wc, fr, fq, lds, wid, lane); S.done(cur); }
#undef PG8_SA
#undef PG8_SB
#undef PG8_STAGE
#undef PG8_LDA
#undef PG8_LDB
#undef PG8_MMA
#undef PG8_WAIT_V
#undef PG8_WAIT_L
#undef PG8_BAR
#undef PG8_SCHED
}
}
#define GAS __attribute__((address_space(1)))
#define LAS __attribute__((address_space(3)))
typedef unsigned short bf16;
typedef unsigned v4u __attribute__((ext_vector_type(4)));
typedef float f32x4 __attribute__((ext_vector_type(4)));
typedef short bf16x8 __attribute__((ext_vector_type(8)));
typedef GAS unsigned gu32;
typedef GAS unsigned long long gu64;
#define RLX_AGENT __ATOMIC_RELAXED, __HIP_MEMORY_SCOPE_AGENT
#define LDS_WAIT() asm volatile("s_waitcnt lgkmcnt(0)" ::: "memory")
#define VM_WAIT() asm volatile("s_waitcnt vmcnt(0)" ::: "memory")
__device__ __forceinline__ unsigned long long rt() { return __builtin_amdgcn_s_memrealtime(); }
__device__ __forceinline__ unsigned f2bf(float f) { unsigned u = __builtin_bit_cast(unsigned, f); return (u + 0x7fffu + ((u >> 16) & 1u)) >> 16; }
__device__ __forceinline__ unsigned pk2(float lo, float hi) { return f2bf(lo) | (f2bf(hi) << 16); }

#define XB_TMO      128
#define XB_XCNT(j)  (256  + 64 * (j))
#define XB_XSUB(j)  (1280 + 64 * (j))
#define XB_XGEN(j)  (2304 + 64 * (j))
#define XB_TOP      3328
#define XB_TOPGEN   3392
#define XCD_BAR_WORDS 3456
#define XB_SPIN_CAP (1u << 18)

__device__ __forceinline__ unsigned xb_ld(unsigned* p)              { return __hip_atomic_load(p, __ATOMIC_RELAXED, __HIP_MEMORY_SCOPE_AGENT); }
__device__ __forceinline__ unsigned xb_add(unsigned* p, unsigned v) { return __hip_atomic_fetch_add(p, v, __ATOMIC_RELAXED, __HIP_MEMORY_SCOPE_AGENT); }
__device__ __forceinline__ unsigned xb_xcc_id() { return (unsigned)__builtin_amdgcn_s_getreg((3 << 11) | 20) & 0xFu; }
#define XB_SPIN(cond, bar) do { unsigned _sp = 0; while (cond) { __builtin_amdgcn_s_sleep(1); \
    if ((++_sp & 255u) == 0u) { if (xb_ld(&(bar)[XB_TMO])) break; if (_sp > XB_SPIN_CAP) { atomicAdd(&(bar)[XB_TMO], 1u); break; } } } } while (0)

struct XcdBarrier {
    unsigned* bar; unsigned x;
    volatile LAS unsigned* st;
    int w0;
};
__device__ __forceinline__ bool xb_is_t0(const XcdBarrier& b) { return b.w0 == 0 && __builtin_amdgcn_mbcnt_hi(~0u, __builtin_amdgcn_mbcnt_lo(~0u, 0u)) == 0u; }

__device__ __forceinline__ XcdBarrier xcd_barrier_post(unsigned* bar, volatile LAS unsigned* st) {
    XcdBarrier b; b.bar = bar; b.x = xb_xcc_id(); b.st = st;
    if (threadIdx.x == 0) (void)xb_add(&bar[XB_XCNT(b.x)], 1u);
    return b;
}
__device__ __forceinline__ void xcd_barrier_complete(unsigned* bar, unsigned x, unsigned& nloc, unsigned& nx) {
    const unsigned G = gridDim.x * gridDim.y * gridDim.z;
    unsigned sum, cnt, mine, sp = 0u;
    for (;;) {
        sum = 0u; cnt = 0u; mine = 0u;
#pragma unroll
        for (unsigned j = 0; j < 16; ++j) { const unsigned c = xb_ld(&bar[XB_XCNT(j)]); sum += c; cnt += (c > 0u) ? 1u : 0u; mine = (j == x) ? c : mine; }
        if (sum == G) break;
        __builtin_amdgcn_s_sleep(1);
        if ((++sp & 255u) == 0u) { if (xb_ld(&bar[XB_TMO])) break; if (sp > XB_SPIN_CAP) { atomicAdd(&bar[XB_TMO], 1u); break; } }
    }
    nloc = mine > 0u ? mine : 1u; nx = cnt > 0u ? cnt : 1u;
}

__device__ __forceinline__ void xcd_barrier(const XcdBarrier& b) {
    asm volatile("s_waitcnt vmcnt(0)" ::: "memory");
    __syncthreads();
    if (xb_is_t0(b)) {
        unsigned* bar = b.bar;
        __builtin_amdgcn_s_waitcnt(0);
        unsigned nloc = b.st[0], nx = b.st[1];
        if (nloc == 0u) { xcd_barrier_complete(bar, b.x, nloc, nx); b.st[0] = nloc; b.st[1] = nx; }
        const unsigned old = xb_add(&bar[XB_XSUB(b.x)], 1u);
        const unsigned gen = old / nloc;
        if (old + 1u == (gen + 1u) * nloc) {
            __builtin_amdgcn_fence(__ATOMIC_RELEASE, "agent");
            asm volatile("s_waitcnt vmcnt(0)" ::: "memory");
            const unsigned og = xb_add(&bar[XB_TOP], 1u);
            const unsigned tg = og / nx;
            if (og + 1u == (tg + 1u) * nx) xb_add(&bar[XB_TOPGEN], 1u);
            else XB_SPIN(xb_ld(&bar[XB_TOPGEN]) == tg, bar);
            __builtin_amdgcn_fence(__ATOMIC_ACQUIRE, "agent");
            xb_add(&bar[XB_XGEN(b.x)], 1u);
            asm volatile("s_waitcnt vmcnt(0)" ::: "memory");
        } else {
            XB_SPIN(xb_ld(&bar[XB_XGEN(b.x)]) == gen, bar);
            __builtin_amdgcn_fence(__ATOMIC_ACQUIRE, "agent");
            asm volatile("s_waitcnt vmcnt(0)" ::: "memory");
        }
    }
    __syncthreads();
}

#ifndef DENSE_FP8
#define DENSE_FP8 2
#endif
#ifndef DENSE_UP8_LAYERS
#define DENSE_UP8_LAYERS 0x4
#endif
#ifndef INPROJ_FP8
#define INPROJ_FP8 1
#endif
constexpr int NWAVES = 8;
constexpr int BATCH = 16, T = 2048, D = 1024, M = BATCH * T, DEPTH = 4;
constexpr int NU = 2560;
constexpr int UQ = 0, UKC = 512, UVC = 640, UKS = 768, UVS = 896, UKW = 1024, UVW = 1152, UCA = 1280, UCG = 1792, UGL = 2304;
constexpr int D_IN = 2328;
constexpr int FF = 2816, FFE = 3584, NEXP = 8;
constexpr int NCMP = 127, NCP = 128;
constexpr float LN_EPS = 1e-5f;
constexpr float ALPHA = 1.6817928305074290f;
constexpr float LOG2E = 1.4426950408889634f;
constexpr float C2 = 0.125f * 1.4426950408889634f;
constexpr int ECAP = 32768;

constexpr size_t MiB = 1u << 20;
constexpr size_t WS_CTL = 0, CTL_ZERO_BYTES = 1 * MiB;
constexpr size_t WS_MOD = 1 * MiB;
constexpr size_t WS_TBL = 3 * MiB;
constexpr size_t WS_KCMP = 4 * MiB;
constexpr size_t WS_VCMP = 4 * MiB + 512 * 1024;
constexpr size_t WS_ROUTE = 5 * MiB;
constexpr size_t WS_WCMP = 6 * MiB;
constexpr size_t WS_WIN = 8 * MiB;
constexpr size_t WS_WO = 13 * MiB;
constexpr size_t WS_W1 = 16 * MiB;
constexpr size_t WS_W2 = 128 * MiB;
constexpr size_t WS_H = 184 * MiB;
constexpr size_t WS_CAT = 248 * MiB;
constexpr size_t WS_Y = 312 * MiB;
constexpr size_t WS_U = 440 * MiB;
constexpr size_t WS_Y2 = 312 * MiB;
constexpr size_t WS_HG = 600 * MiB;
constexpr size_t WS_HID = 1112 * MiB;
constexpr size_t WS_XB = 1574 * MiB;
constexpr size_t WS_END = 1638 * MiB;
static_assert(WS_Y2 + (size_t)(2 * M + 2048) * D * 4 <= WS_HG && WS_HID + (size_t)(2 * M + 2048) * FFE * 2 <= WS_END, "d_ws map");
constexpr int CW_TMO = 0, CW_CODE = 1;
constexpr int CW_BAR = 4096;
constexpr int CW_CNT = 16384;
constexpr int RING_OFF = 0, RING_BYTES = 131072;
constexpr int LDSCTL_OFF = RING_BYTES, MISC_OFF = LDSCTL_OFF + 320;
constexpr int LDS_BYTES = 147456;
constexpr bool dense_up8(int l) { return DENSE_FP8 == 1 || (DENSE_FP8 == 2 && ((DENSE_UP8_LAYERS >> l) & 1) != 0); }
struct Args { const float* in[21]; float* out; unsigned char* ws; int ph_lo, ph_hi; };

struct Frame {
    LAS unsigned char* lds;
    volatile LAS unsigned* MISC;
    gu32* ctl;
    int tid, lane, wave, G, wave0;

    float* X;
    unsigned char* ws;
};
enum { I_X = 0, I_C, I_WIN, I_CPOS, I_CW1, I_CW2, I_CVW, I_CVB, I_CVG, I_CVBE, I_WOUT, I_RB, I_ADAW, I_ADAB, I_LNG, I_LNB, I_FW1, I_FW2, I_RW, I_MW1, I_MW2 };

__device__ __forceinline__ float dpp_f(float v, const int ctrl_sel) {
    const int x = (int)__float_as_uint(v);
    return __uint_as_float((unsigned)(ctrl_sel == 0 ? __builtin_amdgcn_update_dpp(0, x, 0xB1, 0xF, 0xF, true) : ctrl_sel == 1 ? __builtin_amdgcn_update_dpp(0, x, 0x4E, 0xF, 0xF, true)
                                      : ctrl_sel == 2 ? __builtin_amdgcn_update_dpp(0, x, 0x141, 0xF, 0xF, true) : __builtin_amdgcn_update_dpp(0, x, 0x140, 0xF, 0xF, true)));
}
__device__ __forceinline__ float wave_sum(float v) {
    v += dpp_f(v, 0); v += dpp_f(v, 1); v += dpp_f(v, 2); v += dpp_f(v, 3);
    const int x = (int)__float_as_uint(v);
    const float a = __uint_as_float((unsigned)__builtin_amdgcn_readlane(x, 0)), b = __uint_as_float((unsigned)__builtin_amdgcn_readlane(x, 16));
    const float c = __uint_as_float((unsigned)__builtin_amdgcn_readlane(x, 32)), d = __uint_as_float((unsigned)__builtin_amdgcn_readlane(x, 48));
    return (a + b) + (c + d);
}
__device__ __forceinline__ float bf2f(unsigned short v) { return __uint_as_float((unsigned)v << 16); }
__device__ __forceinline__ float bflo(unsigned w) { return __uint_as_float(w << 16); }
__device__ __forceinline__ float bfhi(unsigned w) { return __uint_as_float(w & 0xffff0000u); }
__device__ __forceinline__ float sigmoid_f(float x) { return __builtin_amdgcn_rcpf(1.f + __builtin_amdgcn_exp2f(-1.4426950408889634f * x)); }

__device__ __forceinline__ void ph_ada(const Args& A, Frame& F) {
    LAS float* sc = (LAS float*)(F.lds);
    LAS float* red = (LAS float*)(F.lds + 65536);
    float* MOD = (float*)(F.ws + WS_MOD);
    for (int i = F.tid; i < BATCH * D; i += 512) { const float v = A.in[I_C][i]; sc[i] = v / (1.f + expf(-v)); }
    __syncthreads();
    const int c = F.tid & 63, ks = F.tid >> 6;
    for (int item = blockIdx.x; item < DEPTH * 96; item += gridDim.x) {
        const int l = item / 96, cb = item % 96, col = cb * 64 + c;
        const float* W = A.in[I_ADAW] + (size_t)l * D * 6 * D + col;
        float acc[16];
#pragma unroll
        for (int b = 0; b < 16; ++b) acc[b] = 0.f;
        for (int k0 = ks * 128; k0 < ks * 128 + 128; k0 += 32) { float wv[32];
#pragma unroll
            for (int kk = 0; kk < 32; ++kk) wv[kk] = __builtin_nontemporal_load(W + (size_t)(k0 + kk) * 6 * D);
            asm volatile("" ::: "memory");
#pragma unroll
            for (int b = 0; b < 16; ++b) { f32x4 s4[8];
#pragma unroll
                for (int q = 0; q < 8; ++q) s4[q] = *(const LAS f32x4*)(sc + b * D + k0 + 4 * q);
#pragma unroll
                for (int q = 0; q < 8; ++q) acc[b] += (s4[q].x * wv[4 * q] + s4[q].y * wv[4 * q + 1]) + (s4[q].z * wv[4 * q + 2] + s4[q].w * wv[4 * q + 3]); } }
#pragma unroll
        for (int b = 0; b < 16; ++b) red[(ks * 16 + b) * 64 + c] = acc[b];
        __syncthreads();
        for (int o = F.tid; o < 1024; o += 512) { const int b = o >> 6, cc = o & 63; float s = 0.f;
#pragma unroll
            for (int k2 = 0; k2 < 8; ++k2) s += red[(k2 * 16 + b) * 64 + cc];
            MOD[(size_t)(l * BATCH + b) * 6 * D + cb * 64 + cc] = s + A.in[I_ADAB][l * 6 * D + cb * 64 + cc]; }
        __syncthreads();
    }
}
__device__ __forceinline__ int rel_bucket_dev(int d) {
    if (d < 16) return d;
    int b = 16;
    b += (d >= 19); b += (d >= 21); b += (d >= 24); b += (d >= 27); b += (d >= 31); b += (d >= 35); b += (d >= 40); b += (d >= 46);
    b += (d >= 52); b += (d >= 59); b += (d >= 67); b += (d >= 77); b += (d >= 87); b += (d >= 99); b += (d >= 113);
    return b;
}
__device__ __forceinline__ void ph_tbl(const Args& A, Frame& F) {
    if (blockIdx.x != 0) return;
    float* TBL = (float*)(F.ws + WS_TBL);
    for (int i = F.tid; i < 2048; i += 512) { const int h = i >> 8, d = 191 - (i & 255); TBL[i] = d < 0 ? 0.f : A.in[I_RB][rel_bucket_dev(d) * 8 + h] * LOG2E; }
}
__device__ __forceinline__ int cvt_dest(int kind, int Fh, int n) {
    if (kind == 0) return n;
    if (kind == 1) return n < 1280 ? n : (n < 1304 ? n + 1024 : n - 24);
    return n < Fh ? ((n >> 7) << 8) + (n & 127) : (((n - Fh) >> 7) << 8) + 128 + ((n - Fh) & 127);
}
struct CvtItem { const float* W; bf16* WT; int K, N, kind, Fh, item; };
__device__ __forceinline__ void cvt_load(const CvtItem& c, float (&t)[32], int lane) {
    if (c.kind < 0 || c.kind == 3) return;
    const int nblk = (c.N + 31) >> 5, kb = c.item / nblk, nb = c.item % nblk, k0 = 64 * kb, n0 = 32 * nb;
    const int nn = n0 + (lane & 31);
    const float* wp = c.W + (size_t)(k0 + (lane >> 5)) * c.N + (nn < c.N ? nn : 0);
#pragma unroll
    for (int i = 0; i < 32; ++i) t[i] = __builtin_nontemporal_load(wp + (size_t)(2 * i) * c.N);
}
__device__ __forceinline__ void cvt_store(const CvtItem& c, const float (&t)[32], LAS float* scr, int lane) {
    if (c.kind < 0) return;
    if (c.kind == 3) { unsigned zz = 0u; asm volatile("" : "+v"(zz)); v4u z = {zz, zz, zz, zz}; *(GAS v4u*)(c.WT + ((size_t)c.item * 64 + lane) * 8) = z; return; }
    const int nblk = (c.N + 31) >> 5, kb = c.item / nblk, nb = c.item % nblk, k0 = 64 * kb, n0 = 32 * nb;
    const int nn = n0 + (lane & 31);
#pragma unroll
    for (int i = 0; i < 32; ++i) scr[(2 * i + (lane >> 5)) * 33 + (lane & 31)] = (nn < c.N) ? t[i] : 0.f;
    LDS_WAIT(); asm volatile("" ::: "memory");
    if (INPROJ_FP8 && c.kind == 1) {
        const int c4 = lane & 3;
#pragma unroll
        for (int j = 0; j < 2; ++j) { const int nl = (lane >> 2) + 16 * j; const int n = n0 + nl; const LAS float* s = scr + (16 * c4) * 33 + nl;
            int p0 = __builtin_amdgcn_cvt_pk_fp8_f32(s[0 * 33] * 32.f, s[1 * 33] * 32.f, 0, false); p0 = __builtin_amdgcn_cvt_pk_fp8_f32(s[2 * 33] * 32.f, s[3 * 33] * 32.f, p0, true);
            int p1 = __builtin_amdgcn_cvt_pk_fp8_f32(s[4 * 33] * 32.f, s[5 * 33] * 32.f, 0, false); p1 = __builtin_amdgcn_cvt_pk_fp8_f32(s[6 * 33] * 32.f, s[7 * 33] * 32.f, p1, true);
            int p2 = __builtin_amdgcn_cvt_pk_fp8_f32(s[8 * 33] * 32.f, s[9 * 33] * 32.f, 0, false); p2 = __builtin_amdgcn_cvt_pk_fp8_f32(s[10 * 33] * 32.f, s[11 * 33] * 32.f, p2, true);
            int p3 = __builtin_amdgcn_cvt_pk_fp8_f32(s[12 * 33] * 32.f, s[13 * 33] * 32.f, 0, false); p3 = __builtin_amdgcn_cvt_pk_fp8_f32(s[14 * 33] * 32.f, s[15 * 33] * 32.f, p3, true);
            v4u o; o.x = (unsigned)p0; o.y = (unsigned)p1; o.z = (unsigned)p2; o.w = (unsigned)p3;
            if (n < c.N) *(GAS v4u*)((unsigned char*)c.WT + (size_t)cvt_dest(c.kind, c.Fh, n) * c.K + k0 + 16 * c4) = o; }
        LDS_WAIT(); asm volatile("" ::: "memory");
        return;
    }
    const int cc = lane & 7;
#pragma unroll
    for (int j = 0; j < 4; ++j) { const int nl = (lane >> 3) + 8 * j; const int n = n0 + nl; const LAS float* s = scr + (8 * cc) * 33 + nl;
        v4u o; o.x = pk2(s[0 * 33], s[1 * 33]); o.y = pk2(s[2 * 33], s[3 * 33]); o.z = pk2(s[4 * 33], s[5 * 33]); o.w = pk2(s[6 * 33], s[7 * 33]);
        if (n < c.N) *(GAS v4u*)(c.WT + (size_t)cvt_dest(c.kind, c.Fh, n) * c.K + k0 + 8 * cc) = o; }
    LDS_WAIT(); asm volatile("" ::: "memory");
}
__device__ __forceinline__ CvtItem cvt_decode(const Args& A, Frame& F, int l, int it, int NIT) {
    bf16* WIN = (bf16*)(F.ws + WS_WIN);
    const int I_A = 16 * 73, I_C = 2 * 64;
    CvtItem c; c.W = nullptr; c.WT = nullptr; c.K = 0; c.N = 0; c.kind = -1; c.Fh = 0; c.item = 0;
    if (it >= NIT) return c;
    int r = it;
    if (r < I_A) { c.W = A.in[I_WIN] + (size_t)l * D * D_IN; c.K = D; c.N = D_IN; c.WT = WIN; c.kind = 1; c.item = r; return c; } r -= I_A;
    if (r < I_C) { const int kv = r >> 6; c.W = A.in[I_CW1] + (size_t)(l * 2 + kv) * 2048 * 64; c.K = 2048; c.N = 64; c.WT = (bf16*)(F.ws + WS_WCMP) + (size_t)kv * 64 * 2048; c.kind = 0; c.item = r & 63; return c; } r -= I_C;
    c.kind = 3; c.WT = INPROJ_FP8 ? (bf16*)((unsigned char*)WIN + (size_t)D_IN * D) : WIN + (size_t)D_IN * D; c.item = r; return c;
}
struct CvtBig { const float* W; bf16* WT; int K, N, kind, Fh, kt, nt; float q8; };
__device__ __forceinline__ CvtBig cvtbig_decode(const Args& A, Frame& F, int l, int it, int NIT) {
    bf16* WO = (bf16*)(F.ws + WS_WO); bf16* W1 = (bf16*)(F.ws + WS_W1); bf16* W2 = (bf16*)(F.ws + WS_W2);
    const bool moe = (l & 1) != 0; const int l2 = l >> 1;
    CvtBig c; c.W = nullptr; c.WT = nullptr; c.K = 0; c.N = 0; c.kind = -1; c.Fh = 0; c.kt = 0; c.nt = 0; c.q8 = 0.f;
    if (it >= NIT) return c;
    int r = it;
    if (moe) {
        if (r < 8 * 8 * 28) { const int e = r / (8 * 28), q = r % (8 * 28); c.W = A.in[I_MW1] + (size_t)(l2 * 8 + e) * D * 2 * FFE; c.K = D; c.N = 2 * FFE; c.WT = (bf16*)((unsigned char*)W1 + (size_t)e * 2 * FFE * D); c.kind = 2; c.Fh = FFE; c.kt = q / 28; c.nt = q % 28; c.q8 = 32.f; return c; } r -= 8 * 8 * 28;
        if (r < 8 * 28 * 4) { const int e = r / (28 * 4), q = r % (28 * 4); c.W = A.in[I_MW2] + (size_t)(l2 * 8 + e) * FFE * D; c.K = FFE; c.N = D; c.WT = (bf16*)((unsigned char*)W2 + (size_t)e * D * FFE); c.kind = 0; c.kt = q / 4; c.nt = q % 4; c.q8 = 128.f; return c; } r -= 8 * 28 * 4;
    } else {
        if (r < 8 * 22) { c.W = A.in[I_FW1] + (size_t)l2 * D * 2 * FF; c.K = D; c.N = 2 * FF; c.WT = W1; c.kind = 2; c.Fh = FF; c.kt = r / 22; c.nt = r % 22; c.q8 = dense_up8(l) ? 32.f : 0.f; return c; } r -= 8 * 22;
        if (r < 22 * 4) { c.W = A.in[I_FW2] + (size_t)l2 * FF * D; c.K = FF; c.N = D; c.WT = W2; c.kind = 0; c.kt = r / 4; c.nt = r % 4; c.q8 = DENSE_FP8 ? 128.f : 0.f; return c; } r -= 22 * 4;
    }
    c.W = A.in[I_WOUT] + (size_t)l * D * D; c.K = D; c.N = D; c.WT = WO; c.kind = 0; c.kt = r / 4; c.nt = r % 4; return c;
}
__device__ __forceinline__ void cvtbig_load(const CvtBig& c, float (&t)[64], int wave, int lane) {
    if (c.kind < 0) return;
    const float* wp = c.W + (size_t)(128 * c.kt + 16 * wave) * c.N + 256 * c.nt + lane;
#pragma unroll
    for (int i = 0; i < 16; ++i)
#pragma unroll
        for (int g = 0; g < 4; ++g) t[4 * i + g] = __builtin_nontemporal_load(wp + (size_t)i * c.N + 64 * g);
}
__device__ __forceinline__ void cvtbig_store(const CvtBig& c, const float (&t)[64], LAS unsigned* T, int wave, int lane) {
    if (c.kind >= 0 && c.q8 == 0.f) {
#pragma unroll
        for (int i = 0; i < 8; ++i)
#pragma unroll
            for (int g = 0; g < 4; ++g) T[(64 * g + lane) * 65 + 8 * wave + i] = pk2(t[4 * (2 * i) + g], t[4 * (2 * i + 1) + g]);
    }
    if (c.kind >= 0 && c.q8 != 0.f) {
#pragma unroll
        for (int i = 0; i < 4; ++i)
#pragma unroll
            for (int g = 0; g < 4; ++g) { int pq = __builtin_amdgcn_cvt_pk_fp8_f32(t[4 * (4 * i) + g] * c.q8, t[4 * (4 * i + 1) + g] * c.q8, 0, false); pq = __builtin_amdgcn_cvt_pk_fp8_f32(t[4 * (4 * i + 2) + g] * c.q8, t[4 * (4 * i + 3) + g] * c.q8, pq, true);
                T[(64 * g + lane) * 33 + 4 * wave + i] = (unsigned)pq; }
    }
    __syncthreads();
    if (c.kind >= 0 && c.q8 == 0.f) {
        const int cc = lane & 15;
#pragma unroll
        for (int j = 0; j < 8; ++j) { const int nl = 32 * wave + 4 * j + (lane >> 4); const LAS unsigned* sp = T + nl * 65 + 4 * cc;
            v4u o; o.x = sp[0]; o.y = sp[1]; o.z = sp[2]; o.w = sp[3];
            *(GAS v4u*)(c.WT + (size_t)cvt_dest(c.kind, c.Fh, 256 * c.nt + nl) * c.K + 128 * c.kt + 8 * cc) = o; }
    }
    if (c.kind >= 0 && c.q8 != 0.f) {
        const int cc = lane & 7;
#pragma unroll
        for (int j = 0; j < 4; ++j) { const int nl = 32 * wave + 8 * j + (lane >> 3); const LAS unsigned* sp = T + nl * 33 + 4 * cc;
            v4u o; o.x = sp[0]; o.y = sp[1]; o.z = sp[2]; o.w = sp[3];
            *(GAS v4u*)((unsigned char*)c.WT + (size_t)cvt_dest(c.kind, c.Fh, 256 * c.nt + nl) * c.K + 128 * c.kt + 16 * cc) = o; }
    }
    __syncthreads();
}
__device__ __forceinline__ void ph_cvt(const Args& A, Frame& F, int l) {
    const bool moe = (l & 1) != 0;
    {
      LAS unsigned* T = (LAS unsigned*)F.lds;
      const int NB = (moe ? 8 * 8 * 28 + 8 * 28 * 4 : 8 * 22 + 22 * 4) + 8 * 4;
      const int G = gridDim.x;
      float ta[64], tb[64];
      CvtBig ca = cvtbig_decode(A, F, l, blockIdx.x, NB), cb;
      cvtbig_load(ca, ta, F.wave, F.lane);
      for (int it = blockIdx.x; it < NB; it += 2 * G) {
          cb = cvtbig_decode(A, F, l, it + G, NB); cvtbig_load(cb, tb, F.wave, F.lane);
          asm volatile("" ::: "memory");
          cvtbig_store(ca, ta, T, F.wave, F.lane);
          ca = cvtbig_decode(A, F, l, it + 2 * G, NB); cvtbig_load(ca, ta, F.wave, F.lane);
          asm volatile("" ::: "memory");
          cvtbig_store(cb, tb, T, F.wave, F.lane);
      }
      __syncthreads(); }
    LAS float* scr = (LAS float*)(F.lds + F.wave * 16384);
    const int gw = blockIdx.x * NWAVES + F.wave, NGW = gridDim.x * NWAVES;
    const int NIT = 16 * 73 + 2 * 64 + 464;
    { float ta[32], tb[32];
      CvtItem ca = cvt_decode(A, F, l, gw, NIT), cb;
      cvt_load(ca, ta, F.lane);
      for (int it = gw; it < NIT; it += 2 * NGW) {
          cb = cvt_decode(A, F, l, it + NGW, NIT); cvt_load(cb, tb, F.lane);
          asm volatile("" ::: "memory");
          cvt_store(ca, ta, scr, F.lane);
          ca = cvt_decode(A, F, l, it + 2 * NGW, NIT); cvt_load(ca, ta, F.lane);
          asm volatile("" ::: "memory");
          cvt_store(cb, tb, scr, F.lane);
      } }
    if ((int)blockIdx.x >= (int)gridDim.x - 16) {
        __syncthreads();
        const int part16 = (int)gridDim.x - 1 - (int)blockIdx.x;
        LAS float* red = (LAS float*)F.lds;
        const int kv = F.tid >> 8, j = F.tid & 63, part = (F.tid >> 6) & 3;
        const float* w1 = A.in[I_CW1] + (size_t)(l * 2 + kv) * 2048 * 64 + (size_t)(128 * part16 + 32 * part) * 64 + j; const float* pos = A.in[I_CPOS] + (size_t)(l * 2 + kv) * 2048 + 128 * part16 + 32 * part;
        float wv[32], pv[32];
#pragma unroll
        for (int kk = 0; kk < 32; ++kk) { wv[kk] = w1[(size_t)kk * 64]; pv[kk] = pos[kk]; }
        asm volatile("" ::: "memory");
        float sacc = 0.f;
#pragma unroll
        for (int kk = 0; kk < 32; ++kk) sacc += pv[kk] * wv[kk];
        red[part * 128 + kv * 64 + j] = sacc;
        __syncthreads();
        if (F.tid < 128) ((float*)(F.ws + WS_WCMP + 512 * 1024))[part16 * 128 + F.tid] = (red[F.tid] + red[128 + F.tid]) + (red[256 + F.tid] + red[384 + F.tid]);
        __syncthreads();
    }
}
__device__ __forceinline__ void ph_mod0(const Args& A, Frame& F) {
    const int gw = blockIdx.x * NWAVES + F.wave, NGW = gridDim.x * NWAVES;
    const float* MOD = (const float*)(F.ws + WS_MOD); bf16* H = (bf16*)(F.ws + WS_H);
    for (int grp = gw; grp < M / 16; grp += NGW) { const int b = grp >> 7; const float* mod = MOD + (size_t)b * 6 * D;
        f32x4 shq[4], sclq[4];
#pragma unroll
        for (int j = 0; j < 4; ++j) { shq[j] = *((const f32x4*)mod + F.lane + 64 * j); sclq[j] = *((const f32x4*)(mod + D) + F.lane + 64 * j); }
#pragma unroll 1
        for (int m0 = grp * 16; m0 < grp * 16 + 16; m0 += 4) { f32x4 xv[4][4];
#pragma unroll
            for (int u = 0; u < 4; ++u)
#pragma unroll
                for (int j = 0; j < 4; ++j) xv[u][j] = __builtin_nontemporal_load((const f32x4*)(A.in[I_X] + (size_t)(m0 + u) * D) + F.lane + 64 * j);
            asm volatile("" ::: "memory");
#pragma unroll
            for (int u = 0; u < 4; ++u) { const int m = m0 + u;
#pragma unroll
                for (int j = 0; j < 4; ++j) { const f32x4 h = xv[u][j] * (1.f + sclq[j]) + shq[j];
                    if (INPROJ_FP8) { int pq = __builtin_amdgcn_cvt_pk_fp8_f32(h.x, h.y, 0, false); pq = __builtin_amdgcn_cvt_pk_fp8_f32(h.z, h.w, pq, true); *((unsigned*)((unsigned char*)H + (size_t)m * D) + F.lane + 64 * j) = (unsigned)pq; }
                    else *((unsigned long long*)(H + (size_t)m * D) + F.lane + 64 * j) = (unsigned long long)pk2(h.x, h.y) | ((unsigned long long)pk2(h.z, h.w) << 32); } } }
    }
}
__device__ __forceinline__ f32x4 bf4(unsigned long long w) { f32x4 r; r.x = bflo((unsigned)w); r.y = bfhi((unsigned)w); r.z = bflo((unsigned)(w >> 32)); r.w = bfhi((unsigned)(w >> 32)); return r; }
typedef _Float16 h4v_t __attribute__((ext_vector_type(4)));
__device__ __forceinline__ unsigned long long pack_h4(const f32x4 v) { h4v_t h; h[0] = (_Float16)v.x; h[1] = (_Float16)v.y; h[2] = (_Float16)v.z; h[3] = (_Float16)v.w; return __builtin_bit_cast(unsigned long long, h); }
__device__ __forceinline__ f32x4 h4f(unsigned long long w) { const h4v_t h = __builtin_bit_cast(h4v_t, w); f32x4 r; r.x = (float)h[0]; r.y = (float)h[1]; r.z = (float)h[2]; r.w = (float)h[3]; return r; }
__device__ __forceinline__ void ph_ln1(const Args& A, Frame& F, int l) {
    const int gw = blockIdx.x * NWAVES + F.wave, NGW = gridDim.x * NWAVES;
    const float* MODL = (const float*)(F.ws + WS_MOD) + (size_t)l * BATCH * 6 * D; bf16* H = (bf16*)(F.ws + WS_H); bf16* HG = (bf16*)(F.ws + WS_HG);
    const bf16* Y = (const bf16*)(F.ws + WS_Y); const float* xin = A.in[I_X]; bf16* XB = (bf16*)(F.ws + WS_XB);
    const float* lg = A.in[I_LNG] + (size_t)(l * 2 + 0) * D; const float* lb = A.in[I_LNB] + (size_t)(l * 2 + 0) * D;
    const bool moe = (l & 1) != 0; const float* RW = A.in[I_RW] + (size_t)(l >> 1) * D * 8;
    unsigned* ROUTE = (unsigned*)(F.ws + WS_ROUTE); unsigned* cnt = (unsigned*)(F.ctl + CW_CNT) + (l >> 1) * 8 * 64;
    LAS unsigned* cntL = (LAS unsigned*)F.lds;
    LAS float* RWL = (LAS float*)(F.lds + 256);
    if (F.tid < 16) cntL[F.tid] = 0u;
    if (moe) { f32x4 t[4];
#pragma unroll
        for (int i = 0; i < 4; ++i) t[i] = ((const f32x4*)RW)[F.tid + 512 * i];
        asm volatile("" ::: "memory");
#pragma unroll
        for (int i = 0; i < 4; ++i) ((LAS f32x4*)RWL)[F.tid + 512 * i] = t[i]; }
    f32x4 lgv[4], lbv[4];
#pragma unroll
    for (int j = 0; j < 4; ++j) { lgv[j] = *((const f32x4*)lg + F.lane + 64 * j); lbv[j] = *((const f32x4*)lb + F.lane + 64 * j); }
    __syncthreads();
    int bcur = -1; f32x4 g1v[4], shq[4], sclq[4];
    for (int grp = gw; grp < M / 16; grp += NGW) {
      { const int b = grp >> 7;
        if (b != bcur) { bcur = b; const float* mod = MODL + (size_t)b * 6 * D;
#pragma unroll
            for (int j = 0; j < 4; ++j) { const int q4 = F.lane + 64 * j; g1v[j] = *((const f32x4*)(mod + 2 * D) + q4); shq[j] = *((const f32x4*)(mod + 3 * D) + q4); sclq[j] = *((const f32x4*)(mod + 4 * D) + q4); } } }
      f32x4 xv[2][4]; unsigned long long xw[2][4], yw[2][4];
#define LN1_LOAD(M0) do { _Pragma("unroll") for (int u = 0; u < 2; ++u) { const int m_ = (M0) + u; _Pragma("unroll") for (int j = 0; j < 4; ++j) { const int q4 = F.lane + 64 * j; \
          if (l == 0) xv[u][j] = __builtin_nontemporal_load((const f32x4*)(xin + (size_t)m_ * D) + q4); else xw[u][j] = __builtin_nontemporal_load((const unsigned long long*)(XB + (size_t)m_ * D) + q4); \
          yw[u][j] = __builtin_nontemporal_load((const unsigned long long*)(Y + (size_t)m_ * D) + q4); } } } while (0)
      LN1_LOAD(grp * 16);
#pragma unroll 1
      for (int m0 = grp * 16; m0 < grp * 16 + 16; m0 += 2) {
        f32x4 v[2][4]; float s[2] = {0.f, 0.f};
        asm volatile("" ::: "memory");
#pragma unroll
        for (int u = 0; u < 2; ++u)
#pragma unroll
            for (int j = 0; j < 4; ++j) { const f32x4 xval = (l == 0) ? xv[u][j] : h4f(xw[u][j]); v[u][j] = ALPHA * xval + (1.f + g1v[j]) * bf4(yw[u][j]); s[u] += (v[u][j].x + v[u][j].y) + (v[u][j].z + v[u][j].w); }
        if (m0 + 2 < grp * 16 + 16) LN1_LOAD(m0 + 2);
        asm volatile("" ::: "memory");
        float mean[2], s2[2] = {0.f, 0.f}, rstd[2];
#pragma unroll
        for (int u = 0; u < 2; ++u) mean[u] = wave_sum(s[u]) * (1.f / D);
#pragma unroll
        for (int u = 0; u < 2; ++u)
#pragma unroll
            for (int j = 0; j < 4; ++j) { v[u][j] = v[u][j] - mean[u]; s2[u] += (v[u][j].x * v[u][j].x + v[u][j].y * v[u][j].y) + (v[u][j].z * v[u][j].z + v[u][j].w * v[u][j].w); }
#pragma unroll
        for (int u = 0; u < 2; ++u) rstd[u] = 1.f / sqrtf(wave_sum(s2[u]) * (1.f / D) + LN_EPS);
#pragma unroll
        for (int u = 0; u < 2; ++u) { const int m = m0 + u;
            float lgt[8];
#pragma unroll
            for (int e = 0; e < 8; ++e) lgt[e] = 0.f;
#pragma unroll
            for (int j = 0; j < 4; ++j) { const int q4 = F.lane + 64 * j;
                const f32x4 xn = v[u][j] * rstd[u] * lgv[j] + lbv[j]; *((unsigned long long*)(XB + (size_t)m * D) + q4) = pack_h4(xn);
                const f32x4 h = xn * (1.f + sclq[j]) + shq[j];
                if (!moe && !dense_up8(l)) *((unsigned long long*)(H + (size_t)m * D) + q4) = (unsigned long long)pk2(h.x, h.y) | ((unsigned long long)pk2(h.z, h.w) << 32);
                else { int pq = __builtin_amdgcn_cvt_pk_fp8_f32(h.x, h.y, 0, false); pq = __builtin_amdgcn_cvt_pk_fp8_f32(h.z, h.w, pq, true); *((unsigned*)((unsigned char*)H + (size_t)m * D) + q4) = (unsigned)pq; }
                if (moe) {
#pragma unroll
                    for (int k = 0; k < 4; ++k) { const f32x4 r0 = *(const LAS f32x4*)(RWL + (4 * q4 + k) * 8), r1 = *(const LAS f32x4*)(RWL + (4 * q4 + k) * 8 + 4); const float hv = h[k];
                        lgt[0] += hv * r0.x; lgt[1] += hv * r0.y; lgt[2] += hv * r0.z; lgt[3] += hv * r0.w; lgt[4] += hv * r1.x; lgt[5] += hv * r1.y; lgt[6] += hv * r1.z; lgt[7] += hv * r1.w; } }
            }
            if (moe) {
#pragma unroll
                for (int e = 0; e < 8; ++e) lgt[e] = wave_sum(lgt[e]);
                int e1 = 0; float v1 = lgt[0];
#pragma unroll
                for (int e = 1; e < 8; ++e) if (lgt[e] > v1) { v1 = lgt[e]; e1 = e; }
                int e2 = -1; float v2 = 0.f;
#pragma unroll
                for (int e = 0; e < 8; ++e) if (e != e1 && (e2 < 0 || lgt[e] > v2)) { v2 = lgt[e]; e2 = e; }
                const float w2 = 1.f / (1.f + expf(v1 - v2)), w1 = 1.f - w2;
                if (F.lane == 0) { const unsigned p1 = atomicAdd((unsigned*)(cntL + e1), 1u), p2 = atomicAdd((unsigned*)(cntL + e2), 1u);
                    v4u r; r.x = (unsigned)e1; r.y = p1; r.z = (unsigned)e2; r.w = p2; *(v4u*)(ROUTE + (size_t)m * 8) = r; ROUTE[(size_t)m * 8 + 4] = __float_as_uint(w1); ROUTE[(size_t)m * 8 + 5] = __float_as_uint(w2); }
            }
        }
      }
#undef LN1_LOAD
    }
    if (moe) {
        asm volatile("s_waitcnt vmcnt(0) lgkmcnt(0)" ::: "memory"); __syncthreads();
        if (F.tid < 8) cntL[8 + F.tid] = atomicAdd(cnt + F.tid * 64, cntL[F.tid]);
        __syncthreads();
        for (int grp = gw; grp < M / 16; grp += NGW)
#pragma unroll 1
        for (int m0 = grp * 16; m0 < grp * 16 + 16; m0 += 2) {
            v4u r[2]; unsigned hv[2][4];
#pragma unroll
            for (int u = 0; u < 2; ++u) { const int m = m0 + u; r[u] = *(const v4u*)(ROUTE + (size_t)m * 8);
#pragma unroll
                for (int j = 0; j < 4; ++j) hv[u][j] = *((const unsigned*)((const unsigned char*)H + (size_t)m * D) + F.lane + 64 * j); }
#pragma unroll
            for (int u = 0; u < 2; ++u) { const int m = m0 + u;
                r[u].y += cntL[8 + r[u].x]; r[u].w += cntL[8 + r[u].z];
                if (F.lane == 0) { ROUTE[(size_t)m * 8 + 1] = r[u].y; ROUTE[(size_t)m * 8 + 3] = r[u].w; }
                unsigned char* d1 = (unsigned char*)HG + ((size_t)r[u].x * ECAP + r[u].y) * D; unsigned char* d2 = (unsigned char*)HG + ((size_t)r[u].z * ECAP + r[u].w) * D;
#pragma unroll
                for (int j = 0; j < 4; ++j) { *((unsigned*)d1 + F.lane + 64 * j) = hv[u][j]; *((unsigned*)d2 + F.lane + 64 * j) = hv[u][j]; } }
        }
    }
}
__device__ __forceinline__ void ph_ln2(const Args& A, Frame& F, int l) {
    const int gw = blockIdx.x * NWAVES + F.wave, NGW = gridDim.x * NWAVES;
    const float* MODL = (const float*)(F.ws + WS_MOD) + (size_t)l * BATCH * 6 * D; bf16* H = (bf16*)(F.ws + WS_H);
    const bf16* Y = (const bf16*)(F.ws + WS_Y); const bf16* Y2 = (const bf16*)(F.ws + WS_Y2); bf16* XB = (bf16*)(F.ws + WS_XB);
    const float* lg = A.in[I_LNG] + (size_t)(l * 2 + 1) * D; const float* lb = A.in[I_LNB] + (size_t)(l * 2 + 1) * D;
    const bool moe = (l & 1) != 0;
    const unsigned* ROUTE = (const unsigned*)(F.ws + WS_ROUTE); const unsigned* cnt = (const unsigned*)(F.ctl + CW_CNT) + (l >> 1) * 8 * 64;
    int P[8];
    { int p = 0;
#pragma unroll
      for (int e = 0; e < 8; ++e) { P[e] = p; p += moe ? ((__builtin_amdgcn_readfirstlane((int)cnt[e * 64]) + 255) >> 8) : 0; } }
    f32x4 lgv[4], lbv[4];
#pragma unroll
    for (int j = 0; j < 4; ++j) { lgv[j] = *((const f32x4*)lg + F.lane + 64 * j); lbv[j] = *((const f32x4*)lb + F.lane + 64 * j); }
    int bcur = -1; f32x4 g2v[4], shq[4], sclq[4];
    for (int grp = gw; grp < M / 16; grp += NGW) {
      { const int b = grp >> 7;
        if (b != bcur) { bcur = b; const float* mod = MODL + (size_t)b * 6 * D;
#pragma unroll
            for (int j = 0; j < 4; ++j) { const int q4 = F.lane + 64 * j; g2v[j] = *((const f32x4*)(mod + 5 * D) + q4);
                if (l + 1 < DEPTH) { shq[j] = *((const f32x4*)(mod + (size_t)BATCH * 6 * D) + q4); sclq[j] = *((const f32x4*)(mod + (size_t)BATCH * 6 * D + D) + q4); } } } }
#pragma unroll 1
      for (int m0 = grp * 16; m0 < grp * 16 + 16; m0 += 2) {
        f32x4 v[2][4]; float s[2] = {0.f, 0.f};
        const bf16* f1[2]; const bf16* f2[2]; float w1[2], w2[2];
#pragma unroll
        for (int u = 0; u < 2; ++u) { const int m = m0 + u; f1[u] = Y + (size_t)m * D; f2[u] = f1[u]; w1[u] = 1.f; w2[u] = 0.f;
            if (moe) { const v4u r = *(const v4u*)(ROUTE + (size_t)m * 8); w1[u] = __uint_as_float(ROUTE[(size_t)m * 8 + 4]); w2[u] = __uint_as_float(ROUTE[(size_t)m * 8 + 5]);
                int b1 = 0, b2 = 0;
#pragma unroll
                for (int e = 0; e < 8; ++e) { if ((int)r.x == e) b1 = P[e]; if ((int)r.z == e) b2 = P[e]; }
                f1[u] = Y2 + ((size_t)b1 * 256 + r.y) * D; f2[u] = Y2 + ((size_t)b2 * 256 + r.w) * D; } }
        { unsigned long long xw[2][4], ya[2][4], yb[2][4];
#pragma unroll
          for (int u = 0; u < 2; ++u) { const int m = m0 + u;
#pragma unroll
              for (int j = 0; j < 4; ++j) { const int q4 = F.lane + 64 * j; xw[u][j] = __builtin_nontemporal_load((const unsigned long long*)(XB + (size_t)m * D) + q4);
                  ya[u][j] = __builtin_nontemporal_load((const unsigned long long*)f1[u] + q4); yb[u][j] = moe ? __builtin_nontemporal_load((const unsigned long long*)f2[u] + q4) : 0ull; } }
          asm volatile("" ::: "memory");
#pragma unroll
          for (int u = 0; u < 2; ++u)
#pragma unroll
              for (int j = 0; j < 4; ++j) { f32x4 fv = bf4(ya[u][j]); if (moe) fv = w1[u] * fv + w2[u] * bf4(yb[u][j]);
                  v[u][j] = ALPHA * h4f(xw[u][j]) + (1.f + g2v[j]) * fv; s[u] += (v[u][j].x + v[u][j].y) + (v[u][j].z + v[u][j].w); } }
        float mean[2], s2[2] = {0.f, 0.f}, rstd[2];
#pragma unroll
        for (int u = 0; u < 2; ++u) mean[u] = wave_sum(s[u]) * (1.f / D);
#pragma unroll
        for (int u = 0; u < 2; ++u)
#pragma unroll
            for (int j = 0; j < 4; ++j) { v[u][j] = v[u][j] - mean[u]; s2[u] += (v[u][j].x * v[u][j].x + v[u][j].y * v[u][j].y) + (v[u][j].z * v[u][j].z + v[u][j].w * v[u][j].w); }
#pragma unroll
        for (int u = 0; u < 2; ++u) rstd[u] = 1.f / sqrtf(wave_sum(s2[u]) * (1.f / D) + LN_EPS);
#pragma unroll
        for (int u = 0; u < 2; ++u) { const int m = m0 + u;
#pragma unroll
            for (int j = 0; j < 4; ++j) { const int q4 = F.lane + 64 * j;
                const f32x4 xn = v[u][j] * rstd[u] * lgv[j] + lbv[j];
                if (l + 1 < DEPTH) *((unsigned long long*)(XB + (size_t)m * D) + q4) = pack_h4(xn); else *((f32x4*)(F.X + (size_t)m * D) + q4) = xn;
                if (l + 1 < DEPTH) { const f32x4 h = xn * (1.f + sclq[j]) + shq[j];
                    if (INPROJ_FP8) { int pq = __builtin_amdgcn_cvt_pk_fp8_f32(h.x, h.y, 0, false); pq = __builtin_amdgcn_cvt_pk_fp8_f32(h.z, h.w, pq, true); *((unsigned*)((unsigned char*)H + (size_t)m * D) + q4) = (unsigned)pq; }
                    else *((unsigned long long*)(H + (size_t)m * D) + q4) = (unsigned long long)pk2(h.x, h.y) | ((unsigned long long)pk2(h.z, h.w) << 32); } } }
      }
    }
}

__device__ __forceinline__ float gelu_tanh_f(float x) { return 0.5f * x * (1.f + tanhf(0.7978845608028654f * (x + 0.044715f * x * x * x))); }
__device__ __forceinline__ void ph_compress_naive(const Args& A, Frame& F, int l) {
    const int gw = blockIdx.x * NWAVES + F.wave, NGW = gridDim.x * NWAVES;
    const bf16* U = (const bf16*)(F.ws + WS_U);
    for (int it = gw; it < 2 * BATCH * NCP * 2; it += NGW) {
        const int g = it & 1, n = (it >> 1) & 127, b = (it >> 8) & 15, kv = it >> 12;
        bf16* OUT = (bf16*)(F.ws + (kv ? WS_VCMP : WS_KCMP)) + ((size_t)(b * NCP + n) * 2 + g) * 64;
        float out = 0.f;
        if (n < NCMP) {
            const float* w1 = A.in[I_CW1] + (size_t)(l * 2 + kv) * 2048 * 64; const float* pos = A.in[I_CPOS] + (size_t)(l * 2 + kv) * 2048;
            const float* w2 = A.in[I_CW2] + (size_t)(l * 2 + kv) * 64 * 64;
            const bf16* ub = U + ((size_t)b * T + 16 * n) * NU + (kv ? UVC : UKC) + g * 64;
            float pre = 0.f;
            for (int kk = 0; kk < 2048; ++kk) { const float a = bf2f(ub[(size_t)(kk >> 6) * NU + (kk & 63)]) + pos[kk]; pre += a * w1[(size_t)kk * 64 + F.lane]; }
            const float ge = gelu_tanh_f(pre);
            for (int j = 0; j < 64; ++j) out += __shfl(ge, j) * w2[j * 64 + F.lane];
        }
        OUT[F.lane] = (bf16)f2bf(out);
    }
}
__device__ __forceinline__ void ph_conv_naive(const Args& A, Frame& F, int l) {
    LAS float* glu = (LAS float*)F.lds;
    LAS float* red = (LAS float*)(F.lds + 46 * 512 * 4);
    const bf16* U = (const bf16*)(F.ws + WS_U); bf16* CAT = (bf16*)(F.ws + WS_CAT);
    const int c = F.tid;
    float w[31];
#pragma unroll
    for (int k = 0; k < 31; ++k) w[k] = A.in[I_CVW][(size_t)(l * 31 + k) * 512 + c];
    const float cb = A.in[I_CVB][l * 512 + c], lg = A.in[I_CVG][l * 512 + c], lb = A.in[I_CVBE][l * 512 + c];
    for (int it = blockIdx.x; it < M / 16; it += gridDim.x) {
        const int b = it >> 7, t0 = (it & 127) * 16;
        for (int rr = 0; rr < 46; ++rr) { const int tt = t0 - 30 + rr; float v = 0.f;
            if (tt >= 0) { const bf16* ur = U + ((size_t)b * T + tt) * NU; v = bf2f(ur[UCA + c]) * sigmoid_f(bf2f(ur[UCG + c])); }
            glu[rr * 512 + c] = v; }
        LDS_WAIT();
        float y[16];
#pragma unroll
        for (int i = 0; i < 16; ++i) { float a = cb;
#pragma unroll
            for (int k = 0; k < 31; ++k) a += w[k] * glu[(i + k) * 512 + c];
            y[i] = a; }
#pragma unroll
        for (int i = 0; i < 16; ++i) { const float s = wave_sum(y[i]); if (F.lane == 0) red[i * 8 + F.wave] = s; }
        __syncthreads();
        float mean[16];
#pragma unroll
        for (int i = 0; i < 16; ++i) { float s = 0.f;
#pragma unroll
            for (int k = 0; k < 8; ++k) s += red[i * 8 + k];
            mean[i] = s * (1.f / 512.f); }
        __syncthreads();
#pragma unroll
        for (int i = 0; i < 16; ++i) { y[i] -= mean[i]; const float s = wave_sum(y[i] * y[i]); if (F.lane == 0) red[i * 8 + F.wave] = s; }
        __syncthreads();
#pragma unroll
        for (int i = 0; i < 16; ++i) { float s = 0.f;
#pragma unroll
            for (int k = 0; k < 8; ++k) s += red[i * 8 + k];
            const float rstd = 1.f / sqrtf(s * (1.f / 512.f) + LN_EPS); const float z = y[i] * rstd * lg + lb;
            CAT[((size_t)b * T + t0 + i) * D + 512 + c] = (bf16)f2bf(z * sigmoid_f(z)); }
        __syncthreads();
    }
}
__device__ __forceinline__ float dot64(const v4u (&qp)[8], const bf16* kp) {
    float s = 0.f;
#pragma unroll
    for (int c = 0; c < 8; ++c) { const v4u kv = *(const v4u*)(kp + 8 * c);
        s += bflo(qp[c].x) * bflo(kv.x) + bfhi(qp[c].x) * bfhi(kv.x); s += bflo(qp[c].y) * bflo(kv.y) + bfhi(qp[c].y) * bfhi(kv.y);
        s += bflo(qp[c].z) * bflo(kv.z) + bfhi(qp[c].z) * bfhi(kv.z); s += bflo(qp[c].w) * bflo(kv.w) + bfhi(qp[c].w) * bfhi(kv.w); }
    return s;
}
__device__ __forceinline__ void axpy64(float (&O)[64], float e, const bf16* vp) {
#pragma unroll
    for (int c = 0; c < 8; ++c) { const v4u vv = *(const v4u*)(vp + 8 * c);
        O[8 * c + 0] += e * bflo(vv.x); O[8 * c + 1] += e * bfhi(vv.x); O[8 * c + 2] += e * bflo(vv.y); O[8 * c + 3] += e * bfhi(vv.y);
        O[8 * c + 4] += e * bflo(vv.z); O[8 * c + 5] += e * bfhi(vv.z); O[8 * c + 6] += e * bflo(vv.w); O[8 * c + 7] += e * bfhi(vv.w); }
}
__device__ __forceinline__ void ph_attn_naive(const Args& A, Frame& F, int l) {
    (void)l;
    LAS float* impH = (LAS float*)F.lds;
    LAS unsigned* selm = (LAS unsigned*)(F.lds + 32768);
    LAS float* WOUT = (LAS float*)(F.lds + 32768 + 256);
    const bf16* U = (const bf16*)(F.ws + WS_U); bf16* CAT = (bf16*)(F.ws + WS_CAT);
    const bf16* KC = (const bf16*)(F.ws + WS_KCMP); const bf16* VC = (const bf16*)(F.ws + WS_VCMP);
    const float* TBL = (const float*)(F.ws + WS_TBL);
    const float NEG = -INFINITY;
    for (int it = blockIdx.x; it < BATCH * 2 * 32; it += gridDim.x) {
        const int tb = it & 31, g = (it >> 5) & 1, b = it >> 6;
        const int t0 = tb * 64, i = F.tid & 63, r = F.wave & 3, t = t0 + i, h = g * 4 + r;
        const size_t m = (size_t)b * T + t;
        const bf16* urow = U + m * NU;
        v4u qp[8];
#pragma unroll
        for (int c = 0; c < 8; ++c) qp[c] = *(const v4u*)(urow + UQ + h * 64 + 8 * c);
        const float* tb_h = TBL + h * 128;
        const float gl0 = sigmoid_f(bf2f(urow[UGL + g * 12 + r * 3 + 0])), gl1 = sigmoid_f(bf2f(urow[UGL + g * 12 + r * 3 + 1])), gl2 = sigmoid_f(bf2f(urow[UGL + g * 12 + r * 3 + 2]));
        LAS float* acc = WOUT + (r * 64 + i) * 64;
        float O[64]; float wsc = 0.f;
        if (F.wave < 4) {
            float mx = NEG;
            for (int n = 0; n < NCMP; ++n) { const int dist = t - (16 * n + 31);
                if (dist >= 0) { const float s = dot64(qp, KC + ((size_t)(b * NCP + n) * 2 + g) * 64) + tb_h[dist < 127 ? dist : 127]; mx = fmaxf(mx, s); } }
            float ls = 0.f;
#pragma unroll
            for (int d = 0; d < 64; ++d) O[d] = 0.f;
            LAS float* imp = impH + (r * 64 + i) * 32;
            for (int j = 0; j < 32; ++j) imp[j] = 0.f;
            for (int n = 0; n < NCMP; ++n) { const int dist = t - (16 * n + 31);
                if (dist >= 0) { const float s = dot64(qp, KC + ((size_t)(b * NCP + n) * 2 + g) * 64) + tb_h[dist < 127 ? dist : 127];
                    const float e = exp2f(s - mx); ls += e; axpy64(O, e, VC + ((size_t)(b * NCP + n) * 2 + g) * 64);
                    imp[n >> 2] += e; if ((n & 3) == 3) imp[(n + 1) >> 2] += e; } }
            const float invl = ls > 0.f ? 1.f / ls : 0.f;
            for (int j = 0; j < 32; ++j) imp[j] *= invl;
#pragma unroll
            for (int d = 0; d < 64; ++d) acc[d] = gl0 * invl * O[d];
        } else {
            float mx = NEG, ls = 0.f;
#pragma unroll
            for (int d = 0; d < 64; ++d) O[d] = 0.f;
            const int p0 = t0 - 511 > 0 ? t0 - 511 : 0;
            for (int pos = p0; pos < t0 + 64; ++pos) { const int dist = t - pos;
                if (dist >= 0 && dist < 512) { const bf16* kr = U + ((size_t)b * T + pos) * NU;
                    const float s = dot64(qp, kr + UKW + g * 64) + tb_h[dist < 127 ? dist : 127];
                    if (s > mx) { const float sc = exp2f(mx - s); ls *= sc;
#pragma unroll
                        for (int d = 0; d < 64; ++d) O[d] *= sc;
                        mx = s; }
                    const float e = exp2f(s - mx); ls += e; axpy64(O, e, kr + UVW + g * 64); } }
            wsc = gl2 / ls;
        }
        __syncthreads();
        if (F.wave >= 4) {
#pragma unroll
            for (int d = 0; d < 64; ++d) acc[d] += wsc * O[d];
        }
        if (F.wave == 0) {
            LAS float* sc = impH + i * 32;
            for (int j = 0; j < 32; ++j) { float s = impH[(0 * 64 + i) * 32 + j] + impH[(1 * 64 + i) * 32 + j] + impH[(2 * 64 + i) * 32 + j] + impH[(3 * 64 + i) * 32 + j];
                if (j > tb) s = NEG; else if (j == 0 || j == tb || j == tb - 1) s = INFINITY;
                sc[j] = s; }
            unsigned mask = 0u;
            for (int k = 0; k < 8; ++k) { int best = -1; float bv = 0.f;
                for (int j = 0; j < 32; ++j) if (!((mask >> j) & 1u)) { const float v = sc[j]; if (best < 0 || v > bv) { best = j; bv = v; } }
                mask |= 1u << best; }
            mask &= (tb == 31) ? 0xffffffffu : ((1u << (tb + 1)) - 1u);
            selm[i] = mask;
        }
        __syncthreads();
        if (F.wave < 4) {
            const unsigned mask = selm[i];
            float mx = NEG, ls = 0.f;
#pragma unroll
            for (int d = 0; d < 64; ++d) O[d] = 0.f;
            for (int j = 0; j <= tb; ++j) { const bool sel = (mask >> j) & 1u;
                if (!__any(sel)) continue;
                for (int kk = 0; kk < 64; ++kk) { const int pos = 64 * j + kk, dist = t - pos;
                    if (sel && dist >= 0) { const bf16* kr = U + ((size_t)b * T + pos) * NU;
                        const float s = dot64(qp, kr + UKS + g * 64) + tb_h[dist < 127 ? dist : 127];
                        if (s > mx) { const float sc = exp2f(mx - s); ls *= sc;
#pragma unroll
                            for (int d = 0; d < 64; ++d) O[d] *= sc;
                            mx = s; }
                        const float e = exp2f(s - mx); ls += e; axpy64(O, e, kr + UVS + g * 64); } } }
            const float sc = gl1 / ls;
            bf16* orow = CAT + m * D + h * 64;
#pragma unroll
            for (int c = 0; c < 8; ++c) { float o[8];
#pragma unroll
                for (int k = 0; k < 8; ++k) o[k] = acc[8 * c + k] + sc * O[8 * c + k];
                v4u w; w.x = pk2(o[0], o[1]); w.y = pk2(o[2], o[3]); w.z = pk2(o[4], o[5]); w.w = pk2(o[6], o[7]); *(v4u*)(orow + 8 * c) = w; }
        }
        __syncthreads();
    }
}

namespace att {
using f32x16 = __attribute__((ext_vector_type(16))) float;
using s16x4 = __attribute__((ext_vector_type(4))) short;
typedef short v4i16_t __attribute__((ext_vector_type(4)));
constexpr int SLOTB = 8192;
constexpr int NSLOT = 3;
constexpr int L_K = 0, L_V = NSLOT * SLOTB, L_WSF = 2 * NSLOT * SLOTB, L_OST = L_WSF + 8 * 256, L_TB = L_OST + 8 * 8192, L_IMP = L_TB + 4096, L_MSK = L_IMP + 8 * 1024, L_END = L_MSK + 256;
__device__ __forceinline__ int crow(int r, int hi) { return (r & 3) + 8 * (r >> 2) + 4 * hi; }
__device__ __forceinline__ void glds16(const void* gsrc, unsigned lds_dst) { unsigned keep;
    asm volatile("s_mov_b32 %0, m0\n\ts_mov_b32 m0, %2\n\ts_nop 0\n\tglobal_load_lds_dwordx4 %1, off\n\ts_mov_b32 m0, %0" : "=&s"(keep) : "v"(gsrc), "s"(lds_dst) : "memory"); }
__device__ __forceinline__ unsigned cvtpk(float lo, float hi) { unsigned r; asm volatile("v_cvt_pk_bf16_f32 %0, %1, %2" : "=v"(r) : "v"(lo), "v"(hi)); return r; }
__device__ __forceinline__ void qkt(f32x16& p0, f32x16& p1, const LAS char* Kslot, const bf16x8 (&qr)[4], int r32, int hi, float cinit) {
    const LAS char* kb = Kslot + hi * 1024 + r32 * 16;
    f32x16 z;
#pragma unroll
    for (int r = 0; r < 16; ++r) z[r] = cinit;
    bf16x8 b0[4], b1[4];
#pragma unroll
    for (int d0 = 0; d0 < 4; ++d0) { b0[d0] = *(const LAS bf16x8*)(kb + d0 * 2048); b1[d0] = *(const LAS bf16x8*)(kb + d0 * 2048 + 512); }
    asm volatile("" ::: "memory");
    p0 = __builtin_amdgcn_mfma_f32_32x32x16_bf16(b0[0], qr[0], z, 0, 0, 0); p1 = __builtin_amdgcn_mfma_f32_32x32x16_bf16(b1[0], qr[0], z, 0, 0, 0);
#pragma unroll
    for (int d0 = 1; d0 < 4; ++d0) { p0 = __builtin_amdgcn_mfma_f32_32x32x16_bf16(b0[d0], qr[d0], p0, 0, 0, 0); p1 = __builtin_amdgcn_mfma_f32_32x32x16_bf16(b1[d0], qr[d0], p1, 0, 0, 0); }
}
__device__ __forceinline__ void pv(f32x16 (&o)[2], int vb, bf16x8 pa0, bf16x8 pa1, bf16x8 pa2, bf16x8 pa3) {
    s16x4 lo[2][4], hi[2][4];
#pragma unroll
    for (int d0 = 0; d0 < 2; ++d0)
#pragma unroll
        for (int ks = 0; ks < 4; ++ks) {
            asm volatile("ds_read_b64_tr_b16 %0,%1 offset:%c2" : "=&v"(lo[d0][ks]) : "v"(vb), "i"(d0 * 4096 + ks * 1024) : "memory");
            asm volatile("ds_read_b64_tr_b16 %0,%1 offset:%c2" : "=&v"(hi[d0][ks]) : "v"(vb), "i"(d0 * 4096 + ks * 1024 + 512) : "memory"); }
#define PK(d, k) (bf16x8){lo[d][k][0], lo[d][k][1], lo[d][k][2], lo[d][k][3], hi[d][k][0], hi[d][k][1], hi[d][k][2], hi[d][k][3]}
    asm volatile("s_waitcnt lgkmcnt(8)" : "+v"(lo[0][0]), "+v"(lo[0][1]), "+v"(lo[0][2]), "+v"(lo[0][3]), "+v"(hi[0][0]), "+v"(hi[0][1]), "+v"(hi[0][2]), "+v"(hi[0][3]) :: "memory"); __builtin_amdgcn_sched_barrier(0);
    o[0] = __builtin_amdgcn_mfma_f32_32x32x16_bf16(pa0, PK(0, 0), o[0], 0, 0, 0);
    o[0] = __builtin_amdgcn_mfma_f32_32x32x16_bf16(pa1, PK(0, 1), o[0], 0, 0, 0);
    o[0] = __builtin_amdgcn_mfma_f32_32x32x16_bf16(pa2, PK(0, 2), o[0], 0, 0, 0);
    o[0] = __builtin_amdgcn_mfma_f32_32x32x16_bf16(pa3, PK(0, 3), o[0], 0, 0, 0);
    asm volatile("s_waitcnt lgkmcnt(0)" : "+v"(lo[1][0]), "+v"(lo[1][1]), "+v"(lo[1][2]), "+v"(lo[1][3]), "+v"(hi[1][0]), "+v"(hi[1][1]), "+v"(hi[1][2]), "+v"(hi[1][3]) :: "memory"); __builtin_amdgcn_sched_barrier(0);
    o[1] = __builtin_amdgcn_mfma_f32_32x32x16_bf16(pa0, PK(1, 0), o[1], 0, 0, 0);
    o[1] = __builtin_amdgcn_mfma_f32_32x32x16_bf16(pa1, PK(1, 1), o[1], 0, 0, 0);
    o[1] = __builtin_amdgcn_mfma_f32_32x32x16_bf16(pa2, PK(1, 2), o[1], 0, 0, 0);
    o[1] = __builtin_amdgcn_mfma_f32_32x32x16_bf16(pa3, PK(1, 3), o[1], 0, 0, 0);
#undef PK
}
__device__ __forceinline__ float xhalf_max(float m) { auto rr = __builtin_amdgcn_permlane32_swap(__float_as_uint(m), __float_as_uint(m), false, false); return fmaxf(__uint_as_float(rr[0]), __uint_as_float(rr[1])); }
__device__ __forceinline__ float xhalf_sum(float m) { auto rr = __builtin_amdgcn_permlane32_swap(__float_as_uint(m), __float_as_uint(m), false, false); return __uint_as_float(rr[0]) + __uint_as_float(rr[1]); }
__device__ __forceinline__ float xhalf_other(float m, int hi) { auto rr = __builtin_amdgcn_permlane32_swap(__float_as_uint(m), __float_as_uint(m), false, false); const float a = __uint_as_float(rr[0]), b = __uint_as_float(rr[1]); return hi ? a : b; }
__device__ __forceinline__ float dpp_xor1(float v) { return __uint_as_float((unsigned)__builtin_amdgcn_update_dpp(0, (int)__float_as_uint(v), 0xB1, 0xF, 0xF, true)); }
__device__ __forceinline__ float dpp_xor2(float v) { return __uint_as_float((unsigned)__builtin_amdgcn_update_dpp(0, (int)__float_as_uint(v), 0x4E, 0xF, 0xF, true)); }
__device__ __forceinline__ float dpp_hmir(float v) { return __uint_as_float((unsigned)__builtin_amdgcn_update_dpp(0, (int)__float_as_uint(v), 0x141, 0xF, 0xF, true)); }
__device__ __forceinline__ int dpp_xor1i(int v) { return __builtin_amdgcn_update_dpp(0, v, 0xB1, 0xF, 0xF, true); }
__device__ __forceinline__ int dpp_xor2i(int v) { return __builtin_amdgcn_update_dpp(0, v, 0x4E, 0xF, 0xF, true); }
__device__ __forceinline__ int dpp_hmiri(int v) { return __builtin_amdgcn_update_dpp(0, v, 0x141, 0xF, 0xF, true); }
}

__device__ __forceinline__ void ph_attn(const Args& A, Frame& F, int l) {
    using namespace att; (void)l; (void)A;
    const int lane = F.lane, w = F.wave, r32 = lane & 31, hi = lane >> 5;
    const bf16* U = (const bf16*)(F.ws + WS_U); bf16* CAT = (bf16*)(F.ws + WS_CAT);
    const bf16* KC = (const bf16*)(F.ws + WS_KCMP); const bf16* VC = (const bf16*)(F.ws + WS_VCMP);
    const float* TBL = (const float*)(F.ws + WS_TBL);
    const LAS char* ldsb = (const LAS char*)F.lds;
    const unsigned lds0 = (unsigned)(size_t)F.lds;
    LAS float* wsf = (LAS float*)(F.lds + L_WSF) + w * 64;
    LAS float* tb4 = (LAS float*)(F.lds + L_TB);
    LAS float* impw = (LAS float*)(F.lds + L_IMP) + w * 256;
    LAS unsigned* mskw = (LAS unsigned*)(F.lds + L_MSK) + w * 8;
    const float NEG = -INFINITY;
    const int vbl = ((lane >> 4) & 1) * 32 + (lane & 3) * 8 + (4 * hi + ((lane & 15) >> 2)) * 64;
#ifdef ATT_ECHO
    unsigned long long ec_wait = 0, ec_s1 = 0, ec_pv = 0, ec_t = 0;
#define EC_MARK() (ec_t = __builtin_amdgcn_s_memtime())
#define EC_ADD(x) do { const unsigned long long n_ = __builtin_amdgcn_s_memtime(); x += n_ - ec_t; ec_t = n_; } while (0)
#else
#define EC_MARK() do {} while (0)
#define EC_ADD(x) do {} while (0)
#endif
    const int tok = 8 * w + (r32 >> 2), hr = r32 & 3;
    bf16x8 qn[4]; bf16 gq0 = 0, gq1 = 0, gq2 = 0; int gtab = -1;
#pragma unroll
    for (int d0 = 0; d0 < 4; ++d0) qn[d0] = (bf16x8){0, 0, 0, 0, 0, 0, 0, 0};
#define UNIT_PRE(P) do { const int p_ = (P); const int ui_ = p_ >> 8, w_ = p_ & 255, v_ = ((w_ & 7) << 5) | (w_ >> 3), bg_ = v_ >> 3, s8_ = v_ & 7; \
        const int tb_ = (ui_ == 0) ? s8_ : (ui_ == 1) ? 15 - s8_ : (ui_ == 2) ? 16 + s8_ : 31 - s8_; const int b_ = bg_ >> 1, g_ = bg_ & 1; \
        const bool ld_ = g_ != gtab; float t0_ = 0.f, t1_ = 0.f; if (ld_) { t0_ = TBL[(size_t)(4 * g_) * 256 + F.tid]; t1_ = TBL[(size_t)(4 * g_) * 256 + F.tid + 512]; } \
        const bf16* ur_ = U + ((size_t)b_ * T + tb_ * 64 + tok) * NU; \
        _Pragma("unroll") for (int d0 = 0; d0 < 4; ++d0) qn[d0] = *(const bf16x8*)(ur_ + UQ + (4 * g_ + hr) * 64 + d0 * 16 + hi * 8); \
        gq0 = ur_[UGL + g_ * 12 + hr * 3 + 0]; gq1 = ur_[UGL + g_ * 12 + hr * 3 + 1]; gq2 = ur_[UGL + g_ * 12 + hr * 3 + 2]; \
        asm volatile("" ::: "memory"); \
        const size_t rkc_ = ((size_t)(b_ * NCP) * 2 + g_) * 64; const bf16* kc_ = KC + rkc_ + (size_t)lane * 128 + w * 8; const bf16* vc_ = VC + rkc_ + (size_t)(16 * (w & 3) + (lane >> 2)) * 128 + (w >> 2) * 32 + (lane & 3) * 8; \
        glds16(kc_, (unsigned)__builtin_amdgcn_readfirstlane(lds0 + L_K + w * 1024)); glds16(vc_, (unsigned)__builtin_amdgcn_readfirstlane(lds0 + L_V + w * 1024)); \
        glds16(kc_ + 64 * 128, (unsigned)__builtin_amdgcn_readfirstlane(lds0 + L_K + SLOTB + w * 1024)); glds16(vc_ + 64 * 128, (unsigned)__builtin_amdgcn_readfirstlane(lds0 + L_V + SLOTB + w * 1024)); \
        if (ld_) { tb4[F.tid] = t0_; tb4[F.tid + 512] = t1_; gtab = g_; }     \
        asm volatile("" ::: "memory"); } while (0)
    if ((int)blockIdx.x < BATCH * 2 * 32) UNIT_PRE((int)blockIdx.x);
    for (int p = blockIdx.x; p < BATCH * 2 * 32; p += gridDim.x) {
        const int ui = p >> 8, w8 = p & 255, v = ((w8 & 7) << 5) | (w8 >> 3), bg = v >> 3, s8 = v & 7;
        const int tb = (ui == 0) ? s8 : (ui == 1) ? 15 - s8 : (ui == 2) ? 16 + s8 : 31 - s8;
        const int b = bg >> 1, g = bg & 1, t0 = tb * 64;
        const int t = t0 + tok;
        const int nwin = tb + 1 < 9 ? tb + 1 : 9, nsel = tb + 1, ntile = 2 + nwin + nsel;
        const bf16* ubg = U + (size_t)b * T * NU + g * 64;
        const bf16* kbU = ubg + (size_t)lane * NU + w * 8; const bf16* vbU = ubg + (size_t)(16 * (w & 3) + (lane >> 2)) * NU + (w >> 2) * 32 + (lane & 3) * 8;
#define TILE_DMA(i) do { const int i_ = (i); const bf16* kp_; const bf16* vp_; \
            { const bool win_ = i_ < 2 + nwin; const int kt_ = win_ ? tb - (i_ - 2) : i_ - 2 - nwin; const size_t o_ = (size_t)kt_ * (64 * NU) + (win_ ? UKW : UKS); kp_ = kbU + o_; vp_ = vbU + o_ + (UVW - UKW); } \
            const unsigned so_ = (unsigned)(i_ % NSLOT) * SLOTB; \
            glds16(kp_, (unsigned)__builtin_amdgcn_readfirstlane(lds0 + L_K + so_ + w * 1024)); glds16(vp_, (unsigned)__builtin_amdgcn_readfirstlane(lds0 + L_V + so_ + w * 1024)); } while (0)
        bf16x8 qr[4];
#pragma unroll
        for (int d0 = 0; d0 < 4; ++d0) qr[d0] = qn[d0];
        const float gl0 = sigmoid_f(bf2f(gq0)), gl1 = sigmoid_f(bf2f(gq1)), gl2 = sigmoid_f(bf2f(gq2));
        const LAS float* tbh = tb4 + hr * 256;
        const bool pre_unit = p != (int)blockIdx.x;
        f32x16 o[2];
#pragma unroll
        for (int r = 0; r < 16; ++r) { o[0][r] = 0.f; o[1][r] = 0.f; }
        LAS float* accw = (LAS float*)(F.lds + L_OST) + w * 2048 + lane;
        float cg[8], cl[8];
#pragma unroll
        for (int k = 0; k < 8; ++k) { cg[k] = 0.f; cl[k] = 0.f; }
        float mref = 0.f, lrun = 0.f; unsigned selmask = 0u;
#define FOLD(cf_, MODE) do { if (hi == 0) wsf[r32] = (cf_); asm volatile("s_waitcnt lgkmcnt(0)" ::: "memory"); \
            float f_[16]; _Pragma("unroll") for (int r = 0; r < 16; ++r) f_[r] = wsf[crow(r, hi)]; \
            if ((MODE) == 0) { _Pragma("unroll") for (int r = 0; r < 16; ++r) { accw[(2 * r) * 64] = f_[r] * o[0][r]; accw[(2 * r + 1) * 64] = f_[r] * o[1][r]; o[0][r] = 0.f; o[1][r] = 0.f; } } \
            else { float a0_[16], a1_[16]; _Pragma("unroll") for (int r = 0; r < 16; ++r) { a0_[r] = accw[(2 * r) * 64]; a1_[r] = accw[(2 * r + 1) * 64]; } \
                if ((MODE) == 1) { _Pragma("unroll") for (int r = 0; r < 16; ++r) { accw[(2 * r) * 64] = a0_[r] + f_[r] * o[0][r]; accw[(2 * r + 1) * 64] = a1_[r] + f_[r] * o[1][r]; o[0][r] = 0.f; o[1][r] = 0.f; } } \
                else { _Pragma("unroll") for (int r = 0; r < 16; ++r) { o[0][r] = a0_[r] + f_[r] * o[0][r]; o[1][r] = a1_[r] + f_[r] * o[1][r]; } } } \
            asm volatile("s_waitcnt lgkmcnt(0)" ::: "memory"); mref = 0.f; lrun = 0.f; } while (0)
        for (int i = 0; i < ntile; ++i) {
            EC_MARK();
            if (i == 0 && pre_unit) asm volatile("s_waitcnt vmcnt(6)" ::: "memory");
            else if (i + 1 < ntile) asm volatile("s_waitcnt vmcnt(2)" ::: "memory"); else asm volatile("s_waitcnt vmcnt(0)" ::: "memory");
            asm volatile("s_waitcnt lgkmcnt(0)" ::: "memory"); __builtin_amdgcn_s_barrier(); asm volatile("" ::: "memory");
            EC_ADD(ec_wait);
            if (i + 2 < ntile) TILE_DMA(i + 2);
            const unsigned so = (unsigned)(i % NSLOT) * SLOTB;
            const LAS char* Ks = ldsb + L_K + so; const int vb = (int)(lds0 + L_V + so) + vbl;
            const int kind = i < 2 ? 0 : (i < 2 + nwin ? 1 : 2);
            const int kt = kind == 0 ? i : (kind == 1 ? tb - (i - 2) : i - 2 - nwin);
            if (i == 2 + nwin) { const float lt = xhalf_sum(lrun); FOLD(gl2 / lt, 1); }
            const bool rowok = kind == 2 ? ((selmask >> kt) & 1u) != 0u : true;
            if (__any(rowok)) {
                const bool cfar = kind == 0 && kt == 0 && t0 >= 1152;
                const bool near = (kind == 0 && !cfar) || (kind != 0 && kt + 2 >= tb); const float b31 = tbh[191 - 127];
                const bool first = (i == 0) || (i == 2) || (i == 2 + nwin);
                const bool diag = kind != 0 && kt == tb, wedge = kind == 1 && (kt == tb - 8);
                f32x16 p0, p1; qkt(p0, p1, Ks, qr, r32, hi, (near ? 0.f : b31) - mref);
                if (kind == 0 && !cfar) {
                    const int dbase = t - 31 - 1024 * kt - 64 * hi;
#pragma unroll
                    for (int r = 0; r < 16; ++r) { const int cc = (r & 3) + 8 * (r >> 2); const int d0 = dbase - 16 * cc, d1 = d0 - 512;
                        p0[r] += tbh[191 - (int)min((unsigned)d0, 127u)]; p1[r] += tbh[191 - (int)min((unsigned)d1, 127u)]; }
                    asm volatile("" ::: "memory");
#pragma unroll
                    for (int r = 0; r < 16; ++r) { const int cc = (r & 3) + 8 * (r >> 2); const int d0 = dbase - 16 * cc, d1 = d0 - 512;
                        p0[r] = d0 >= 0 ? p0[r] : NEG; p1[r] = d1 >= 0 ? p1[r] : NEG; }
                } else if (near && kind != 0) {
                    const int dbase = t - 64 * kt - 4 * hi;
                    const LAS float* bp = tbh + (191 - dbase);
#pragma unroll
                    for (int r = 0; r < 16; ++r) { const int cc = (r & 3) + 8 * (r >> 2); p0[r] += bp[cc]; p1[r] += bp[cc + 32]; }
                    if (diag) {
                        asm volatile("" ::: "memory");
#pragma unroll
                        for (int r = 0; r < 16; ++r) { const int cc = (r & 3) + 8 * (r >> 2); const int d0 = dbase - cc, d1 = d0 - 32;
                            p0[r] = d0 >= 0 ? p0[r] : NEG; p1[r] = d1 >= 0 ? p1[r] : NEG; }
                    }
                } else if (wedge) {
                    const int dbase = t - 64 * kt - 4 * hi;
#pragma unroll
                    for (int r = 0; r < 16; ++r) { const int cc = (r & 3) + 8 * (r >> 2); const int d0 = dbase - cc, d1 = d0 - 32;
                        if (d0 >= 512) p0[r] = NEG; if (d1 >= 512) p1[r] = NEG; }
                }
                float alpha = 1.f;
                if (first) {
                    float mx;
                    { float m0 = fmaxf(fmaxf(p0[0], p0[1]), p0[2]), m1 = fmaxf(fmaxf(p1[0], p1[1]), p1[2]);
#pragma unroll
                      for (int r = 3; r < 15; r += 2) { m0 = fmaxf(fmaxf(m0, p0[r]), p0[r + 1]); m1 = fmaxf(fmaxf(m1, p1[r]), p1[r + 1]); }
                      mx = fmaxf(fmaxf(m0, m1), fmaxf(p0[15], p1[15])); }
                    mx = xhalf_max(mx);
                    const float dl = (mx == NEG) ? 0.f : mx;
                    mref += dl;
#pragma unroll
                    for (int r = 0; r < 16; ++r) { p0[r] -= dl; p1[r] -= dl; }
                }
#pragma unroll
                for (int r = 0; r < 16; ++r) { p0[r] = __builtin_amdgcn_exp2f(p0[r]); p1[r] = __builtin_amdgcn_exp2f(p1[r]); }
                float ls;
                { const f32x16 sv = p0 + p1; ls = ((sv[0] + sv[1]) + (sv[2] + sv[3])) + ((sv[4] + sv[5]) + (sv[6] + sv[7])) + (((sv[8] + sv[9]) + (sv[10] + sv[11])) + ((sv[12] + sv[13]) + (sv[14] + sv[15]))); }
                if (!rowok) ls = 0.f;
                const float lsr = first ? 0.f : xhalf_sum(ls);
                if (!first && __any(lsr > 1048576.f)) {
                    const float dl = lsr > 1048576.f ? __builtin_amdgcn_logf(lsr) : 0.f;
                    mref += dl; alpha = __builtin_amdgcn_exp2f(-dl);
#pragma unroll
                    for (int r = 0; r < 16; ++r) { p0[r] *= alpha; p1[r] *= alpha; }
                    ls *= alpha; lrun *= alpha;
                    if (hi == 0) wsf[r32] = alpha; asm volatile("s_waitcnt lgkmcnt(0)" ::: "memory");
#pragma unroll
                    for (int r = 0; r < 16; ++r) { const float f = wsf[crow(r, hi)]; o[0][r] *= f; o[1][r] *= f; }
                    asm volatile("s_waitcnt lgkmcnt(0)" ::: "memory");
                }
                lrun += ls;
                v4u pw0, pw1, pw2, pw3;
                pw0.x = cvtpk(p0[0], p0[1]); pw0.y = cvtpk(p0[2], p0[3]); pw0.z = cvtpk(p0[4], p0[5]); pw0.w = cvtpk(p0[6], p0[7]);
                pw1.x = cvtpk(p0[8], p0[9]); pw1.y = cvtpk(p0[10], p0[11]); pw1.z = cvtpk(p0[12], p0[13]); pw1.w = cvtpk(p0[14], p0[15]);
                pw2.x = cvtpk(p1[0], p1[1]); pw2.y = cvtpk(p1[2], p1[3]); pw2.z = cvtpk(p1[4], p1[5]); pw2.w = cvtpk(p1[6], p1[7]);
                pw3.x = cvtpk(p1[8], p1[9]); pw3.y = cvtpk(p1[10], p1[11]); pw3.z = cvtpk(p1[12], p1[13]); pw3.w = cvtpk(p1[14], p1[15]);
                if (kind == 2 && !__all(rowok)) { const unsigned km = rowok ? 0xffffffffu : 0u;
                    pw0.x &= km; pw0.y &= km; pw0.z &= km; pw0.w &= km; pw1.x &= km; pw1.y &= km; pw1.z &= km; pw1.w &= km;
                    pw2.x &= km; pw2.y &= km; pw2.z &= km; pw2.w &= km; pw3.x &= km; pw3.y &= km; pw3.z &= km; pw3.w &= km; }
                asm volatile("" ::: "memory"); EC_ADD(ec_s1);
                pv(o, vb, __builtin_bit_cast(bf16x8, pw0), __builtin_bit_cast(bf16x8, pw1), __builtin_bit_cast(bf16x8, pw2), __builtin_bit_cast(bf16x8, pw3));
                asm volatile("s_nop 0" ::: "memory"); EC_ADD(ec_pv);
                if (i == 0) {
#pragma unroll
                    for (int a = 0; a < 4; ++a) { cg[a] = (p0[4 * a] + p0[4 * a + 1]) + (p0[4 * a + 2] + p0[4 * a + 3]); cl[a] = p0[4 * a + 3]; cg[4 + a] = (p1[4 * a] + p1[4 * a + 1]) + (p1[4 * a + 2] + p1[4 * a + 3]); cl[4 + a] = p1[4 * a + 3]; } }
                if (i == 1) {
                    const float lt = xhalf_sum(lrun); const float inv = lt > 0.f ? 1.f / lt : 0.f;
                    const float ia = inv * alpha;
                    { float prev = 0.f;
#pragma unroll
                      for (int k = 0; k < 16; ++k) { float gsum, lst;
                          if (k < 8) { gsum = cg[k] * ia; lst = cl[k] * ia; }
                          else if (k < 12) { const int a = k - 8; gsum = ((p0[4 * a] + p0[4 * a + 1]) + (p0[4 * a + 2] + p0[4 * a + 3])) * inv; lst = p0[4 * a + 3] * inv; }
                          else { const int a = k - 12; gsum = ((p1[4 * a] + p1[4 * a + 1]) + (p1[4 * a + 2] + p1[4 * a + 3])) * inv; lst = p1[4 * a + 3] * inv; }
                          const float ot = xhalf_other(lst, hi); gsum += hi ? ot : prev; prev = ot;
                          gsum += dpp_xor1(gsum); gsum += dpp_xor2(gsum);
                          if (hr == 0) impw[(r32 >> 2) * 32 + 2 * k + hi] = gsum; } }
                    asm volatile("s_waitcnt lgkmcnt(0)" ::: "memory");
                    {
                      const int tk = lane >> 3, sub = lane & 7;
                      const f32x4 sv = *(const LAS f32x4*)(impw + tk * 32 + sub * 4);
                      float sc4[4];
#pragma unroll
                      for (int q = 0; q < 4; ++q) { const int j = sub * 4 + q; sc4[q] = j > tb ? -1.f : ((j == 0 || j == tb || j == tb - 1) ? INFINITY : sv[q]); }
                      unsigned mask = 0u;
#pragma unroll 1
                      for (int k = 0; k < 8; ++k) {
                          float bv = sc4[0]; int gj = sub * 4;
#pragma unroll
                          for (int q = 1; q < 4; ++q) if (sc4[q] > bv) { bv = sc4[q]; gj = sub * 4 + q; }
                          { float ov = dpp_xor1(bv); int oj = dpp_xor1i(gj); if (ov > bv || (ov == bv && oj < gj)) { bv = ov; gj = oj; }
                            ov = dpp_xor2(bv); oj = dpp_xor2i(gj); if (ov > bv || (ov == bv && oj < gj)) { bv = ov; gj = oj; }
                            ov = dpp_hmir(bv); oj = dpp_hmiri(gj); if (ov > bv || (ov == bv && oj < gj)) { bv = ov; gj = oj; } }
                          mask |= 1u << gj;
#pragma unroll
                          for (int q = 0; q < 4; ++q) if (gj == sub * 4 + q) sc4[q] = NEG;
                      }
                      mask &= (tb == 31) ? 0xffffffffu : ((1u << (tb + 1)) - 1u);
                      selmask = (unsigned)__shfl((int)mask, (r32 >> 2) * 8); }
                    FOLD(gl0 * inv, 0);
                }
            }
        }
        asm volatile("s_waitcnt lgkmcnt(0)" ::: "memory"); __builtin_amdgcn_s_barrier(); asm volatile("" ::: "memory");
        if (p + (int)gridDim.x < BATCH * 2 * 32) UNIT_PRE(p + (int)gridDim.x);
        { const float lt = xhalf_sum(lrun); FOLD(gl1 / lt, 2); }
        { LAS bf16* stg = (LAS bf16*)(F.lds + L_OST + w * 8192);
#pragma unroll
          for (int r = 0; r < 16; ++r) { const int orow = crow(r, hi);
#pragma unroll
              for (int d0 = 0; d0 < 2; ++d0) stg[orow * 64 + d0 * 32 + r32] = (bf16)f2bf(o[d0][r]); }
          asm volatile("s_waitcnt lgkmcnt(0)" ::: "memory");
#pragma unroll
          for (int i2 = 0; i2 < 4; ++i2) { const int row = i2 * 8 + (lane >> 3), ch = lane & 7; const v4u vv = *(const LAS v4u*)(stg + row * 64 + ch * 8);
              *(v4u*)(CAT + ((size_t)b * T + t0 + 8 * w + (row >> 2)) * D + (4 * g + (row & 3)) * 64 + ch * 8) = vv; }
          asm volatile("s_waitcnt lgkmcnt(0)" ::: "memory"); }
#undef FOLD
#undef TILE_DMA
    }
#undef UNIT_PRE
#ifdef ATT_ECHO
    { const unsigned long long dur = (ATT_ECHO == 1) ? ec_wait : (ATT_ECHO == 2) ? ec_s1 : ec_pv;
      if (w == 0) { const unsigned long long t0_ = __builtin_amdgcn_s_memtime(); while (__builtin_amdgcn_s_memtime() - t0_ < dur) __builtin_amdgcn_s_sleep(4); }
      __syncthreads(); }
#endif
}

__device__ __forceinline__ void ph_compress(const Args& A, Frame& F, int l) {
    LAS float* P = (LAS float*)F.lds;
    LAS float* G = (LAS float*)(F.lds + 17408);
    LAS float* W2 = (LAS float*)(F.lds + 25600);
    const bf16* U = (const bf16*)(F.ws + WS_U);
    const int lane = F.lane, w = F.wave, rt = w & 1, hf = (w >> 1) & 1, ch = w >> 2;
    for (int it = blockIdx.x; it < 256; it += gridDim.x) {
        const int q = it & 3, g = (it >> 2) & 1, b = (it >> 3) & 15, kv = it >> 7;
        const bf16* WT = (const bf16*)(F.ws + WS_WCMP) + (size_t)kv * 64 * 2048;
        const float* w2 = A.in[I_CW2] + (size_t)(l * 2 + kv) * 64 * 64;
        float posb = 0.f;
        { const float* pp = (const float*)(F.ws + WS_WCMP + 512 * 1024) + kv * 64 + (F.tid & 63); float pt[16];
#pragma unroll
          for (int i = 0; i < 16; ++i) pt[i] = pp[i * 128];
#pragma unroll
          for (int i = 0; i < 16; ++i) posb += pt[i]; }
        { f32x4 t[2];
#pragma unroll
          for (int i = 0; i < 2; ++i) t[i] = ((const f32x4*)w2)[F.tid + 512 * i];
          asm volatile("" ::: "memory");
#pragma unroll
          for (int i = 0; i < 2; ++i) ((LAS f32x4*)W2)[F.tid + 512 * i] = t[i]; }
        f32x4 acc[2] = {(f32x4){0.f, 0.f, 0.f, 0.f}, (f32x4){0.f, 0.f, 0.f, 0.f}};
        const int kq = lane >> 4, rc = lane & 15;
        int chunk = 32 * q + 16 * rt + rc + hf; chunk = chunk < 128 ? chunk : 127;
        const bf16* ap = U + ((size_t)b * T + 16 * chunk) * NU + (kv ? UVC : UKC) + g * 64 + 8 * kq;
        const bf16* bp = WT + (size_t)(32 * ch + rc) * 2048 + 1024 * hf + 8 * kq;
        for (int ks0 = 0; ks0 < 32; ks0 += 8) {
            bf16x8 a[8], bb[8][2];
#pragma unroll
            for (int u = 0; u < 8; ++u) { const int ks = ks0 + u; a[u] = *(const bf16x8*)(ap + (size_t)(ks >> 1) * NU + (ks & 1) * 32);
                bb[u][0] = *(const bf16x8*)(bp + 32 * ks); bb[u][1] = *(const bf16x8*)(bp + (size_t)16 * 2048 + 32 * ks); }
            asm volatile("" ::: "memory");
#pragma unroll
            for (int u = 0; u < 8; ++u) { acc[0] = __builtin_amdgcn_mfma_f32_16x16x32_bf16(a[u], bb[u][0], acc[0], 0, 0, 0); acc[1] = __builtin_amdgcn_mfma_f32_16x16x32_bf16(a[u], bb[u][1], acc[1], 0, 0, 0); } }
#pragma unroll
        for (int ct = 0; ct < 2; ++ct)
#pragma unroll
            for (int r = 0; r < 4; ++r) P[(hf * 32 + 16 * rt + kq * 4 + r) * 68 + 32 * ch + 16 * ct + rc] = acc[ct][r];
        __syncthreads();
#pragma unroll
        for (int i = 0; i < 4; ++i) { const int idx = F.tid + 512 * i, n = idx >> 6, j = idx & 63; G[idx] = gelu_tanh_f(P[n * 68 + j] + P[(32 + n) * 68 + j] + posb); }
        __syncthreads();
        { const int j2 = F.tid & 63, ng = F.tid >> 6;
          bf16* OUT = (bf16*)(F.ws + (kv ? WS_VCMP : WS_KCMP));
          float sacc[4] = {0.f, 0.f, 0.f, 0.f};
#pragma unroll 1
          for (int jc = 0; jc < 4; ++jc) { float wv[16]; f32x4 gv[4][4];
#pragma unroll
              for (int i = 0; i < 16; ++i) wv[i] = W2[(16 * jc + i) * 64 + j2];
#pragma unroll
              for (int i = 0; i < 4; ++i)
#pragma unroll
                  for (int q4 = 0; q4 < 4; ++q4) gv[i][q4] = *(const LAS f32x4*)(G + (ng + 8 * i) * 64 + 16 * jc + 4 * q4);
              asm volatile("" ::: "memory");
#pragma unroll
              for (int i = 0; i < 4; ++i)
#pragma unroll
                  for (int q4 = 0; q4 < 4; ++q4) sacc[i] += gv[i][q4].x * wv[4 * q4] + gv[i][q4].y * wv[4 * q4 + 1] + gv[i][q4].z * wv[4 * q4 + 2] + gv[i][q4].w * wv[4 * q4 + 3]; }
#pragma unroll
          for (int i = 0; i < 4; ++i) { const int nl = ng + 8 * i, n = 32 * q + nl; OUT[((size_t)(b * NCP + n) * 2 + g) * 64 + j2] = (bf16)f2bf(n < NCMP ? sacc[i] : 0.f); } }
        __syncthreads();
    }
}

__device__ __forceinline__ void ph_conv(const Args& A, Frame& F, int l) {
    typedef _Float16 h8 __attribute__((ext_vector_type(8)));
    typedef _Float16 h4 __attribute__((ext_vector_type(4)));
    LAS _Float16* taps = (LAS _Float16*)F.lds;
    LAS _Float16* glu = (LAS _Float16*)(F.lds + 31 * 512 * 2);
    const bf16* U = (const bf16*)(F.ws + WS_U); bf16* CAT = (bf16*)(F.ws + WS_CAT);
    const int lane = F.lane, w = F.wave, c0 = 8 * lane;
    { const f32x4* src = (const f32x4*)(A.in[I_CVW] + (size_t)l * 31 * 512); f32x4 t[8];
#pragma unroll
      for (int i = 0; i < 8; ++i) { const int q = F.tid + 512 * i; t[i] = q < 31 * 128 ? src[q] : (f32x4){0.f, 0.f, 0.f, 0.f}; }
      asm volatile("" ::: "memory");
#pragma unroll
      for (int i = 0; i < 8; ++i) { const int q = F.tid + 512 * i; if (q < 31 * 128) { h4 o; o[0] = (_Float16)t[i].x; o[1] = (_Float16)t[i].y; o[2] = (_Float16)t[i].z; o[3] = (_Float16)t[i].w; ((LAS h4*)taps)[q] = o; } } }
    f32x4 cb[2], lg[2], lb[2];
#pragma unroll
    for (int h = 0; h < 2; ++h) { cb[h] = *(const f32x4*)(A.in[I_CVB] + l * 512 + c0 + 4 * h); lg[h] = *(const f32x4*)(A.in[I_CVG] + l * 512 + c0 + 4 * h); lb[h] = *(const f32x4*)(A.in[I_CVBE] + l * 512 + c0 + 4 * h); }
    __syncthreads();
    for (int it = blockIdx.x; it < M / 32; it += gridDim.x) {
        const int w8 = it & 255, itx = (it & ~255) | ((w8 & 7) << 5) | (w8 >> 3);
        const int b = itx >> 6, t0 = (itx & 63) * 32;
        { v4u av[8], gv[8];
#pragma unroll
          for (int i = 0; i < 8; ++i) { const int q = F.tid + 512 * i; const int rr = q >> 6, ch = (q & 63) * 8; const int tt = t0 - 30 + rr; const bool ok = q < 62 * 64 && tt >= 0;
              const bf16* ur = U + ((size_t)b * T + (ok ? tt : 0)) * NU; av[i] = *(const v4u*)(ur + UCA + ch); gv[i] = *(const v4u*)(ur + UCG + ch); }
          asm volatile("" ::: "memory");
#pragma unroll
          for (int i = 0; i < 8; ++i) { const int q = F.tid + 512 * i; const int rr = q >> 6, ch = (q & 63) * 8; const int tt = t0 - 30 + rr;
              if (q < 62 * 64) { h8 o;
                  if (tt >= 0) { o[0] = (_Float16)(bflo(av[i].x) * sigmoid_f(bflo(gv[i].x))); o[1] = (_Float16)(bfhi(av[i].x) * sigmoid_f(bfhi(gv[i].x))); o[2] = (_Float16)(bflo(av[i].y) * sigmoid_f(bflo(gv[i].y))); o[3] = (_Float16)(bfhi(av[i].y) * sigmoid_f(bfhi(gv[i].y)));
                      o[4] = (_Float16)(bflo(av[i].z) * sigmoid_f(bflo(gv[i].z))); o[5] = (_Float16)(bfhi(av[i].z) * sigmoid_f(bfhi(gv[i].z))); o[6] = (_Float16)(bflo(av[i].w) * sigmoid_f(bflo(gv[i].w))); o[7] = (_Float16)(bfhi(av[i].w) * sigmoid_f(bfhi(gv[i].w))); }
                  else {
#pragma unroll
                      for (int k = 0; k < 8; ++k) o[k] = (_Float16)0.f; }
                  *(LAS h8*)(glu + rr * 512 + ch) = o; } } }
        __syncthreads();
        h8 y16[4];
        { h8 cb16; cb16[0] = (_Float16)cb[0].x; cb16[1] = (_Float16)cb[0].y; cb16[2] = (_Float16)cb[0].z; cb16[3] = (_Float16)cb[0].w; cb16[4] = (_Float16)cb[1].x; cb16[5] = (_Float16)cb[1].y; cb16[6] = (_Float16)cb[1].z; cb16[7] = (_Float16)cb[1].w;
#pragma unroll
          for (int i = 0; i < 4; ++i) y16[i] = cb16; }
        h8 wk[11];
#pragma unroll
        for (int c8 = 0; c8 < 34; c8 += 8) {
            h8 gh[8];
#pragma unroll
            for (int i = 0; i < 8; ++i) { const int rho = c8 + i;
                if (rho < 34) gh[i] = *(const LAS h8*)(glu + (4 * w + rho) * 512 + c0);
                if (rho < 31) wk[3 + i] = *(const LAS h8*)(taps + rho * 512 + c0); }
            asm volatile("" ::: "memory");
#pragma unroll
            for (int i = 0; i < 8; ++i) { const int rho = c8 + i;
                if (rho < 34) {
#pragma unroll
                    for (int t = 0; t < 4; ++t) { const int k = rho - t; if (k >= 0 && k < 31) y16[t] += wk[3 + i - t] * gh[i]; } } }
#pragma unroll
            for (int t = 0; t < 3; ++t) wk[t] = wk[8 + t];
        }
        f32x4 y[4][2];
#pragma unroll
        for (int i = 0; i < 4; ++i) { y[i][0] = (f32x4){(float)y16[i][0], (float)y16[i][1], (float)y16[i][2], (float)y16[i][3]}; y[i][1] = (f32x4){(float)y16[i][4], (float)y16[i][5], (float)y16[i][6], (float)y16[i][7]}; }
#pragma unroll
        for (int i = 0; i < 4; ++i) {
            float s = (y[i][0].x + y[i][0].y) + (y[i][0].z + y[i][0].w) + (y[i][1].x + y[i][1].y) + (y[i][1].z + y[i][1].w);
            const float mean = wave_sum(s) * (1.f / 512.f);
            const f32x4 d0 = y[i][0] - mean, d1 = y[i][1] - mean;
            float q = (d0.x * d0.x + d0.y * d0.y) + (d0.z * d0.z + d0.w * d0.w) + (d1.x * d1.x + d1.y * d1.y) + (d1.z * d1.z + d1.w * d1.w);
            const float rstd = 1.f / sqrtf(wave_sum(q) * (1.f / 512.f) + LN_EPS);
            const f32x4 z0 = d0 * rstd * lg[0] + lb[0], z1 = d1 * rstd * lg[1] + lb[1];
            v4u o; o.x = pk2(z0.x * sigmoid_f(z0.x), z0.y * sigmoid_f(z0.y)); o.y = pk2(z0.z * sigmoid_f(z0.z), z0.w * sigmoid_f(z0.w));
            o.z = pk2(z1.x * sigmoid_f(z1.x), z1.y * sigmoid_f(z1.y)); o.w = pk2(z1.z * sigmoid_f(z1.z), z1.w * sigmoid_f(z1.w));
            *(v4u*)(CAT + ((size_t)b * T + t0 + 4 * w + i) * D + 512 + c0) = o; }
        __syncthreads();
    }
}

constexpr int NSTEP_PRO = 2, NSTEP_LAYER = 8, NSTEPS = NSTEP_PRO + DEPTH * NSTEP_LAYER;
#define IN(k) (lo <= (k) && (k) < hi)
#define SEAM(k) do { if (IN(k) && IN((k) + 1)) xcd_barrier(bar); } while (0)
#define FRESH() do { int t_ = (int)__builtin_amdgcn_mbcnt_hi(~0u, __builtin_amdgcn_mbcnt_lo(~0u, 0u)) + 64 * F.wave0; asm volatile("" : "+v"(t_)); F.tid = t_; F.lane = t_ & 63; F.wave = __builtin_amdgcn_readfirstlane(t_ >> 6); \
        size_t z_ = 0; asm volatile("" : "+s"(z_)); F.ws = args.ws + z_; F.ctl = (gu32*)(F.ws + WS_CTL); F.X = args.out + z_; } while (0)

template <int L> __device__ __forceinline__ void layer_steps(const Args& args, Frame& F, const XcdBarrier& bar, const int lo, const int hi) {
    constexpr int l = L;
        constexpr int base = NSTEP_PRO + l * NSTEP_LAYER; constexpr bool moe = (l & 1) != 0;
        if (IN(base + 0)) { FRESH();
            pg8::Gemm g{(const pg8::bf16_t*)(F.ws + WS_H), (const pg8::bf16_t*)(F.ws + WS_WIN), M, NU, D}; pg8::StaticOrder S; S.init(M, NU, F.G, (int)blockIdx.x);
            pg8::EpiU E{(pg8::bf16_t*)(F.ws + WS_U), NU, 2, INPROJ_FP8 ? C2 / 32.f : C2, INPROJ_FP8 ? 1.f / 32.f : 1.f};
            pg8::gemm_phase<pg8::EpiU, pg8::StaticOrder, true, true, INPROJ_FP8 != 0>(F.lds + RING_OFF, g, S, E, F.tid);
        }
        SEAM(base + 0);
        if (IN(base + 1)) { FRESH(); ph_compress(args, F, l); FRESH(); ph_conv(args, F, l); }
        SEAM(base + 1);
        if (IN(base + 2)) { FRESH();
#ifdef USE_NAIVE_ATTN
            ph_attn_naive(args, F, l);
#else
            ph_attn(args, F, l);
#endif
        }
        SEAM(base + 2);
        if (IN(base + 3)) { FRESH();
            pg8::Gemm g{(const pg8::bf16_t*)(F.ws + WS_CAT), (const pg8::bf16_t*)(F.ws + WS_WO), M, D, D}; pg8::StaticOrder S; S.init(M, D, F.G, (int)blockIdx.x);
            pg8::EpiBf E{(pg8::bf16_t*)(F.ws + WS_Y), D, 4, 1.f};
            pg8::gemm_phase<pg8::EpiBf, pg8::StaticOrder, true, true>(F.lds + RING_OFF, g, S, E, F.tid);
        }
        SEAM(base + 3);
        if (IN(base + 4)) { FRESH(); ph_ln1(args, F, l); }
        SEAM(base + 4);
        if (IN(base + 5)) { FRESH();
            pg8::MoeOrder S;
            if constexpr (moe) S.init_moe((unsigned*)(F.ctl + CW_CNT) + (l >> 1) * 8 * 64, 2 * FFE / 256, F.G, (int)blockIdx.x, 1); else S.init_dense(M / 256, 2 * FF / 256, F.G, (int)blockIdx.x);
            pg8::Gemm g{(const pg8::bf16_t*)(F.ws + (moe ? WS_HG : WS_H)), (const pg8::bf16_t*)(F.ws + WS_W1), M, 0, D};
            if constexpr (moe || dense_up8(l)) { pg8::EpiSwiGLU8 E{(unsigned char*)(F.ws + WS_HID), moe ? FFE : FF, moe ? 2 * FFE / 256 : 2 * FF / 256, 1.f / 32.f};
                pg8::gemm_phase<pg8::EpiSwiGLU8, pg8::MoeOrder, true, true, true>(F.lds + RING_OFF, g, S, E, F.tid); }
            else if constexpr (DENSE_FP8 == 2) { pg8::EpiSwiGLU8 E{(unsigned char*)(F.ws + WS_HID), FF, 2 * FF / 256, 1.f};
                pg8::gemm_phase<pg8::EpiSwiGLU8, pg8::MoeOrder, true, true>(F.lds + RING_OFF, g, S, E, F.tid); }
            else { pg8::EpiSwiGLU E{(pg8::bf16_t*)(F.ws + WS_HID), FF, 2 * FF / 256};
                pg8::gemm_phase<pg8::EpiSwiGLU, pg8::MoeOrder, true, true>(F.lds + RING_OFF, g, S, E, F.tid); }
        }
        SEAM(base + 5);
        if (IN(base + 6)) { FRESH();
            pg8::MoeOrder S;
            if constexpr (moe) S.init_moe((unsigned*)(F.ctl + CW_CNT) + (l >> 1) * 8 * 64, 4, F.G, (int)blockIdx.x, 0); else S.init_dense(M / 256, 4, F.G, (int)blockIdx.x);
            pg8::Gemm g{(const pg8::bf16_t*)(F.ws + WS_HID), (const pg8::bf16_t*)(F.ws + WS_W2), M, D, moe ? FFE : FF};
            if constexpr (moe) {
                const int n_units = S.so.nwg, n_full = (n_units / F.G) * F.G, tail = n_units - n_full;
                const int chunks = tail == 0 ? 1 : (tail * 7 <= F.G ? 7 : (tail * 2 <= F.G ? 2 : 1));
                if (chunks > 1) S.so.nwg = n_full;
                { pg8::EpiBf E{(pg8::bf16_t*)(F.ws + WS_Y2), D, 4, 1.f / 128.f};
                  pg8::gemm_phase<pg8::EpiBf, pg8::MoeOrder, true, true, true>(F.lds + RING_OFF, g, S, E, F.tid); }
                if (chunks > 1) {
                    asm volatile("s_waitcnt vmcnt(0) lgkmcnt(0)" ::: "memory"); __syncthreads();
                    FRESH();
                    const int kb = FFE / chunks;
                    pg8::OneUnit S1; S1.have = 0; S1.u.pm = 0; S1.u.pn = 0; S1.u.pa = 0; int cch = 0;
                    if ((int)blockIdx.x < tail * chunks) { const int tu = (int)blockIdx.x / chunks; cch = (int)blockIdx.x % chunks; pg8::Unit t; S.unit_of(n_full + tu, t);
                        S1.have = 1; S1.u.pm = tu * chunks + cch; S1.u.pn = t.pn; S1.u.pa = t.pa; }
                    pg8::Gemm g1{(const pg8::bf16_t*)(F.ws + WS_HID + (size_t)cch * kb), (const pg8::bf16_t*)(F.ws + WS_W2 + (size_t)cch * kb), M, D, kb, FFE};
                    pg8::EpiF32P E1{(float*)(F.ws + WS_H), 256};
                    pg8::gemm_phase<pg8::EpiF32P, pg8::OneUnit, true, true, true>(F.lds + RING_OFF, g1, S1, E1, F.tid);
                    xcd_barrier(bar);
                    FRESH();
                    { const float* Pp = (const float*)(F.ws + WS_H); bf16* Y2o = (bf16*)(F.ws + WS_Y2);
                      const int gw = (int)blockIdx.x * NWAVES + F.wave, NGW = F.G * NWAVES;
                      for (int rr = gw; rr < tail * 256; rr += NGW) { const int tu = rr >> 8, r = rr & 255; pg8::Unit t; S.unit_of(n_full + tu, t);
                          f32x4 a = {0.f, 0.f, 0.f, 0.f};
                          for (int c2 = 0; c2 < chunks; ++c2) a += *((const f32x4*)(Pp + ((size_t)(tu * chunks + c2) * 256 + r) * 256) + F.lane);
                          a = a * (1.f / 128.f);
                          *((unsigned long long*)(Y2o + ((size_t)t.pm * 256 + r) * D + (t.pn & 3) * 256) + F.lane) = (unsigned long long)pk2(a.x, a.y) | ((unsigned long long)pk2(a.z, a.w) << 32); } }
                }
            } else if constexpr (DENSE_FP8 != 0) { pg8::EpiBf E{(pg8::bf16_t*)(F.ws + WS_Y), D, 4, 1.f / 128.f};
                pg8::gemm_phase<pg8::EpiBf, pg8::MoeOrder, true, true, true>(F.lds + RING_OFF, g, S, E, F.tid); }
            else { pg8::EpiBf E{(pg8::bf16_t*)(F.ws + WS_Y), D, 4, 1.f};
                pg8::gemm_phase<pg8::EpiBf, pg8::MoeOrder, true, true>(F.lds + RING_OFF, g, S, E, F.tid); }
        }
        SEAM(base + 6);
        if (IN(base + 7)) { FRESH(); ph_ln2(args, F, l); FRESH(); if (l + 1 < DEPTH) ph_cvt(args, F, l + 1); }
        SEAM(base + 7);
}
__global__ void __launch_bounds__(NWAVES * 64, 2) fwd(Args args) {
    extern __shared__ __attribute__((aligned(16))) unsigned char lds[];
    Frame F;
    F.lds = (LAS unsigned char*)lds;
    F.MISC = (volatile LAS unsigned*)(F.lds + MISC_OFF);
    F.tid = threadIdx.x; F.lane = F.tid & 63; F.wave = __builtin_amdgcn_readfirstlane(F.tid >> 6); F.wave0 = F.wave;
    F.G = gridDim.x;
    F.ws = args.ws; F.ctl = (gu32*)(args.ws + WS_CTL); F.X = args.out;
    for (int u = F.tid; u < (LDS_BYTES - LDSCTL_OFF) / 4; u += NWAVES * 64) ((LAS unsigned*)(F.lds + LDSCTL_OFF))[u] = 0u;
    __syncthreads();
    const int lo = args.ph_lo, hi = args.ph_hi;
    XcdBarrier bar; bar.bar = (unsigned*)(F.ctl + CW_BAR); bar.x = 0; bar.st = nullptr; bar.w0 = F.wave0;
    if (hi - lo > 1) { bar = xcd_barrier_post((unsigned*)(F.ctl + CW_BAR), F.MISC + 8); bar.w0 = F.wave0; }
    if (IN(0)) { ph_ada(args, F); ph_tbl(args, F); ph_cvt(args, F, 0); }
    SEAM(0);
    if (IN(1)) { ph_mod0(args, F); }
    SEAM(1);
    layer_steps<0>(args, F, bar, lo, hi); layer_steps<1>(args, F, bar, lo, hi); layer_steps<2>(args, F, bar, lo, hi); layer_steps<3>(args, F, bar, lo, hi);
#undef IN
#undef SEAM
}

extern "C" void kernel_launch(void* const* d_in, const int* in_sizes, int n_in, void* d_out, int out_size, void* d_ws, size_t ws_size, hipStream_t stream) {
    static int grid = 0;
    if (grid == 0) {
        if (n_in != 21 || out_size != M * D || ws_size < WS_END) { fprintf(stderr, "kernel_launch: unexpected shapes (n_in %d out %d ws %zu)\n", n_in, out_size, ws_size); grid = -1; return; }
        int dev = 0, cus = 0, per_cu = 0;
        if (hipGetDevice(&dev) != hipSuccess || hipDeviceGetAttribute(&cus, hipDeviceAttributeMultiprocessorCount, dev) != hipSuccess) { grid = -1; return; }
        if (hipFuncSetAttribute((const void*)fwd, hipFuncAttributeMaxDynamicSharedMemorySize, LDS_BYTES) != hipSuccess) { fprintf(stderr, "kernel_launch: hipFuncSetAttribute failed\n"); grid = -1; return; }
        if (hipOccupancyMaxActiveBlocksPerMultiprocessor(&per_cu, (const void*)fwd, NWAVES * 64, LDS_BYTES) != hipSuccess || per_cu < 1) fprintf(stderr, "kernel_launch: occupancy query reports %d\n", per_cu);
        (void)hipGetLastError();
        grid = cus;
    }
    if (grid < 0) return;
    (void)in_sizes;
    if (hipMemsetAsync((char*)d_ws + WS_CTL, 0, CTL_ZERO_BYTES, stream) != hipSuccess) return;
    Args a{};
    for (int i = 0; i < 21; ++i) a.in[i] = (const float*)d_in[i];
    a.out = (float*)d_out; a.ws = (unsigned char*)d_ws;
#ifndef MK_ONE_LAUNCH
    for (int s = 0; s < NSTEPS; ++s) { a.ph_lo = s; a.ph_hi = s + 1; hipLaunchKernelGGL(fwd, dim3(grid), dim3(NWAVES * 64), LDS_BYTES, stream, a); }
#else
    a.ph_lo = 0; a.ph_hi = NSTEPS; hipLaunchKernelGGL(fwd, dim3(grid), dim3(NWAVES * 64), LDS_BYTES, stream, a);
#endif
}
```
